# Optimizing an MI355X kernel written in HIP

```python
import math
import jax
import jax.numpy as jnp
from jax import lax
import numpy as np

D_MODEL = 1024
BATCH = 2
SEQ = 8192
DEPTH = 2

GRID_W = 64
CTX_LEN = 256
D_MIX = D_MODEL
GROUP_W = D_MIX // 4
A_HEADS = 4
A_DV = GROUP_W // A_HEADS
A_DK = A_DV // 2
B_HEADS = 4
B_DH = GROUP_W // B_HEADS
CONV_W = 3
C_HEADS = 4
C_DV = GROUP_W // C_HEADS
C_DK = C_DV // 2
GLA_RANK = 16
GLA_TAU = 16.0
D_HEADS = 4
D_KV = 2
D_GROUP = D_HEADS // D_KV
D_HD = GROUP_W // D_HEADS
WINDOW = 128
BLOCK = 128
CHUNK = 64
ROPE_THETA = 10000.0
EPS = 1e-6
F32 = jnp.float32

SPLIT_SIZES = (
    A_HEADS * 2 * A_DK, A_HEADS * 2 * A_DK, A_HEADS * A_DV,
    B_HEADS * B_DH, B_HEADS * B_DH, B_HEADS * B_DH, 4 * B_HEADS, B_HEADS * B_DH,
    C_HEADS * C_DK, C_HEADS * C_DK, C_HEADS * C_DV, 2 * GLA_RANK,
    D_HEADS * D_HD, D_KV * D_HD, D_KV * D_HD,
    D_MIX,
)
N_IN = sum(SPLIT_SIZES)

kernel_name = 'hybrid_parallel_heads_diffusion_block'


def rmsnorm(x, g):
    xf = x.astype(F32)
    y = xf * lax.rsqrt(jnp.mean(xf * xf, axis=-1, keepdims=True) + EPS)
    return (y * g.astype(F32)).astype(x.dtype)


def split_cols(p):
    outs, start = [], 0
    for size in SPLIT_SIZES:
        outs.append(p[..., start:start + size])
        start += size
    return outs


def _rotate(xh, ang):
    x1, x2 = jnp.split(xh, 2, axis=-1)
    cos, sin = jnp.cos(ang), jnp.sin(ang)
    return jnp.concatenate([x1 * cos - x2 * sin, x1 * sin + x2 * cos], axis=-1)


def axial_rope(x, rows, cols):
    hd = x.shape[-1]
    nq = hd // 4
    inv = ROPE_THETA ** (-jnp.arange(nq, dtype=F32) / nq)
    shp = (x.shape[1],) + (1,) * (x.ndim - 3) + (nq,)
    ang_r = (rows.astype(F32)[:, None] * inv).reshape(shp)
    ang_c = (cols.astype(F32)[:, None] * inv).reshape(shp)
    xf = x.astype(F32)
    out = jnp.concatenate([_rotate(xf[..., :hd // 2], ang_r), _rotate(xf[..., hd // 2:], ang_c)], axis=-1)
    return out.astype(x.dtype)


def short_conv(x, w, b):
    ch = x.shape[-1]
    y = lax.conv_general_dilated(x, w.reshape(CONV_W, 1, ch).astype(x.dtype), (1,),
                                 [((CONV_W - 1) // 2, CONV_W // 2)],
                                 dimension_numbers=('NWC', 'WIO', 'NWC'), feature_group_count=ch)
    return y + b.astype(x.dtype)


def _to_chunks(a):
    bsz, nh, t = a.shape[:3]
    a = a.reshape((bsz, nh, t // CHUNK, CHUNK) + a.shape[3:])
    return jnp.moveaxis(a, 2, 0)


def chunked_scan(step, state, seqs):
    t = seqs[0].shape[2]
    state, hs = lax.scan(step, state, tuple(_to_chunks(a) for a in seqs))
    hs = jnp.moveaxis(hs, 0, 2)
    return hs.reshape(hs.shape[:2] + (t,) + hs.shape[4:]), state


def bidir(step, init, ctx_f, lat_f, ctx_b, lat_b):
    flip = lambda seqs: tuple(jnp.flip(a, 2) for a in seqs)
    hc_f, st_f = chunked_scan(step, init, ctx_f)
    hl_f, _ = chunked_scan(step, st_f, lat_f)
    hc_b, st_b = chunked_scan(step, init, flip(ctx_b))
    hl_b, _ = chunked_scan(step, st_b, flip(lat_b))
    return hl_f + jnp.flip(hl_b, 2), hc_f + jnp.flip(hc_b, 2)


def _mlstm_step(state, xs):
    cmat, nvec, m = state
    q, k, v, li, lf = xs
    ln = q.shape[2]
    tril = jnp.tril(jnp.ones((ln, ln), dtype=bool))
    b = jnp.cumsum(lf, axis=-1)
    d = jnp.where(tril, b[..., :, None] - b[..., None, :] + li[..., None, :], -jnp.inf)
    m_inter = b + m[..., None]
    m_t = jnp.maximum(m_inter, jnp.max(d, axis=-1))
    w = jnp.exp(d - m_t[..., None])
    g_inter = jnp.exp(m_inter - m_t)
    s = jnp.einsum('bhtd,bhsd->bhts', q, k) * w
    num = jnp.einsum('bhts,bhsv->bhtv', s, v) + g_inter[..., None] * jnp.einsum('bhvd,bhtd->bhtv', cmat, q)
    nq = jnp.sum(s, axis=-1) + g_inter * jnp.einsum('bhd,bhtd->bht', nvec, q)
    h = num / jnp.maximum(jnp.abs(nq), jnp.exp(-m_t))[..., None]
    b_end = b[..., -1]
    g = b_end[..., None] - b + li
    m_new = jnp.maximum(b_end + m, jnp.max(g, axis=-1))
    w_end = jnp.exp(g - m_new[..., None])
    decay = jnp.exp(b_end + m - m_new)
    cmat = decay[..., None, None] * cmat + jnp.einsum('bhs,bhsv,bhsd->bhvd', w_end, v, k)
    nvec = decay[..., None] * nvec + jnp.einsum('bhs,bhsd->bhd', w_end, k)
    return (cmat, nvec, m_new), h


def _gla_step(smat, xs):
    q, k, v, la = xs
    ln = q.shape[2]
    tril = jnp.tril(jnp.ones((ln, ln), dtype=bool))
    bc = jnp.cumsum(la, axis=2)
    inter = jnp.einsum('bhtd,bhdv->bhtv', q * jnp.exp(bc), smat)
    rel = jnp.where(tril[:, :, None], bc[:, :, :, None, :] - bc[:, :, None, :, :], -jnp.inf)
    a = jnp.einsum('bhtd,bhtsd,bhsd->bhts', q, jnp.exp(rel), k)
    o = inter + jnp.einsum('bhts,bhsv->bhtv', a, v)
    b_end = bc[:, :, -1]
    smat = jnp.exp(b_end)[..., None] * smat + jnp.einsum('bhsd,bhsv->bhdv', k * jnp.exp(b_end[:, :, None] - bc), v)
    return smat, o


def diff_attention(pl, pc, qn_g, kn_g, lam_p, subln_g, lam_init, rows, cols, with_ctx):
    (ql, kl, vl), (qc, kc, vc) = pl, pc
    bsz, t = ql.shape[:2]
    lc = qc.shape[1]

    def heads(q, k, v, n):
        q = rmsnorm(q.reshape(bsz, n, A_HEADS, 2, A_DK), qn_g)
        k = rmsnorm(k.reshape(bsz, n, A_HEADS, 2, A_DK), kn_g)
        return q, k, v.reshape(bsz, n, A_HEADS, A_DV)

    ql, kl, vl = heads(ql, kl, vl, t)
    ql = axial_rope(ql, rows, cols)
    kl = axial_rope(kl, rows, cols)
    qc, kc, vc = heads(qc, kc, vc, lc)
    lp = lam_p.astype(F32)
    lam = jnp.exp(jnp.sum(lp[0] * lp[1])) - jnp.exp(jnp.sum(lp[2] * lp[3])) + lam_init
    scale = A_DK ** -0.5

    def attend(q, k, v):
        s = jnp.einsum('bqhcd,bkhcd->bhcqk', q, k).astype(F32) * scale
        p = jax.nn.softmax(s, axis=-1)
        a = p[:, :, 0] - lam * p[:, :, 1]
        return jnp.einsum('bhqk,bkhd->bqhd', a, v.astype(F32))

    k_all = jnp.concatenate([kc, kl], axis=1)
    v_all = jnp.concatenate([vc, vl], axis=1)
    nb = t // BLOCK
    qb = jnp.moveaxis(ql.reshape(bsz, nb, BLOCK, A_HEADS, 2, A_DK), 1, 0)
    ol = lax.map(lambda qblk: attend(qblk, k_all, v_all), qb)
    ol = jnp.moveaxis(ol, 0, 1).reshape(bsz, t, A_HEADS, A_DV)

    def finish(o):
        return (rmsnorm(o, subln_g) * (1.0 - lam_init)).reshape(o.shape[0], o.shape[1], A_HEADS * A_DV)

    out_c = finish(attend(qc, kc, vc)) if with_ctx else None
    return finish(ol), out_c


def mlstm_mixer(pl, pc, conv_w, conv_b, gate_b, outn_g, with_ctx):
    def prep(q, k, v, gt, o):
        bsz, t = q.shape[:2]
        qk = jax.nn.silu(short_conv(jnp.concatenate([q, k], axis=-1), conv_w, conv_b))
        q, k = jnp.split(qk, 2, axis=-1)
        th = lambda a: a.reshape(bsz, t, B_HEADS, B_DH).transpose(0, 2, 1, 3).astype(F32)
        pre = gt.reshape(bsz, t, 4, B_HEADS).astype(F32) + gate_b.astype(F32)
        pre = pre.transpose(2, 0, 3, 1)
        base = (th(q), th(k) * B_DH ** -0.5, th(v))
        fwd = base + (pre[0], jax.nn.log_sigmoid(pre[1]))
        bwd = base + (pre[2], jax.nn.log_sigmoid(pre[3]))
        return fwd, bwd, o

    lat_f, lat_b, o_l = prep(*pl)
    ctx_f, ctx_b, o_c = prep(*pc)
    bsz = o_l.shape[0]
    init = (jnp.zeros((bsz, B_HEADS, B_DH, B_DH), F32), jnp.zeros((bsz, B_HEADS, B_DH), F32),
            jnp.zeros((bsz, B_HEADS), F32))
    hl, hc = bidir(_mlstm_step, init, ctx_f, lat_f, ctx_b, lat_b)

    def finish(h, o):
        h = rmsnorm(jnp.swapaxes(h, 1, 2), outn_g)
        return h.reshape(h.shape[0], h.shape[1], B_HEADS * B_DH) * jax.nn.sigmoid(o.astype(F32))

    out_c = finish(hc, o_c) if with_ctx else None
    return finish(hl, o_l), out_c


def gla_mixer(pl, pc, wg, bg, outn_g, with_ctx):
    def prep(q, k, v, lr):
        bsz, t = q.shape[:2]
        th = lambda a, dd: a.reshape(bsz, t, C_HEADS, dd).transpose(0, 2, 1, 3).astype(F32)
        lr = lr.reshape(bsz, t, 2, GLA_RANK).astype(F32)
        la = jax.nn.log_sigmoid(jnp.einsum('btzr,zrk->btzk', lr, wg.astype(F32)) + bg.astype(F32)) / GLA_TAU
        base = (th(q, C_DK) * C_DK ** -0.5, th(k, C_DK), th(v, C_DV))
        return base + (th(la[:, :, 0], C_DK),), base + (th(la[:, :, 1], C_DK),)

    lat_f, lat_b = prep(*pl)
    ctx_f, ctx_b = prep(*pc)
    bsz = pl[0].shape[0]
    init = jnp.zeros((bsz, C_HEADS, C_DK, C_DV), F32)
    hl, hc = bidir(_gla_step, init, ctx_f, lat_f, ctx_b, lat_b)

    def finish(h):
        h = rmsnorm(jnp.swapaxes(h, 1, 2), outn_g)
        return h.reshape(h.shape[0], h.shape[1], C_HEADS * C_DV)

    out_c = finish(hc) if with_ctx else None
    return finish(hl), out_c


def window_gqa(pl, pc, qn_g, kn_g, sink, rows, cols, with_ctx):
    (ql, kl, vl), (qc, kc, vc) = pl, pc
    bsz, t = ql.shape[:2]
    lc = qc.shape[1]
    ql = axial_rope(rmsnorm(ql.reshape(bsz, t, D_KV, D_GROUP, D_HD), qn_g), rows, cols)
    kl = axial_rope(rmsnorm(kl.reshape(bsz, t, D_KV, D_HD), kn_g), rows, cols)
    vl = vl.reshape(bsz, t, D_KV, D_HD)
    qc = rmsnorm(qc.reshape(bsz, lc, D_KV, D_GROUP, D_HD), qn_g)
    kc = rmsnorm(kc.reshape(bsz, lc, D_KV, D_HD), kn_g)
    vc = vc.reshape(bsz, lc, D_KV, D_HD)
    scale = D_HD ** -0.5
    sk = sink.astype(F32).reshape(D_KV, D_GROUP, 1, 1)
    nb = t // BLOCK
    pad = ((0, 0), (WINDOW, WINDOW), (0, 0), (0, 0))
    kb = jnp.pad(kl, pad).reshape(bsz, nb + 2, BLOCK, D_KV, D_HD)
    vb = jnp.pad(vl, pad).reshape(bsz, nb + 2, BLOCK, D_KV, D_HD)
    kw = jnp.concatenate([kb[:, :-2], kb[:, 1:-1], kb[:, 2:]], axis=2)
    vw = jnp.concatenate([vb[:, :-2], vb[:, 1:-1], vb[:, 2:]], axis=2)
    qb = ql.reshape(bsz, nb, BLOCK, D_KV, D_GROUP, D_HD)
    s_loc = jnp.einsum('bnqhgd,bnkhd->bnhgqk', qb, kw).astype(F32) * scale
    a_idx = jnp.arange(BLOCK)[:, None]
    j_idx = jnp.arange(3 * BLOCK)[None, :]
    kpos = jnp.arange(nb)[:, None, None] * BLOCK - WINDOW + j_idx[None]
    band = (j_idx - a_idx >= 0) & (j_idx - a_idx <= 2 * WINDOW)
    valid = band[None] & (kpos >= 0) & (kpos < t)
    s_loc = jnp.where(valid[None, :, None, None], s_loc, -jnp.inf)
    s_ctx = jnp.einsum('bnqhgd,bchd->bnhgqc', qb, kc).astype(F32) * scale
    logits = jnp.concatenate([s_loc, s_ctx, jnp.broadcast_to(sk, s_loc.shape[:-1] + (1,))], axis=-1)
    p = jax.nn.softmax(logits, axis=-1)
    o = (jnp.einsum('bnhgqk,bnkhd->bnqhgd', p[..., :3 * BLOCK], vw.astype(F32))
         + jnp.einsum('bnhgqc,bchd->bnqhgd', p[..., 3 * BLOCK:3 * BLOCK + lc], vc.astype(F32)))
    out_l = o.reshape(bsz, t, D_HEADS * D_HD)
    out_c = None
    if with_ctx:
        s = jnp.einsum('bqhgd,bkhd->bhgqk', qc, kc).astype(F32) * scale
        lg = jnp.concatenate([s, jnp.broadcast_to(sk, s.shape[:-1] + (1,))], axis=-1)
        pc_ = jax.nn.softmax(lg, axis=-1)
        out_c = jnp.einsum('bhgqk,bkhd->bqhgd', pc_[..., :lc], vc.astype(F32)).reshape(bsz, lc, D_HEADS * D_HD)
    return out_l, out_c


def setup_inputs(seed: int = 0) -> dict:
    key = jax.random.key(seed)
    ks = jax.random.split(key, 24)
    nrm = lambda k, shape, s: s * jax.random.normal(k, shape, F32)
    gain = lambda k, shape: 1.0 + 0.1 * jax.random.normal(k, shape, F32)
    f_bias = jnp.linspace(3.0, 6.0, B_HEADS, dtype=F32)
    zb = jnp.zeros((B_HEADS,), F32)
    gate_base = jnp.stack([zb, f_bias, zb, f_bias])
    return {
        'x': nrm(ks[0], (BATCH, SEQ, D_MODEL), 1.0),
        'c': nrm(ks[1], (BATCH, D_MODEL), 1.0),
        'ctx': nrm(ks[2], (BATCH, CTX_LEN, D_MODEL), 1.0),
        'c_ctx': nrm(ks[3], (D_MODEL,), 1.0),
        'w_mod': nrm(ks[4], (DEPTH, D_MODEL, 3 * D_MODEL), 0.5 * D_MODEL ** -0.5),
        'b_mod': nrm(ks[5], (DEPTH, 3 * D_MODEL), 0.02),
        'norm_g': gain(ks[6], (DEPTH, D_MODEL)),
        'w_in': nrm(ks[7], (DEPTH, D_MODEL, N_IN), D_MODEL ** -0.5),
        'w_out': nrm(ks[8], (DEPTH, D_MIX, D_MODEL), D_MIX ** -0.5),
        'a_qn': gain(ks[9], (DEPTH, A_DK)),
        'a_kn': gain(ks[10], (DEPTH, A_DK)),
        'a_lam': nrm(ks[11], (DEPTH, 4, A_DK), 0.1),
        'a_subln': gain(ks[12], (DEPTH, A_DV)),
        'b_conv_w': nrm(ks[13], (DEPTH, CONV_W, 2 * B_HEADS * B_DH), CONV_W ** -0.5),
        'b_conv_b': nrm(ks[14], (DEPTH, 2 * B_HEADS * B_DH), 0.02),
        'b_gate_b': gate_base + nrm(ks[15], (DEPTH, 4, B_HEADS), 0.1),
        'b_outn': gain(ks[16], (DEPTH, B_DH)),
        'c_wg': nrm(ks[17], (DEPTH, 2, GLA_RANK, C_HEADS * C_DK), GLA_RANK ** -0.5),
        'c_bg': nrm(ks[18], (DEPTH, 2, C_HEADS * C_DK), 0.1),
        'c_outn': gain(ks[19], (DEPTH, C_DV)),
        'd_qn': gain(ks[20], (DEPTH, D_HD)),
        'd_kn': gain(ks[21], (DEPTH, D_HD)),
        'd_sink': nrm(ks[22], (DEPTH, D_HEADS), 0.5),
    }


def reference(x, c, ctx, c_ctx, w_mod, b_mod, norm_g, w_in, w_out, a_qn, a_kn, a_lam, a_subln,
              b_conv_w, b_conv_b, b_gate_b, b_outn, c_wg, c_bg, c_outn, d_qn, d_kn, d_sink):
    t = x.shape[1]
    rows_n = t // GRID_W
    rows = jnp.repeat(jnp.arange(rows_n, dtype=jnp.int32), GRID_W)
    cols = jnp.tile(jnp.arange(GRID_W, dtype=jnp.int32), rows_n)
    s_lat = jax.nn.silu(c)
    s_ctx = jax.nn.silu(c_ctx)
    for l in range(DEPTH):
        with_ctx = l < DEPTH - 1
        sh, sc, gt = jnp.split(s_lat @ w_mod[l] + b_mod[l], 3, axis=-1)
        sh_c, sc_c, gt_c = jnp.split(s_ctx @ w_mod[l] + b_mod[l], 3, axis=-1)
        hx = rmsnorm(x, norm_g[l]) * (1.0 + sc[:, None]) + sh[:, None]
        hc = rmsnorm(ctx, norm_g[l]) * (1.0 + sc_c) + sh_c
        px = split_cols(hx @ w_in[l])
        pcx = split_cols(hc @ w_in[l])
        lam_init = 0.8 - 0.6 * math.exp(-0.3 * l)
        a_l, a_c = diff_attention(px[0:3], pcx[0:3], a_qn[l], a_kn[l], a_lam[l], a_subln[l], lam_init,
                                  rows, cols, with_ctx)
        b_l, b_c = mlstm_mixer(px[3:8], pcx[3:8], b_conv_w[l], b_conv_b[l], b_gate_b[l], b_outn[l], with_ctx)
        c_l, c_c = gla_mixer(px[8:12], pcx[8:12], c_wg[l], c_bg[l], c_outn[l], with_ctx)
        d_l, d_c = window_gqa(px[12:15], pcx[12:15], d_qn[l], d_kn[l], d_sink[l], rows, cols, with_ctx)
        y = jnp.concatenate([a_l, b_l, c_l, d_l], axis=-1).astype(x.dtype) * jax.nn.silu(px[15])
        x = x + gt[:, None] * (y @ w_out[l])
        if with_ctx:
            yc = jnp.concatenate([a_c, b_c, c_c, d_c], axis=-1).astype(ctx.dtype) * jax.nn.silu(pcx[15])
            ctx = ctx + gt_c * (yc @ w_out[l])
    return x
```

```cpp
#include <hip/hip_runtime.h>
#include <hip/hip_cooperative_groups.h>
#include <cstdio>
#include <cstdint>
namespace cg = cooperative_groups;
#define DUP_MASK 0
namespace pg8 {
#define PG8_LAS __attribute__((address_space(3)))
typedef unsigned short bf16_t;
typedef short bf16x8 __attribute__((ext_vector_type(8)));
typedef float f32x4 __attribute__((ext_vector_type(4)));
typedef unsigned u32x4 __attribute__((ext_vector_type(4)));
constexpr int BM = 256, BK = 64, HALF = 128, HTB = HALF * BK * 2  , STAGE_BYTES = 8 * HTB, NXCD = 8, WGM = 8;

__host__ __device__ __forceinline__ int lds_byte(int r, int c) { const int st = (r >> 4) * 2 + (c >> 5), rr = r & 15, cc = c & 31, ob = rr * 64 + cc * 2; return st * 1024 + (ob ^ (((ob >> 9) & 1) << 5)); }
__host__ __device__ __forceinline__ void stage_rc(int b, int& R, int& C) { const int st = b / 1024, sb = b % 1024, swz = sb ^ (((sb >> 9) & 1) << 5); R = (st >> 1) * 16 + swz / 64; C = (st & 1) * 32 + (swz % 64) / 2; }
__host__ __device__ __forceinline__ int perm32(int rho) { const int n = rho >> 4, i = rho & 15; return 8 * (i >> 2) + 4 * n + (i & 3); }

struct Unit { int pm, pn; };
struct Gemm { const bf16_t* A; const bf16_t* Bt; int M, N, K; };

struct StaticOrder {
    int nM, nN, nwg, G, c;
    __host__ __device__ void init(int M, int N, int G_, int c_) { nM = M / BM; nN = N / BM; nwg = nM * nN; G = G_; c = c_; }
    __host__ __device__ bool next(int i, Unit& u) const {
        const long L = (long)i * G + c; if (L >= nwg) return false;
        int wgid = (int)L; { const int q = nwg / NXCD, r = nwg % NXCD, xcd = wgid % NXCD, off = wgid / NXCD; wgid = (xcd < r ? xcd * (q + 1) : r * (q + 1) + (xcd - r) * q) + off; }
        const int nig = WGM * nN, gid = wgid / nig, fm = gid * WGM, gsz = (nM - fm) < WGM ? (nM - fm) : WGM;
        u.pm = fm + ((wgid % nig) % gsz); u.pn = (wgid % nig) / gsz; return true;
    }
    __device__ __forceinline__ void a_ready(const Unit&) const {}
    __device__ __forceinline__ void done(const Unit&) const {}
};

__device__ __forceinline__ unsigned cvt_pk_bf16(float lo, float hi) { unsigned r; asm volatile("v_cvt_pk_bf16_f32 %0, %1, %2" : "=v"(r) : "v"(lo), "v"(hi)); return r; }
typedef float f32x2 __attribute__((ext_vector_type(2)));
template <class Epi, class Sched, bool ALIGN_EPI = false, bool SP2 = false>
__device__ __forceinline__ void gemm_phase(PG8_LAS unsigned char* lds, const Gemm g, const Sched& S, const Epi& E) {
    int tid_ = threadIdx.x; asm volatile("" : "+v"(tid_)); const int tid = tid_, wid = __builtin_amdgcn_readfirstlane(tid >> 6), lane = tid & 63, wr = wid >> 2, wc = wid & 3, fr = lane & 15, fq = lane >> 4;
    const int K = g.K, nt = K / BK;
    unsigned voffA[2], voffB[2];
#pragma unroll
    for (int i = 0; i < 2; ++i) { int R, C; stage_rc(tid * 16 + i * 8192, R, C); const int Rb = Epi::PERM ? ((R & ~31) + perm32(R & 31)) : R;
        voffA[i] = (unsigned)(R * K + C) * 2u; voffB[i] = (unsigned)(Rb * K + C) * 2u; }
    const size_t kstep = (size_t)(BK * 2);
    const size_t hstep = (size_t)HALF * K * 2;
    const size_t tstep = 2 * hstep;
    const unsigned ldsw = (unsigned)wid * 1024u;
    const int aoff = lds_byte(wr * 64 + fr, fq * 8), boff = lds_byte(wc * 32 + fr, fq * 8);
#define PG8_SA(b, h) (((b) * 2 + (h)) * HTB)
#define PG8_SB(b, h) ((4 + (b) * 2 + (h)) * HTB)
#define PG8_STAGE(bufoff, gbase, voff) do { _Pragma("unroll") for (int _i = 0; _i < 2; ++_i) \
        __builtin_amdgcn_global_load_lds((const unsigned*)((const char*)(gbase) + (voff)[_i]), (PG8_LAS unsigned*)(lds + (bufoff) + ldsw + _i * 8192), 16, 0, 0); } while (0)
#define PG8_LDA(dst, b, h) do { _Pragma("unroll") for (int m = 0; m < 4; ++m) _Pragma("unroll") for (int k = 0; k < 2; ++k) dst[m][k] = *(const PG8_LAS bf16x8*)(lds + PG8_SA(b, h) + aoff + m * 2048 + k * 1024); } while (0)
#define PG8_LDB(dst, b, h) do { _Pragma("unroll") for (int n = 0; n < 2; ++n) _Pragma("unroll") for (int k = 0; k < 2; ++k) dst[n][k] = *(const PG8_LAS bf16x8*)(lds + PG8_SB(b, h) + boff + n * 2048 + k * 1024); } while (0)
#define PG8_MMA(ai, bj, At, Bt) do { __builtin_amdgcn_s_setprio(1); _Pragma("unroll") for (int m = 0; m < 4; ++m) _Pragma("unroll") for (int n = 0; n < 2; ++n) _Pragma("unroll") for (int k = 0; k < 2; ++k) \
        acc[ai][bj][m][n] = __builtin_amdgcn_mfma_f32_16x16x32_bf16(Bt[n][k], At[m][k], acc[ai][bj][m][n], 0, 0, 0); __builtin_amdgcn_s_setprio(0); } while (0)
#define PG8_WAIT_V(n) asm volatile("s_waitcnt vmcnt(" #n ")" ::: "memory")
#define PG8_WAIT_L(n) asm volatile("s_waitcnt lgkmcnt(" #n ")" ::: "memory")
#define PG8_BAR __builtin_amdgcn_s_barrier()
#define PG8_SCHED __builtin_amdgcn_sched_barrier(0)
    Unit cur, nxt; int ui = 0;
    if (!S.next(0, cur)) return;
    f32x4 acc[2][2][4][2];
#pragma unroll
    for (int a = 0; a < 2; ++a)
#pragma unroll
        for (int b = 0; b < 2; ++b)
#pragma unroll
            for (int m = 0; m < 4; ++m)
#pragma unroll
                for (int n = 0; n < 2; ++n) acc[a][b][m][n] = (f32x4){0.f, 0.f, 0.f, 0.f};
    bf16x8 At[4][2], B0[2][2], B1[2][2];
    const char* cA = (const char*)g.A + (size_t)cur.pm * tstep; const char* cB = (const char*)g.Bt + (size_t)cur.pn * tstep;
    S.a_ready(cur);
    if constexpr (SP2) {
        PG8_STAGE(PG8_SB(0, 0), cB, voffB); PG8_STAGE(PG8_SB(0, 1), cB + hstep, voffB); PG8_STAGE(PG8_SA(0, 0), cA, voffA); PG8_STAGE(PG8_SA(0, 1), cA + hstep, voffA);
        if (wr == 1) PG8_BAR;
        PG8_WAIT_V(2); PG8_BAR;
        PG8_STAGE(PG8_SB(1, 0), cB + kstep, voffB); PG8_STAGE(PG8_SA(1, 0), cA + kstep, voffA); PG8_STAGE(PG8_SB(1, 1), cB + hstep + kstep, voffB);
        PG8_WAIT_V(6); PG8_BAR;
    } else {
        PG8_STAGE(PG8_SB(0, 0), cB, voffB); PG8_STAGE(PG8_SA(0, 0), cA, voffA); PG8_STAGE(PG8_SB(0, 1), cB + hstep, voffB); PG8_STAGE(PG8_SA(0, 1), cA + hstep, voffA);
        if (wr == 1) PG8_BAR;
        PG8_WAIT_V(4); PG8_BAR;
        PG8_STAGE(PG8_SB(1, 0), cB + kstep, voffB); PG8_STAGE(PG8_SA(1, 0), cA + kstep, voffA); PG8_STAGE(PG8_SB(1, 1), cB + hstep + kstep, voffB);
        PG8_WAIT_V(6); PG8_BAR;
    }
    for (;;) {
        const bool has_next = S.next(ui + 1, nxt);
        const char* nA = has_next ? (const char*)g.A + (size_t)nxt.pm * tstep : cA; const char* nB = has_next ? (const char*)g.Bt + (size_t)nxt.pn * tstep : cB;
        for (int t = 0; t < nt; t += 2) {
            const bool last = (t == nt - 2);
            const char* a1 = cA + (size_t)(t + 1) * kstep;
            const char* a2 = last ? nA : cA + (size_t)(t + 2) * kstep; const char* b2 = last ? nB : cB + (size_t)(t + 2) * kstep;
            const char* a3 = a2 + kstep; const char* b3 = b2 + kstep;
            if (last && has_next) S.a_ready(nxt);
            if constexpr (SP2) {
            PG8_LDB(B0, 0, 0); PG8_LDB(B1, 0, 1); PG8_SCHED; PG8_LDA(At, 0, 0); PG8_STAGE(PG8_SA(1, 1), a1 + hstep, voffA);
            PG8_WAIT_V(8); PG8_WAIT_L(0); PG8_BAR; PG8_MMA(0, 0, At, B0); PG8_MMA(0, 1, At, B1); PG8_BAR; PG8_SCHED;
            PG8_LDA(At, 0, 1); PG8_STAGE(PG8_SB(0, 0), b2, voffB); PG8_STAGE(PG8_SB(0, 1), b2 + hstep, voffB); PG8_STAGE(PG8_SA(0, 0), a2, voffA);
            PG8_WAIT_V(8); PG8_WAIT_L(0); PG8_BAR; PG8_MMA(1, 0, At, B0); PG8_MMA(1, 1, At, B1); PG8_BAR; PG8_SCHED;
            PG8_LDB(B0, 1, 0); PG8_LDB(B1, 1, 1); PG8_SCHED; PG8_LDA(At, 1, 0); PG8_STAGE(PG8_SA(0, 1), a2 + hstep, voffA);
            PG8_WAIT_V(8); PG8_WAIT_L(0); PG8_BAR; PG8_MMA(0, 0, At, B0); PG8_MMA(0, 1, At, B1); PG8_BAR; PG8_SCHED;
            PG8_LDA(At, 1, 1); PG8_STAGE(PG8_SB(1, 0), b3, voffB); PG8_STAGE(PG8_SB(1, 1), b3 + hstep, voffB); PG8_STAGE(PG8_SA(1, 0), a3, voffA);
            PG8_WAIT_V(8); PG8_WAIT_L(0); PG8_BAR; PG8_MMA(1, 0, At, B0); PG8_MMA(1, 1, At, B1); PG8_BAR; PG8_SCHED;
            } else {
            PG8_LDB(B0, 0, 0); PG8_SCHED; PG8_LDA(At, 0, 0); PG8_STAGE(PG8_SA(1, 1), a1 + hstep, voffA);
            PG8_WAIT_L(8); PG8_BAR; PG8_WAIT_L(0); PG8_MMA(0, 0, At, B0); PG8_BAR; PG8_SCHED;
            PG8_LDB(B1, 0, 1); PG8_STAGE(PG8_SB(0, 0), b2, voffB);
            PG8_BAR; PG8_WAIT_L(0); PG8_MMA(0, 1, At, B1); PG8_BAR;
            PG8_LDA(At, 0, 1); PG8_STAGE(PG8_SA(0, 0), a2, voffA);
            PG8_BAR; PG8_WAIT_L(0); PG8_MMA(1, 0, At, B0); PG8_BAR; PG8_SCHED;
            PG8_STAGE(PG8_SB(0, 1), b2 + hstep, voffB);
            PG8_WAIT_V(6); PG8_BAR; PG8_MMA(1, 1, At, B1); PG8_BAR;
            PG8_LDB(B0, 1, 0); PG8_SCHED; PG8_LDA(At, 1, 0); PG8_STAGE(PG8_SA(0, 1), a2 + hstep, voffA);
            PG8_WAIT_L(8); PG8_BAR; PG8_WAIT_L(0); PG8_MMA(0, 0, At, B0); PG8_BAR; PG8_SCHED;
            PG8_LDB(B1, 1, 1); PG8_STAGE(PG8_SB(1, 0), b3, voffB);
            PG8_BAR; PG8_WAIT_L(0); PG8_MMA(0, 1, At, B1); PG8_BAR;
            PG8_LDA(At, 1, 1); PG8_STAGE(PG8_SA(1, 0), a3, voffA);
            PG8_BAR; PG8_WAIT_L(0); PG8_MMA(1, 0, At, B0); PG8_BAR; PG8_SCHED;
            PG8_STAGE(PG8_SB(1, 1), b3 + hstep, voffB);
            PG8_WAIT_V(6); PG8_BAR; PG8_MMA(1, 1, At, B1); PG8_BAR;
            }
        }
        if constexpr (ALIGN_EPI) { if (wr == 0) PG8_BAR; }
        if constexpr (!Epi::AFTER_DRAIN) { E(acc, cur, wr, wc, fr, fq); S.done(cur); }
        if (!has_next) break;
#pragma unroll
        for (int a = 0; a < 2; ++a)
#pragma unroll
            for (int b = 0; b < 2; ++b)
#pragma unroll
                for (int m = 0; m < 4; ++m)
#pragma unroll
                    for (int n = 0; n < 2; ++n) acc[a][b][m][n] = (f32x4){0.f, 0.f, 0.f, 0.f};
        cur = nxt; cA = nA; cB = nB; ++ui;
        if constexpr (ALIGN_EPI) { if (wr == 1) PG8_BAR; }
    }
    PG8_WAIT_V(0);
    if constexpr (!ALIGN_EPI) { if (wr == 0) PG8_BAR; }
    PG8_BAR;
    if constexpr (Epi::AFTER_DRAIN) { E.fused(acc, cur, wr, wc, fr, fq, lds, wid, lane); S.done(cur); }
#undef PG8_SA
#undef PG8_SB
#undef PG8_STAGE
#undef PG8_LDA
#undef PG8_LDB
#undef PG8_MMA
#undef PG8_WAIT_V
#undef PG8_WAIT_L
#undef PG8_BAR
#undef PG8_SCHED
}
}

#define DI __device__ __forceinline__
typedef unsigned short bf16;
typedef short bf16x8 __attribute__((ext_vector_type(8)));
typedef float f32x4 __attribute__((ext_vector_type(4)));
typedef float f32x16 __attribute__((ext_vector_type(16)));
typedef unsigned u32x4 __attribute__((ext_vector_type(4)));
typedef unsigned u32x2 __attribute__((ext_vector_type(2)));
typedef __bf16 bf16x2_t __attribute__((ext_vector_type(2)));
typedef float f32x2_t __attribute__((ext_vector_type(2)));
#define MFMA32(a, b, c) __builtin_amdgcn_mfma_f32_32x32x16_bf16((a), (b), (c), 0, 0, 0)

constexpr int NB = 2, T = 8192, LC = 256, TK = 8448, M = NB * TK, D = 1024, NSRC = 3888, NP = 4096, NCH = 132;
constexpr float EPS = 1e-6f, LOG2E = 1.4426950408889634f;
constexpr int LDS_BYTES = 147456;

constexpr size_t MiB = 1u << 20;
constexpr size_t S8 = (size_t)M * 256 * 2, S4 = S8 / 2;
constexpr size_t WS_ARGS = 512 * 1024, WS_XBAR = 64 * 1024;
constexpr size_t WS_MODV = 1 * MiB, WS_TABA = WS_MODV + 131072, WS_TABD = WS_TABA + 8192, WS_MISC = WS_TABD + 16384;
constexpr size_t WS_WIN = 2 * MiB, WS_WOUT = 18 * MiB, WS_CTX = 22 * MiB, WS_HXY = 24 * MiB;
constexpr size_t WS_QA = 57 * MiB, WS_KA = WS_QA + S8, WS_VAT = WS_KA + S8, WS_QB = WS_VAT + S8, WS_KB = WS_QB + S8, WS_VBT = WS_KB + S8, WS_OB = WS_VBT + S8;
constexpr size_t WS_QC = WS_OB + S8, WS_KC = WS_QC + S4, WS_VCT = WS_KC + S4, WS_QD = WS_VCT + S8, WS_KD = WS_QD + S8, WS_VDT = WS_KD + S4, WS_GATE = WS_VDT + S4;
constexpr size_t WS_SMALL = WS_GATE + 4 * S8;
constexpr size_t WS_CST = 184 * MiB, WS_NST = 217 * MiB, WS_SSC = WS_NST + 768 * 1024, WS_SST = 218 * MiB, WS_GD = WS_SST + (size_t)16 * NCH * 2048 * 4;
static_assert(WS_SMALL + (size_t)M * 48 * 4 <= WS_CST, "ws map");
static_assert(WS_CST + (size_t)16 * NCH * 4096 * 4 <= WS_NST, "ws map");
static_assert(WS_GD + (size_t)16 * NCH * 32 * 4 <= 256 * MiB, "ws map");

DI unsigned pk(float lo, float hi) { f32x2_t v = {lo, hi}; bf16x2_t b = __builtin_convertvector(v, bf16x2_t); return __builtin_bit_cast(unsigned, b); }
DI bf16 f2b(float x) { return (bf16)(pk(x, 0.f) & 0xffffu); }
DI float b2f(bf16 x) { return __uint_as_float((unsigned)x << 16); }
DI float bfe(const u32x4& v, int e) { const unsigned w = v[e >> 1]; return __uint_as_float((e & 1) ? (w & 0xffff0000u) : (w << 16)); }
DI float bfe2(const u32x2& v, int e) { const unsigned w = v[e >> 1]; return __uint_as_float((e & 1) ? (w & 0xffff0000u) : (w << 16)); }
DI void st8(bf16* p, const float* v) { u32x4 w; w.x = pk(v[0], v[1]); w.y = pk(v[2], v[3]); w.z = pk(v[4], v[5]); w.w = pk(v[6], v[7]); *(u32x4*)p = w; }
DI void st8g(bf16* p, const float* v) { u32x4 w; w.x = pk(v[0], v[1]); w.y = pk(v[2], v[3]); w.z = pk(v[4], v[5]); w.w = pk(v[6], v[7]); *(__attribute__((address_space(1))) u32x4*)p = w; }
DI void st8t(bf16* p, const float* v) {
#pragma unroll
    for (int e = 0; e < 8; ++e) *(__attribute__((address_space(1))) bf16*)(p + (size_t)e * TK) = f2b(v[e]); }
DI float sigmoid_(float x) { return 1.f / (1.f + __expf(-x)); }
DI float silu_(float x) { return x * sigmoid_(x); }
DI float logsigmoid_(float x) { return fminf(x, 0.f) - log1pf(expf(-fabsf(x))); }
DI int crow(int r, int hi) { return (r & 3) + 8 * (r >> 2) + 4 * hi; }
DI float wave_sum(float v) {
#pragma unroll
    for (int o = 1; o < 64; o <<= 1) v += __shfl_xor(v, o);
    return v; }
DI void getv(const f32x4& a, const f32x4& b, float* v) { v[0] = a[0]; v[1] = a[1]; v[2] = a[2]; v[3] = a[3]; v[4] = b[0]; v[5] = b[1]; v[6] = b[2]; v[7] = b[3]; }
DI bf16x8 ldfrag(const bf16* X, int ld, int r0, int k0, int lane) { return *(const bf16x8*)(X + (r0 + (lane & 31)) * ld + k0 + 8 * (lane >> 5)); }

DI int otid() { int t = threadIdx.x; asm volatile("" : "+v"(t)); return t; }
template <class T> DI T ldg(const T* p) { return *(const __attribute__((address_space(1))) T*)p; }
template <class T> DI void stg(T* p, const T& v) { *(__attribute__((address_space(1))) T*)p = v; }
DI void lbar() { asm volatile("s_waitcnt lgkmcnt(0)" ::: "memory"); __builtin_amdgcn_s_barrier(); asm volatile("" ::: "memory"); }
struct Args { const float* in[23]; float* out; unsigned char* ws; };

DI int srccol(int n) {
    const int tile = n >> 8, p = n & 255;
    if (tile < 6) return n;
    if (tile == 6) return 1552 + p;
    if (tile == 7) return 1808 + p;
    if (tile == 8) return 2064 + p;
    if (tile == 9 || tile == 10) {
        const int hh = (p >> 5) & 3, d = ((p >> 7) << 5) + (p & 31);
        if (tile == 9) return 2352 + hh * 64 + d;
        return hh < 2 ? 2608 + hh * 64 + d : 2736 + (hh - 2) * 64 + d;
    }
    if (tile < 15) return 2864 + (n - 11 * 256);
    if (p < 16) return 1536 + p;
    if (p < 48) return 2320 + (p - 16);
    return -1;
}

DI void transpose_item(const float* W, int Nsrc, bool perm, bf16* WT, int K, int item, int nblk, float* scr, int lane) {
    const int kb = item / nblk, nb = item - kb * nblk, k0 = 64 * kb, n0 = 32 * nb;
    const int n = n0 + (lane & 31); const int sc = perm ? srccol(n) : n;
#pragma unroll 8
    for (int i = 0; i < 32; ++i) { const int kk = 2 * i + (lane >> 5); scr[kk * 33 + (lane & 31)] = sc >= 0 ? W[(size_t)(k0 + kk) * Nsrc + sc] : 0.f; }
    asm volatile("s_waitcnt lgkmcnt(0)" ::: "memory");
    const int c = lane & 7;
#pragma unroll
    for (int j = 0; j < 4; ++j) { const int nn = (lane >> 3) + 8 * j; const float* s = scr + (8 * c) * 33 + nn;
        u32x4 o; o.x = pk(s[0 * 33], s[1 * 33]); o.y = pk(s[2 * 33], s[3 * 33]); o.z = pk(s[4 * 33], s[5 * 33]); o.w = pk(s[6 * 33], s[7 * 33]);
        *(u32x4*)(WT + (size_t)(n0 + nn) * K + k0 + 8 * c) = o; }
    asm volatile("s_waitcnt lgkmcnt(0)" ::: "memory");
}

DI void a_head(float* v, const float* gn, bool rope, const float* tab, int fq, float scale) {
    float ss = 0.f;
#pragma unroll
    for (int e = 0; e < 8; ++e) ss += v[e] * v[e];
    ss += __shfl_xor(ss, 16); ss += __shfl_xor(ss, 32);
    const float rinv = rsqrtf(ss * (1.f / 32.f) + EPS);
#pragma unroll
    for (int e = 0; e < 8; ++e) v[e] *= rinv * gn[e];
    if (rope) {
        const f32x4 ca = ldg((const f32x4*)tab), cb = ldg((const f32x4*)(tab + 4)), sa = ldg((const f32x4*)(tab + 8)), sb = ldg((const f32x4*)(tab + 12));
        float c[8], sn[8]; getv(ca, cb, c); getv(sa, sb, sn);
#pragma unroll
        for (int e = 0; e < 8; ++e) { const float p = __shfl_xor(v[e], 16); v[e] = (fq & 1) ? (p * sn[e] + v[e] * c[e]) : (v[e] * c[e] - p * sn[e]); }
    }
#pragma unroll
    for (int e = 0; e < 8; ++e) v[e] *= scale;
}
DI void d_head(float* v0, float* v1, const float* g0, const float* g1, bool rope, const float* tabr, const float* tabc, int fq, float scale) {
    float ss = 0.f;
#pragma unroll
    for (int e = 0; e < 8; ++e) ss += v0[e] * v0[e] + v1[e] * v1[e];
    ss += __shfl_xor(ss, 16); ss += __shfl_xor(ss, 32);
    const float rinv = rsqrtf(ss * (1.f / 64.f) + EPS);
#pragma unroll
    for (int e = 0; e < 8; ++e) { v0[e] *= rinv * g0[e]; v1[e] *= rinv * g1[e]; }
    if (rope) {
        const int fi = 8 * (fq & 1);
        { const f32x4 ca = ldg((const f32x4*)(tabr + fi)), cb = ldg((const f32x4*)(tabr + fi + 4)), sa = ldg((const f32x4*)(tabr + 16 + fi)), sb = ldg((const f32x4*)(tabr + 16 + fi + 4));
          float c[8], sn[8]; getv(ca, cb, c); getv(sa, sb, sn);
#pragma unroll
          for (int e = 0; e < 8; ++e) { const float p0 = __shfl_xor(v0[e], 32); v0[e] = (fq >= 2) ? (p0 * sn[e] + v0[e] * c[e]) : (v0[e] * c[e] - p0 * sn[e]); } }
        asm volatile("" ::: "memory");
        { const f32x4 ca = ldg((const f32x4*)(tabc + fi)), cb = ldg((const f32x4*)(tabc + fi + 4)), sa = ldg((const f32x4*)(tabc + 16 + fi)), sb = ldg((const f32x4*)(tabc + 16 + fi + 4));
          float c[8], sn[8]; getv(ca, cb, c); getv(sa, sb, sn);
#pragma unroll
          for (int e = 0; e < 8; ++e) { const float p1 = __shfl_xor(v1[e], 32); v1[e] = (fq >= 2) ? (p1 * sn[e] + v1[e] * c[e]) : (v1[e] * c[e] - p1 * sn[e]); } }
    }
#pragma unroll
    for (int e = 0; e < 8; ++e) { v0[e] *= scale; v1[e] *= scale; }
}

struct EpiIn {
    static constexpr bool PERM = true, AFTER_DRAIN = false;
    unsigned char* ws; int l;
    DI void operator()(const pg8::f32x4 (&acc)[2][2][4][2], const pg8::Unit& u, int wr, int wc, int fr_, int fq_) const {
        int fr = fr_, fq = fq_; asm volatile("" : "+v"(fr), "+v"(fq));
        const int b = u.pm >= 33 ? 1 : 0, pmi = u.pm - 33 * b; const bool is_ctx = (pmi == 0);
        const int j00 = pmi * 256 + wr * 64 + fr, pn = u.pn;
        const float* tabA = (const float*)(ws + WS_TABA); const float* tabD = (const float*)(ws + WS_TABD);
        const float* const* IN = (const float* const*)(ws + WS_ARGS);
#define ROWS_BEGIN _Pragma("unroll") for (int ai = 0; ai < 2; ++ai) _Pragma("unroll") for (int m = 0; m < 4; ++m) { \
        float v0[8], v1[8]; getv(acc[ai][0][m][0], acc[ai][0][m][1], v0); getv(acc[ai][1][m][0], acc[ai][1][m][1], v1); \
        const int j = j00 + ai * 128 + m * 16; const size_t mrow = (size_t)b * TK + j; const int t = is_ctx ? 0 : j - LC; (void)mrow; (void)t;
#define ROWS_END asm volatile("" ::: "memory"); }
        if (pn == 0 || pn == 1) {
            const float* gsrc = IN[pn == 0 ? 9 : 10] + l * 32 + 8 * fq;
            const float scale = pn == 0 ? 0.17677669529663687f * LOG2E : 1.f;
            bf16* dstb = (bf16*)(ws + (pn == 0 ? WS_QA : WS_KA));
            ROWS_BEGIN
                const float* tab = tabA + ((fq < 2) ? (t >> 6) : (t & 63)) * 16;
                float gn[8]; getv(ldg((const f32x4*)gsrc), ldg((const f32x4*)(gsrc + 4)), gn);
                a_head(v0, gn, !is_ctx, tab, fq, scale); a_head(v1, gn, !is_ctx, tab, fq, scale);
                { const int gi = wc, h = gi >> 1, c = gi & 1; st8g(dstb + (((b * 4 + h) * TK + j) * 64 + c * 32 + 8 * fq), v0); }
                { const int gi = 4 + wc, h = gi >> 1, c = gi & 1; st8g(dstb + (((b * 4 + h) * TK + j) * 64 + c * 32 + 8 * fq), v1); }
            ROWS_END
        } else if (pn == 2 || pn == 5 || pn == 8) {
            bf16* dstb = (bf16*)(ws + (pn == 2 ? WS_VAT : (pn == 5 ? WS_VBT : WS_VCT)));
            const int dv0 = (wc & 1) * 32 + 8 * fq;
            ROWS_BEGIN
                st8t(dstb + ((size_t)(b * 4 + (wc >> 1)) * 64 + dv0) * TK + j, v0);
                st8t(dstb + ((size_t)(b * 4 + 2 + (wc >> 1)) * 64 + dv0) * TK + j, v1);
            ROWS_END
        } else if (pn == 3 || pn == 4 || pn == 6) {
            bf16* dstb = (bf16*)(ws + (pn == 3 ? WS_QB : (pn == 4 ? WS_KB : WS_OB)));
            const int c0 = wc * 32 + 8 * fq;
            ROWS_BEGIN
                if (pn == 6) {
#pragma unroll
                    for (int e = 0; e < 8; ++e) { v0[e] = sigmoid_(v0[e]); v1[e] = sigmoid_(v1[e]); } }
                st8g(dstb + mrow * 256 + c0, v0); st8g(dstb + mrow * 256 + 128 + c0, v1);
            ROWS_END
        } else if (pn == 7) {
            bf16* dq = (bf16*)(ws + WS_QC); bf16* dk = (bf16*)(ws + WS_KC); const int c0 = wc * 32 + 8 * fq;
            ROWS_BEGIN
#pragma unroll
                for (int e = 0; e < 8; ++e) v0[e] *= 0.17677669529663687f;
                st8g(dq + mrow * 128 + c0, v0); st8g(dk + mrow * 128 + c0, v1);
            ROWS_END
        } else if (pn == 9) {
            bf16* dstb = (bf16*)(ws + WS_QD); const float* d_qn = IN[20] + l * 64;
            ROWS_BEGIN
                float g0[8], g1[8]; getv(ldg((const f32x4*)(d_qn + 8 * fq)), ldg((const f32x4*)(d_qn + 8 * fq + 4)), g0); getv(ldg((const f32x4*)(d_qn + 32 + 8 * fq)), ldg((const f32x4*)(d_qn + 36 + 8 * fq)), g1);
                d_head(v0, v1, g0, g1, !is_ctx, tabD + (t >> 6) * 32, tabD + (t & 63) * 32, fq, 0.125f * LOG2E);
                bf16* p = dstb + ((((b * 2 + (wc >> 1)) * 2 + (wc & 1)) * TK + j) * 64 + 8 * fq);
                st8g(p, v0); st8g(p + 32, v1);
            ROWS_END
        } else if (pn == 10) {
            if (wc < 2) {
                bf16* dstb = (bf16*)(ws + WS_KD); const float* d_kn = IN[21] + l * 64;
                ROWS_BEGIN
                    float g0[8], g1[8]; getv(ldg((const f32x4*)(d_kn + 8 * fq)), ldg((const f32x4*)(d_kn + 8 * fq + 4)), g0); getv(ldg((const f32x4*)(d_kn + 32 + 8 * fq)), ldg((const f32x4*)(d_kn + 36 + 8 * fq)), g1);
                    d_head(v0, v1, g0, g1, !is_ctx, tabD + (t >> 6) * 32, tabD + (t & 63) * 32, fq, 1.f);
                    bf16* p = dstb + (((b * 2 + wc) * TK + j) * 64 + 8 * fq);
                    st8g(p, v0); st8g(p + 32, v1);
                ROWS_END
            } else {
                bf16* dstb = (bf16*)(ws + WS_VDT);
                ROWS_BEGIN
                    bf16* p = dstb + ((size_t)(b * 2 + (wc - 2)) * 64 + 8 * fq) * TK + j;
                    st8t(p, v0); st8t(p + (size_t)32 * TK, v1);
                ROWS_END
            }
        } else if (pn < 15) {
            bf16* dstb = (bf16*)(ws + WS_GATE); const int c0 = (pn - 11) * 256 + wc * 32 + 8 * fq;
            ROWS_BEGIN
#pragma unroll
                for (int e = 0; e < 8; ++e) { v0[e] = silu_(v0[e]); v1[e] = silu_(v1[e]); }
                st8g(dstb + mrow * 1024 + c0, v0); st8g(dstb + mrow * 1024 + 128 + c0, v1);
            ROWS_END
        } else {
            float* dstb = (float*)(ws + WS_SMALL); const int p0 = wc * 32 + 8 * fq; const float* gate_b = IN[15] + l * 16;
            if (p0 < 48) {
                ROWS_BEGIN
                    if (p0 < 16) {
#pragma unroll
                        for (int e = 0; e < 8; ++e) { const int p = p0 + e, type = p >> 2; float x = v0[e] + ldg(gate_b + p); if (type & 1) x = logsigmoid_(x); v0[e] = x; } }
                    float* o = dstb + mrow * 48 + p0;
                    stg((f32x4*)o, (f32x4){v0[0], v0[1], v0[2], v0[3]}); stg((f32x4*)(o + 4), (f32x4){v0[4], v0[5], v0[6], v0[7]});
                ROWS_END
            }
        }
    }
};

struct EpiOut {
    static constexpr bool PERM = true, AFTER_DRAIN = false;
    const float* xsrc; const float* csrc; float* xdst; float* cdst; const float* modv;
    DI void operator()(const pg8::f32x4 (&acc)[2][2][4][2], const pg8::Unit& u, int wr, int wc, int fr_, int fq_) const {
        int fr = fr_, fq = fq_; asm volatile("" : "+v"(fr), "+v"(fq));
        const int b = u.pm >= 33 ? 1 : 0, pmi = u.pm - 33 * b; const bool is_ctx = (pmi == 0);
        const int j00 = pmi * 256 + wr * 64 + fr, col0 = u.pn * 256 + wc * 32 + 8 * fq;
        const float* gt = modv + (is_ctx ? 2 : b) * 3072 + 2048 + col0;
        f32x4 g[2][2];
#pragma unroll
        for (int bj = 0; bj < 2; ++bj) { g[bj][0] = ldg((const f32x4*)(gt + bj * 128)); g[bj][1] = ldg((const f32x4*)(gt + bj * 128 + 4)); }
#pragma unroll
        for (int ai = 0; ai < 2; ++ai)
#pragma unroll
            for (int m = 0; m < 4; ++m) {
                const int j = j00 + ai * 128 + m * 16;
                const size_t off = (is_ctx ? (size_t)(b * LC + j) : (size_t)(b * T + j - LC)) * D + col0;
                const float* s = (is_ctx ? csrc : xsrc) + off; float* d = (is_ctx ? cdst : xdst) + off;
#pragma unroll
                for (int bj = 0; bj < 2; ++bj) {
                    const f32x4 r0 = ldg((const f32x4*)(s + bj * 128)), r1 = ldg((const f32x4*)(s + bj * 128 + 4));
                    stg((f32x4*)(d + bj * 128), (f32x4)(r0 + g[bj][0] * acc[ai][bj][m][0]));
                    stg((f32x4*)(d + bj * 128 + 4), (f32x4)(r1 + g[bj][1] * acc[ai][bj][m][1]));
                }
            }
    }
};
struct LatOrder {
    pg8::StaticOrder so;
    DI bool next(int i, pg8::Unit& u) const { if (!so.next(i, u)) return false; u.pm += 1 + (u.pm >= 32 ? 1 : 0); return true; }
    DI void a_ready(const pg8::Unit&) const {}
    DI void done(const pg8::Unit&) const {}
};

constexpr int KS_LD = 72, VS_LD = 68, KS_BYTES = 64 * KS_LD * 2, VS_BYTES = 64 * VS_LD * 2;
template <int MODE>
DI void attn_core(unsigned char* lds, const bf16* qrow, const bf16* Kb, const bf16* Vt, int n1, int js, int nt, int qpos, float negM,
                  f32x16 (&O)[MODE == 0 ? 2 : 1][2], float (&lsum)[MODE == 0 ? 2 : 1]) {
    constexpr int NC = MODE == 0 ? 2 : 1, KS = MODE == 0 ? 2 : 4;
    const int tid = otid(), lane = tid & 63, l32 = lane & 31, hi = lane >> 5;
    bf16* Ksm = (bf16*)lds; bf16* Vsm = (bf16*)(lds + 2 * KS_BYTES);
    bf16x8 qf[NC][KS];
#pragma unroll
    for (int c = 0; c < NC; ++c)
#pragma unroll
        for (int ks = 0; ks < KS; ++ks) qf[c][ks] = ldg((const bf16x8*)(qrow + c * (KS * 16) + 16 * ks + 8 * hi));
#pragma unroll
    for (int c = 0; c < NC; ++c) { lsum[c] = 0.f;
#pragma unroll
        for (int d = 0; d < 2; ++d)
#pragma unroll
            for (int i = 0; i < 16; ++i) O[c][d][i] = 0.f; }
    const int lr = tid >> 3, lc = (tid & 7) * 8;
    f32x16 L1;
#pragma unroll
    for (int i = 0; i < 16; ++i) L1[i] = 0.f;
    f32x16 L0;
#pragma unroll
    for (int i = 0; i < 16; ++i) L0[i] = 0.f;
    const bf16x8 ones = (bf16x8){0x3F80, 0x3F80, 0x3F80, 0x3F80, 0x3F80, 0x3F80, 0x3F80, 0x3F80};
    f32x16 CNEG;
#pragma unroll
    for (int i = 0; i < 16; ++i) CNEG[i] = negM;
    asm volatile("" : "+v"(CNEG));
    u32x4 kreg, vreg;
    { const int j0 = (0 < n1) ? 0 : js;
      kreg = ldg((const u32x4*)(Kb + (size_t)(j0 + lr) * 64 + lc)); vreg = ldg((const u32x4*)(Vt + (size_t)lr * TK + j0 + lc));
      *(u32x4*)(Ksm + lr * KS_LD + lc) = kreg; *(u32x2*)(Vsm + lr * VS_LD + lc) = (u32x2){vreg.x, vreg.y}; *(u32x2*)(Vsm + lr * VS_LD + lc + 4) = (u32x2){vreg.z, vreg.w}; }
    lbar();
    for (int it = 0; it < nt; ++it) {
        const int buf = it & 1; const int j0 = (it < n1) ? 64 * it : js + 64 * (it - n1);
        const bool more = (it + 1 < nt);
        if (more) { const int jn = (it + 1 < n1) ? 64 * (it + 1) : js + 64 * (it + 1 - n1);
            kreg = ldg((const u32x4*)(Kb + (size_t)(jn + lr) * 64 + lc)); vreg = ldg((const u32x4*)(Vt + (size_t)lr * TK + jn + lc)); }
        const bf16* Kc = Ksm + buf * (64 * KS_LD); const bf16* Vc = Vsm + buf * (64 * VS_LD);
        const bool masked = (MODE == 1) && (it >= n1);
#pragma unroll
        for (int kb = 0; kb < 2; ++kb) {
            bf16x8 pf[NC][2];
#pragma unroll
            for (int c = 0; c < NC; ++c) {
                f32x16 S;
#pragma unroll
                for (int ks = 0; ks < KS; ++ks) { const bf16x8 a = *(const bf16x8*)(Kc + (32 * kb + l32) * KS_LD + c * (KS * 16) + 16 * ks + 8 * hi); S = MFMA32(a, qf[c][ks], ks == 0 ? CNEG : S); }
                float p[16];
#pragma unroll
                for (int i = 0; i < 16; ++i) p[i] = __builtin_amdgcn_exp2f(S[i]);
                if (MODE == 1) { if (masked) { const int kp0 = j0 - LC + 32 * kb + 4 * hi - qpos;
#pragma unroll
                    for (int i = 0; i < 16; ++i) { const int dlt = kp0 + (i & 3) + 8 * (i >> 2); p[i] = (dlt >= -128 && dlt <= 128) ? p[i] : 0.f; } } }
                if (c != 0) { float ps = 0.f;
#pragma unroll
                    for (int i = 8; i < 16; ++i) ps += p[i];
                    lsum[c] += ps; }
#pragma unroll
                for (int s = 0; s < 2; ++s) { u32x4 w; w.x = pk(p[8 * s], p[8 * s + 1]); w.y = pk(p[8 * s + 2], p[8 * s + 3]); w.z = pk(p[8 * s + 4], p[8 * s + 5]); w.w = pk(p[8 * s + 6], p[8 * s + 7]); pf[c][s] = __builtin_bit_cast(bf16x8, w); }
            }
#pragma unroll
            for (int dvb = 0; dvb < 2; ++dvb)
#pragma unroll
                for (int s = 0; s < 2; ++s) {
                    const bf16* vp = Vc + (32 * dvb + l32) * VS_LD + 32 * kb + 16 * s + 4 * hi;
                    const u32x2 lo = *(const u32x2*)vp, hh = *(const u32x2*)(vp + 8);
                    const bf16x8 va = __builtin_bit_cast(bf16x8, (u32x4){lo.x, lo.y, hh.x, hh.y});
#pragma unroll
                    for (int c = 0; c < NC; ++c) O[c][dvb] = MFMA32(va, pf[c][s], O[c][dvb]);
                    if (dvb == 0) L0 = MFMA32(ones, pf[0][s], L0);
                    if (dvb == 1 && s == 0 && NC == 2) L1 = MFMA32(ones, pf[NC - 1][0], L1);
                }
        }
        if (more) { bf16* Kn = Ksm + (buf ^ 1) * (64 * KS_LD); bf16* Vn = Vsm + (buf ^ 1) * (64 * VS_LD);
            *(u32x4*)(Kn + lr * KS_LD + lc) = kreg; *(u32x2*)(Vn + lr * VS_LD + lc) = (u32x2){vreg.x, vreg.y}; *(u32x2*)(Vn + lr * VS_LD + lc + 4) = (u32x2){vreg.z, vreg.w}; }
        lbar();
    }
    lsum[0] = 0.5f * L0[0];
    if (NC == 2) lsum[NC - 1] += 0.5f * L1[0];
}

DI void attnA_unit(unsigned char* lds, unsigned char* ws, int u, const float* subln, const float* misc) {
    const int tid = otid(), lane = tid & 63, wave = tid >> 6, l32 = lane & 31, hi = lane >> 5;
    int bh, jq0, nt;
    if (u < 256) { bh = u & 7; jq0 = LC + 256 * (u >> 3); nt = TK / 64; } else { bh = u - 256; jq0 = 0; nt = LC / 64; }
    const int b = bh >> 2, h = bh & 3, jq = jq0 + 32 * wave + l32;
    const bf16* qrow = (const bf16*)(ws + WS_QA) + ((size_t)bh * TK + jq) * 64;
    const bf16* Kb = (const bf16*)(ws + WS_KA) + (size_t)bh * TK * 64;
    const bf16* Vt = (const bf16*)(ws + WS_VAT) + (size_t)bh * 64 * TK;
    f32x16 O[2][2]; float lsum[2];
    attn_core<0>(lds, qrow, Kb, Vt, nt, 0, nt, 0, -misc[2], O, lsum);
    const float lam = misc[0], lam_init = misc[1];
    const float l0 = lsum[0] + __shfl_xor(lsum[0], 32), l1 = lsum[1] + __shfl_xor(lsum[1], 32);
    const float i0 = 1.f / l0, i1 = lam / l1;
    float ss = 0.f;
#pragma unroll
    for (int d = 0; d < 2; ++d)
#pragma unroll
        for (int i = 0; i < 16; ++i) { const float a = O[0][d][i] * i0 - O[1][d][i] * i1; O[0][d][i] = a; ss += a * a; }
    ss += __shfl_xor(ss, 32);
    const float rinv = rsqrtf(ss * (1.f / 64.f) + EPS) * (1.f - lam_init);
    const size_t mrow = (size_t)b * TK + jq;
    const bf16* gate = (const bf16*)(ws + WS_GATE) + mrow * 1024 + h * 64;
    bf16* y = (bf16*)(ws + WS_HXY) + mrow * 1024 + h * 64;
#pragma unroll
    for (int d = 0; d < 2; ++d)
#pragma unroll
        for (int g = 0; g < 4; ++g) {
            const int dv = 32 * d + 8 * g + 4 * hi;
            const u32x2 gg = ldg((const u32x2*)(gate + dv)); const f32x4 sb = ldg((const f32x4*)(subln + dv));
            u32x2 o; o.x = pk(O[0][d][4 * g] * rinv * sb[0] * bfe2(gg, 0), O[0][d][4 * g + 1] * rinv * sb[1] * bfe2(gg, 1));
            o.y = pk(O[0][d][4 * g + 2] * rinv * sb[2] * bfe2(gg, 2), O[0][d][4 * g + 3] * rinv * sb[3] * bfe2(gg, 3));
            stg((u32x2*)(y + dv), o);
        }
}

DI void attnD_unit(unsigned char* lds, unsigned char* ws, int u, const float* sink, const float* misc) {
    const int tid = otid(), lane = tid & 63, wave = tid >> 6, l32 = lane & 31, hi = lane >> 5;
    int b, kv, jq0, n1 = LC / 64, js = 0, nt = LC / 64, qpos = 0;
    if (u < 256) { const int x = u & 7; b = x >> 2; kv = (x >> 1) & 1; const int qblk = (x & 1) * 32 + (u >> 3), q0 = qblk * 128;
        jq0 = LC + q0; const int p0 = q0 - 128 < 0 ? 0 : q0 - 128, p1 = q0 + 256 > T ? T : q0 + 256; js = LC + p0; nt = n1 + (p1 - p0) / 64; qpos = q0 + 32 * (wave & 3) + l32; }
    else { const int x = u - 256; b = x >> 2; kv = (x >> 1) & 1; jq0 = 128 * (x & 1); }
    const int g = wave >> 2, jq = jq0 + 32 * (wave & 3) + l32;
    const bf16* qrow = (const bf16*)(ws + WS_QD) + ((size_t)((b * 2 + kv) * 2 + g) * TK + jq) * 64;
    const bf16* Kb = (const bf16*)(ws + WS_KD) + (size_t)(b * 2 + kv) * TK * 64;
    const bf16* Vt = (const bf16*)(ws + WS_VDT) + (size_t)(b * 2 + kv) * 64 * TK;
    f32x16 O[1][2]; float lsum[1];
    attn_core<1>(lds, qrow, Kb, Vt, n1, js, nt, qpos, -misc[3], O, lsum);
    const float l = lsum[0] + __shfl_xor(lsum[0], 32) + __builtin_amdgcn_exp2f(sink[kv * 2 + g] * LOG2E - misc[3]);
    const float inv = 1.f / l;
    const size_t mrow = (size_t)b * TK + jq; const int hc = 768 + (kv * 2 + g) * 64;
    const bf16* gate = (const bf16*)(ws + WS_GATE) + mrow * 1024 + hc;
    bf16* y = (bf16*)(ws + WS_HXY) + mrow * 1024 + hc;
#pragma unroll
    for (int d = 0; d < 2; ++d)
#pragma unroll
        for (int gq = 0; gq < 4; ++gq) {
            const int dv = 32 * d + 8 * gq + 4 * hi;
            const u32x2 gg = ldg((const u32x2*)(gate + dv));
            u32x2 o; o.x = pk(O[0][d][4 * gq] * inv * bfe2(gg, 0), O[0][d][4 * gq + 1] * inv * bfe2(gg, 1));
            o.y = pk(O[0][d][4 * gq + 2] * inv * bfe2(gg, 2), O[0][d][4 * gq + 3] * inv * bfe2(gg, 3));
            stg((u32x2*)(y + dv), o);
        }
}

DI int ord_cidx(int dir, int step) { return dir == 0 ? step : (step < 4 ? 3 - step : 135 - step); }
constexpr int LD64 = 72, LD32 = 40, HLD = 68;
constexpr int WC_OFF = 110592, WC_CW = 0, WC_CB = 1536, WC_BON = 2048, WC_CON = 2112, WC_WG = 2176, WC_BG = 6272, WC_N = 6528;
DI void fill_wcache(unsigned char* lds, const float* const* IN, int l) {
    float* WC = (float*)(lds + WC_OFF); const int tid = otid();
    const float* cw = IN[13] + l * 1536; const float* cb = IN[14] + l * 512; const float* bo = IN[16] + l * 64; const float* co = IN[19] + l * 64; const float* wg = IN[17] + l * 4096; const float* bg = IN[18] + l * 256;
    for (int i = tid; i < WC_N; i += 512) { float v;
        if (i < WC_CB) v = ldg(cw + i); else if (i < WC_BON) v = ldg(cb + i - WC_CB); else if (i < WC_CON) v = ldg(bo + i - WC_BON); else if (i < WC_WG) v = ldg(co + i - WC_CON);
        else if (i < WC_BG) v = ldg(wg + i - WC_WG); else v = ldg(bg + i - WC_BG);
        WC[i] = v; }
    lbar();
}

struct ScanPtrs { float *CST, *NST, *SB, *SG, *SM, *SST, *GD; };
DI ScanPtrs scan_ptrs(unsigned char* ws) { ScanPtrs p; p.CST = (float*)(ws + WS_CST); p.NST = (float*)(ws + WS_NST); p.SB = (float*)(ws + WS_SSC); p.SG = p.SB + 16 * NCH; p.SM = p.SG + 16 * NCH;
    p.SST = (float*)(ws + WS_SST); p.GD = (float*)(ws + WS_GD); return p; }


DI float wscan_add(float v, int lane, bool rev) {
#pragma unroll
    for (int off = 1; off < 64; off <<= 1) { const float t = rev ? __shfl_down(v, off) : __shfl_up(v, off); const bool ok = rev ? (lane + off < 64) : (lane >= off); v += ok ? t : 0.f; }
    return v; }
DI float wscan_max(float v, int lane, bool rev) {
#pragma unroll
    for (int off = 1; off < 64; off <<= 1) { const float t = rev ? __shfl_down(v, off) : __shfl_up(v, off); const bool ok = rev ? (lane + off < 64) : (lane >= off); v = ok ? fmaxf(v, t) : v; }
    return v; }
DI float wave_max(float v) {
#pragma unroll
    for (int o = 1; o < 64; o <<= 1) v = fmaxf(v, __shfl_xor(v, o));
    return v; }

DI void conv8r(const u32x4& pv, const u32x4& c, const u32x4& nv, const float* w  , const float* cb, float mul, float* o) {
    float w0[8], w1[8], w2[8], bb[8];
    getv(*(const f32x4*)w, *(const f32x4*)(w + 4), w0); getv(*(const f32x4*)(w + 512), *(const f32x4*)(w + 516), w1);
    getv(*(const f32x4*)(w + 1024), *(const f32x4*)(w + 1028), w2); getv(*(const f32x4*)cb, *(const f32x4*)(cb + 4), bb);
#pragma unroll
    for (int e = 0; e < 8; ++e) { const float y = w0[e] * bfe(pv, e) + w1[e] * bfe(c, e) + w2[e] * bfe(nv, e) + bb[e]; o[e] = silu_(y) * mul; }
}
DI void load3(const bf16* p, bool hasp, bool hasn, u32x4& pv, u32x4& c, u32x4& nv) {
    c = ldg((const u32x4*)p); pv = (u32x4){0u, 0u, 0u, 0u}; nv = pv;
    if (hasp) pv = ldg((const u32x4*)(p - 256));
    if (hasn) nv = ldg((const u32x4*)(p + 256));
}

struct MaPre { float lf, li; u32x4 kp, kc, kn, vraw; };
DI MaPre mlstm_a_load(unsigned char* ws, int tsk) {
    const int bh = tsk / NCH, cidx = tsk - bh * NCH, b = bh >> 2, h = bh & 3, tid = otid();
    const size_t m0 = (size_t)b * TK + cidx * 64; MaPre p; p.lf = 0.f; p.li = 0.f;
    if (tid < 128) { const int dir = tid >> 6, s = tid & 63; const float* sm = (const float*)(ws + WS_SMALL) + (m0 + s) * 48; p.lf = ldg(sm + (2 * dir + 1) * 4 + h); p.li = ldg(sm + (2 * dir) * 4 + h); }
    const int s = tid >> 3, d0 = (tid & 7) * 8;
    const bool hasp = (s > 0) || (cidx != 0 && cidx != 4), hasn = (s < 63) || (cidx != 3 && cidx != NCH - 1);
    load3((const bf16*)(ws + WS_KB) + (m0 + s) * 256 + h * 64 + d0, hasp, hasn, p.kp, p.kc, p.kn);
    p.vraw = ldg((const u32x4*)((const bf16*)(ws + WS_VBT) + ((size_t)bh * 64 + s) * TK + cidx * 64 + d0));
    return p;
}
DI void mlstm_a_run(unsigned char* lds, unsigned char* ws, int tsk, const MaPre& p, const float* conv_w, const float* conv_b) {
    const int bh = tsk / NCH, cidx = tsk - bh * NCH, h = bh & 3;
    const int tid = otid(), lane = tid & 63, wave = tid >> 6; const ScanPtrs sp = scan_ptrs(ws);
    bf16* KT = (bf16*)lds; bf16* VW = (bf16*)(lds + 9216); float* WE = (float*)(lds + 27648);
    if (wave < 2) { const int dir = wave; const float tot = wave_sum(p.lf), pre = wscan_add(p.lf, lane, false);
        const float g = (dir == 0 ? tot - pre : pre - p.lf) + p.li; const float G = wave_max(g);
        WE[dir * 64 + lane] = expf(g - G);
        if (lane == 0) { stg(sp.SB + (bh * 2 + dir) * NCH + cidx, tot); stg(sp.SG + (bh * 2 + dir) * NCH + cidx, G); } }
    { const int s = tid >> 3, d0 = (tid & 7) * 8; float kv[8];
      conv8r(p.kp, p.kc, p.kn, conv_w + 256 + h * 64 + d0, conv_b + 256 + h * 64 + d0, 0.125f, kv);
#pragma unroll
      for (int e = 0; e < 8; ++e) KT[(d0 + e) * LD64 + s] = f2b(kv[e]); }
    lbar();
    { const int v = tid >> 3, s0 = (tid & 7) * 8;
#pragma unroll
      for (int dir = 0; dir < 2; ++dir) { float o[8];
#pragma unroll
          for (int e = 0; e < 8; ++e) o[e] = bfe(p.vraw, e) * WE[dir * 64 + s0 + e];
          st8(VW + dir * (64 * LD64) + v * LD64 + s0, o); } }
    { const int o = tid >> 2, part = tid & 3, dir = o >> 6, d = o & 63; float a = 0.f;
#pragma unroll
      for (int q = 0; q < 16; ++q) { const int s = part * 16 + q; a += WE[dir * 64 + s] * b2f(KT[d * LD64 + s]); }
      a += __shfl_xor(a, 1); a += __shfl_xor(a, 2);
      if (part == 0) stg(sp.NST + ((size_t)(bh * 2 + dir) * NCH + cidx) * 64 + d, a); }
    lbar();
    { const int dir = wave >> 2, tr = (wave >> 1) & 1, tc = wave & 1, l32 = lane & 31, hi = lane >> 5;
      f32x16 acc;
#pragma unroll
      for (int i = 0; i < 16; ++i) acc[i] = 0.f;
#pragma unroll
      for (int ks = 0; ks < 4; ++ks) acc = MFMA32(ldfrag(VW + dir * (64 * LD64), LD64, 32 * tr, 16 * ks, lane), ldfrag(KT, LD64, 32 * tc, 16 * ks, lane), acc);
      float* dst = sp.CST + ((size_t)(bh * 2 + dir) * NCH + cidx) * 4096;
#pragma unroll
      for (int i = 0; i < 16; ++i) stg(dst + (32 * tr + crow(i, hi)) * 64 + 32 * tc + l32, acc[i]); }
    lbar();
}

struct GlPre { f32x4 lr[4]; u32x4 kraw, qraw, vraw; };
DI GlPre gla_load(unsigned char* ws, int tsk, bool need_q) {
    const int bh = tsk / NCH, cidx = tsk - bh * NCH, b = bh >> 2, h = bh & 3, tid = otid(), lane = tid & 63, wave = tid >> 6, z = wave >> 2, dg = wave & 3;
    const size_t m0 = (size_t)b * TK + cidx * 64; GlPre p;
    const float* sm = (const float*)(ws + WS_SMALL) + (m0 + lane) * 48 + 16 + z * 16;
#pragma unroll
    for (int q = 0; q < 4; ++q) p.lr[q] = ldg((const f32x4*)(sm + 4 * q));
    p.kraw = ldg((const u32x4*)((const bf16*)(ws + WS_KC) + (m0 + lane) * 128 + h * 32 + dg * 8));
    p.qraw = (u32x4){0u, 0u, 0u, 0u}; if (need_q) p.qraw = ldg((const u32x4*)((const bf16*)(ws + WS_QC) + (m0 + lane) * 128 + h * 32 + dg * 8));
    p.vraw = ldg((const u32x4*)((const bf16*)(ws + WS_VCT) + ((size_t)bh * 64 + (tid >> 3)) * TK + cidx * 64 + (tid & 7) * 8));
    return p;
}
DI void gla_bc(const GlPre& p, int h, int z, int dg, int lane, const float* wg, const float* bg, float* bc) {
    const float* wgp = wg + (z * 16) * 128 + h * 32 + dg * 8;
#pragma unroll
    for (int e = 0; e < 8; ++e) bc[e] = bg[z * 128 + h * 32 + dg * 8 + e];
#pragma unroll
    for (int r = 0; r < 16; ++r) { const float lr = p.lr[r >> 2][r & 3];
#pragma unroll
        for (int e = 0; e < 8; ++e) bc[e] += lr * wgp[r * 128 + e]; }
#pragma unroll
    for (int e = 0; e < 8; ++e) bc[e] = wscan_add((fminf(bc[e], 0.f) - __logf(1.f + __expf(-fabsf(bc[e])))) * (1.f / 16.f), lane, z == 1);
}
DI void gla_a_run(unsigned char* lds, unsigned char* ws, int tsk, const GlPre& p, const float* wg, const float* bg) {
    const int bh = tsk / NCH, cidx = tsk - bh * NCH, h = bh & 3;
    const int tid = otid(), lane = tid & 63, wave = __builtin_amdgcn_readfirstlane(tid >> 6), z = wave >> 2, dg = wave & 3; const ScanPtrs sp = scan_ptrs(ws);
    bf16* KH = (bf16*)lds; bf16* VT = (bf16*)(lds + 9216);
    float bc[8]; gla_bc(p, h, z, dg, lane, wg, bg, bc);
#pragma unroll
    for (int e = 0; e < 8; ++e) { const float bend = __shfl(bc[e], z == 0 ? 63 : 0);
        KH[z * (32 * LD64) + (dg * 8 + e) * LD64 + lane] = f2b(bfe(p.kraw, e) * expf(bend - bc[e]));
        if (lane == 0) stg(sp.GD + ((size_t)(bh * 2 + z) * NCH + cidx) * 32 + dg * 8 + e, expf(bend)); }
    *(u32x4*)(VT + (tid >> 3) * LD64 + (tid & 7) * 8) = p.vraw;
    lbar();
    if (wave < 4) { const int zz = wave >> 1, vc = wave & 1, l32 = lane & 31, hi = lane >> 5;
      f32x16 acc;
#pragma unroll
      for (int i = 0; i < 16; ++i) acc[i] = 0.f;
#pragma unroll
      for (int ks = 0; ks < 4; ++ks) acc = MFMA32(ldfrag(KH + zz * (32 * LD64), LD64, 0, 16 * ks, lane), ldfrag(VT, LD64, 32 * vc, 16 * ks, lane), acc);
      float* dst = sp.SST + ((size_t)(bh * 2 + zz) * NCH + cidx) * 2048;
#pragma unroll
      for (int i = 0; i < 16; ++i) stg(dst + crow(i, hi) * 64 + 32 * vc + l32, acc[i]); }
    lbar();
}
DI void scan_b(unsigned char* lds, unsigned char* ws, int t) {
    const int tid = otid(); const ScanPtrs sp = scan_ptrs(ws);
    float* DEC = (float*)lds; float* SCL = DEC + 256; float* XA = SCL + 256; float* XB = XA + 256; float* GS = XB + 256; float* BS = GS + 256; float* GDs = (float*)lds;
    if (t < 144) {
        const int scan = t < 128 ? (t >> 3) : (t - 128), dir = scan & 1;
        float bv = 0.f, gv = 0.f;
        if (tid < 132) { const int cidx = ord_cidx(dir, tid); bv = ldg(sp.SB + scan * NCH + cidx); gv = ldg(sp.SG + scan * NCH + cidx); }
        if (tid < 256) { XA[tid] = bv; BS[tid] = bv; GS[tid] = gv; }
        lbar();
        for (int off = 1; off < 256; off <<= 1) { float v = 0.f; if (tid < 256 && tid >= off) v = XA[tid - off]; lbar(); if (tid < 256) XA[tid] += v; lbar(); }
        if (tid < 256) XB[tid] = tid < 132 ? GS[tid] - XA[tid] : -INFINITY;
        lbar();
        for (int off = 1; off < 256; off <<= 1) { float v = -INFINITY; if (tid < 256 && tid >= off) v = XB[tid - off]; lbar(); if (tid < 256) XB[tid] = fmaxf(XB[tid], v); lbar(); }
        if (tid < 132) {
            const float m0 = tid == 0 ? 0.f : XA[tid - 1] + fmaxf(0.f, XB[tid - 1]);
            const float m1 = XA[tid] + fmaxf(0.f, XB[tid]);
            DEC[tid] = expf(BS[tid] + m0 - m1); SCL[tid] = expf(GS[tid] - m1);
            if (t >= 128) stg(sp.SM + scan * NCH + ord_cidx(dir, tid), m0);
        }
        lbar();
        if (t < 128 || tid < 64) {
            const int stride = t < 128 ? 4096 : 64;
            float* buf = (t < 128 ? sp.CST + (size_t)scan * NCH * 4096 + (t & 7) * 512 : sp.NST + (size_t)scan * NCH * 64) + tid;
            float run = 0.f;
            for (int s0 = 0; s0 < 132; s0 += 33) { float dl[33];
#pragma unroll
                for (int u = 0; u < 33; ++u) dl[u] = ldg(buf + (size_t)ord_cidx(dir, s0 + u) * stride);
#pragma unroll
                for (int u = 0; u < 33; ++u) { stg(buf + (size_t)ord_cidx(dir, s0 + u) * stride, run); run = DEC[s0 + u] * run + SCL[s0 + u] * dl[u]; } }
        }
        lbar();
    } else {
        const int scan = (t - 144) >> 2, dir = scan & 1, elem = ((t - 144) & 3) * 512 + tid, d = elem >> 6;
        for (int idx = tid; idx < 132 * 32; idx += 512) GDs[idx] = ldg(sp.GD + ((size_t)scan * NCH + ord_cidx(dir, idx >> 5)) * 32 + (idx & 31));
        lbar();
        float* buf = sp.SST + (size_t)scan * NCH * 2048 + elem; float run = 0.f;
        for (int s0 = 0; s0 < 132; s0 += 33) { float dl[33];
#pragma unroll
            for (int u = 0; u < 33; ++u) dl[u] = ldg(buf + (size_t)ord_cidx(dir, s0 + u) * 2048);
#pragma unroll
            for (int u = 0; u < 33; ++u) { stg(buf + (size_t)ord_cidx(dir, s0 + u) * 2048, run); run = GDs[(s0 + u) * 32 + d] * run + dl[u]; } }
        lbar();
    }
}

DI void chunk_finish(const float* H, unsigned char* ws, size_t m0, int colbase, int h, const float* outn, bool use_o, const u32x4& gg, const u32x4& og) {
    const int tid = otid(), t = tid >> 3, v8 = (tid & 7) * 8;
    float hs[8]; float ss = 0.f;
#pragma unroll
    for (int e = 0; e < 8; ++e) { hs[e] = H[t * HLD + v8 + e] + H[64 * HLD + t * HLD + v8 + e]; ss += hs[e] * hs[e]; }
    ss += __shfl_xor(ss, 1); ss += __shfl_xor(ss, 2); ss += __shfl_xor(ss, 4);
    const float rinv = rsqrtf(ss * (1.f / 64.f) + EPS);
    const size_t mrow = m0 + t;
    float o[8];
#pragma unroll
    for (int e = 0; e < 8; ++e) { float x = hs[e] * rinv * outn[v8 + e] * bfe(gg, e); if (use_o) x *= bfe(og, e); o[e] = x; }
    st8g((bf16*)(ws + WS_HXY) + mrow * 1024 + colbase + h * 64 + v8, o);
}

struct McPre { float lf, li, nl, mp; u32x4 qp, qc, qn, kp, kc, kn, vraw, gg, og; f32x4 c[2][2]; };
DI McPre mlstm_c_load(unsigned char* ws, int tsk) {
    const int bh = tsk / NCH, cidx = tsk - bh * NCH, b = bh >> 2, h = bh & 3, tid = otid();
    const size_t m0 = (size_t)b * TK + cidx * 64; const ScanPtrs sp = scan_ptrs(ws); McPre p; p.lf = 0.f; p.li = 0.f; p.nl = 0.f; p.mp = 0.f;
    if (tid < 128) { const int dir = tid >> 6, s = tid & 63; const float* sm = (const float*)(ws + WS_SMALL) + (m0 + s) * 48; p.lf = ldg(sm + (2 * dir + 1) * 4 + h); p.li = ldg(sm + (2 * dir) * 4 + h);
        p.nl = ldg(sp.NST + ((size_t)(bh * 2 + dir) * NCH + cidx) * 64 + s); p.mp = ldg(sp.SM + (bh * 2 + dir) * NCH + cidx); }
    const int s = tid >> 3, d0 = (tid & 7) * 8;
    const bool hasp = (s > 0) || (cidx != 0 && cidx != 4), hasn = (s < 63) || (cidx != 3 && cidx != NCH - 1);
    load3((const bf16*)(ws + WS_QB) + (m0 + s) * 256 + h * 64 + d0, hasp, hasn, p.qp, p.qc, p.qn);
    load3((const bf16*)(ws + WS_KB) + (m0 + s) * 256 + h * 64 + d0, hasp, hasn, p.kp, p.kc, p.kn);
    p.vraw = ldg((const u32x4*)((const bf16*)(ws + WS_VBT) + ((size_t)bh * 64 + s) * TK + cidx * 64 + d0));
#pragma unroll
    for (int dir = 0; dir < 2; ++dir) { const float* src = sp.CST + ((size_t)(bh * 2 + dir) * NCH + cidx) * 4096 + s * 64 + d0; p.c[dir][0] = ldg((const f32x4*)src); p.c[dir][1] = ldg((const f32x4*)(src + 4)); }
    p.gg = ldg((const u32x4*)((const bf16*)(ws + WS_GATE) + (m0 + s) * 1024 + 256 + h * 64 + d0));
    p.og = ldg((const u32x4*)((const bf16*)(ws + WS_OB) + (m0 + s) * 256 + h * 64 + d0));
    return p;
}
DI void mlstm_c_run(unsigned char* lds, unsigned char* ws, int tsk, const McPre& p, const float* conv_w, const float* conv_b, const float* outn) {
    const int bh = tsk / NCH, cidx = tsk - bh * NCH, b = bh >> 2, h = bh & 3;
    const int tid = otid(), lane = tid & 63, wave = tid >> 6, l32 = lane & 31, hi = lane >> 5;
    const size_t m0 = (size_t)b * TK + cidx * 64;
    bf16* QS = (bf16*)lds; bf16* KSm = (bf16*)(lds + 9216); bf16* VT = (bf16*)(lds + 18432); bf16* CB = (bf16*)(lds + 27648); bf16* PL = (bf16*)(lds + 46080);
    float* H = (float*)(lds + 64512); float* AA = (float*)(lds + 99328); float* MU = AA + 128; float* GI = MU + 128; float* EN = GI + 128;
    float* NQ = EN + 128; float* RS = NQ + 128; float* NL = RS + 256;
    if (wave < 2) { const int dir = wave; const bool rev = dir == 1;
        const float bcum = wscan_add(p.lf, lane, rev), a = p.li - bcum, cm = wscan_max(a, lane, rev), mu = fmaxf(p.mp, cm);
        AA[dir * 64 + lane] = a; MU[dir * 64 + lane] = mu; GI[dir * 64 + lane] = expf(p.mp - mu); EN[dir * 64 + lane] = expf(-bcum - mu); NL[dir * 64 + lane] = p.nl; }
    { const int s = tid >> 3, d0 = (tid & 7) * 8; float qv[8], kv[8];
      conv8r(p.qp, p.qc, p.qn, conv_w + h * 64 + d0, conv_b + h * 64 + d0, 1.f, qv);
      conv8r(p.kp, p.kc, p.kn, conv_w + 256 + h * 64 + d0, conv_b + 256 + h * 64 + d0, 0.125f, kv);
      st8(QS + s * LD64 + d0, qv); st8(KSm + s * LD64 + d0, kv);
      *(u32x4*)(VT + s * LD64 + d0) = p.vraw;
#pragma unroll
      for (int dir = 0; dir < 2; ++dir) { float cv[8]; getv(p.c[dir][0], p.c[dir][1], cv); st8(CB + dir * (64 * LD64) + s * LD64 + d0, cv); } }
    lbar();
    { const int o = tid >> 2, part = tid & 3, dir = o >> 6, t = o & 63; float a = 0.f;
#pragma unroll
      for (int q = 0; q < 16; ++q) { const int d = part * 16 + q; a += NL[dir * 64 + d] * b2f(QS[t * LD64 + d]); }
      a += __shfl_xor(a, 1); a += __shfl_xor(a, 2);
      if (part == 0) NQ[dir * 64 + t] = a; }
    { const int dir = wave >> 2, tr = (wave >> 1) & 1, tc = wave & 1;
      f32x16 S;
#pragma unroll
      for (int i = 0; i < 16; ++i) S[i] = 0.f;
#pragma unroll
      for (int ks = 0; ks < 4; ++ks) S = MFMA32(ldfrag(KSm, LD64, 32 * tr, 16 * ks, lane), ldfrag(QS, LD64, 32 * tc, 16 * ks, lane), S);
      const int t = 32 * tc + l32; const float mu = MU[dir * 64 + t]; float rs = 0.f;
#pragma unroll
      for (int g = 0; g < 4; ++g) { float pw[4];
#pragma unroll
          for (int e = 0; e < 4; ++e) { const int s = 32 * tr + 8 * g + 4 * hi + e; const bool ok = dir == 0 ? (s <= t) : (s >= t);
              pw[e] = ok ? S[4 * g + e] * __expf(AA[dir * 64 + s] - mu) : 0.f; rs += pw[e]; }
          *(u32x2*)(PL + dir * (64 * LD64) + t * LD64 + 32 * tr + 8 * g + 4 * hi) = (u32x2){pk(pw[0], pw[1]), pk(pw[2], pw[3])}; }
      rs += __shfl_xor(rs, 32);
      if (hi == 0) RS[(dir * 2 + tr) * 64 + t] = rs; }
    lbar();
    { const int dir = wave >> 2, vr = (wave >> 1) & 1, tc = wave & 1;
      f32x16 aP, aC;
#pragma unroll
      for (int i = 0; i < 16; ++i) { aP[i] = 0.f; aC[i] = 0.f; }
#pragma unroll
      for (int ks = 0; ks < 4; ++ks) { aP = MFMA32(ldfrag(VT, LD64, 32 * vr, 16 * ks, lane), ldfrag(PL + dir * (64 * LD64), LD64, 32 * tc, 16 * ks, lane), aP);
          aC = MFMA32(ldfrag(CB + dir * (64 * LD64), LD64, 32 * vr, 16 * ks, lane), ldfrag(QS, LD64, 32 * tc, 16 * ks, lane), aC); }
      const int t = 32 * tc + l32; const float gi = GI[dir * 64 + t];
      const float nq = RS[(dir * 2) * 64 + t] + RS[(dir * 2 + 1) * 64 + t] + gi * NQ[dir * 64 + t];
      const float inv = 1.f / fmaxf(fabsf(nq), EN[dir * 64 + t]);
#pragma unroll
      for (int i = 0; i < 16; ++i) H[dir * (64 * HLD) + t * HLD + 32 * vr + crow(i, hi)] = (aP[i] + gi * aC[i]) * inv; }
    lbar();
    chunk_finish(H, ws, m0, 256, h, outn, true, p.gg, p.og);
    lbar();
}

struct GcPre { GlPre g; u32x4 gg; float st[2][4]; };
DI GcPre gla_c_load(unsigned char* ws, int tsk) {
    const int bh = tsk / NCH, cidx = tsk - bh * NCH, b = bh >> 2, h = bh & 3, tid = otid(); const ScanPtrs sp = scan_ptrs(ws);
    const size_t m0 = (size_t)b * TK + cidx * 64; GcPre p; p.g = gla_load(ws, tsk, true);
    p.gg = ldg((const u32x4*)((const bf16*)(ws + WS_GATE) + (m0 + (tid >> 3)) * 1024 + 512 + h * 64 + (tid & 7) * 8));
#pragma unroll
    for (int z = 0; z < 2; ++z) { const float* src = sp.SST + ((size_t)(bh * 2 + z) * NCH + cidx) * 2048;
#pragma unroll
        for (int it = 0; it < 4; ++it) p.st[z][it] = ldg(src + tid + 512 * it); }
    return p;
}
DI void gla_c_run(unsigned char* lds, unsigned char* ws, int tsk, const GcPre& p, const float* wg, const float* bg, const float* outn) {
    const int bh = tsk / NCH, cidx = tsk - bh * NCH, b = bh >> 2, h = bh & 3;
    const int tid = otid(), lane = tid & 63, wave = tid >> 6, l32 = lane & 31, hi = lane >> 5;
    const size_t m0 = (size_t)b * TK + cidx * 64;
    bf16* QT = (bf16*)lds; bf16* KT2 = (bf16*)(lds + 10240); bf16* QH = (bf16*)(lds + 20480); bf16* VT = (bf16*)(lds + 30720);
    bf16* ST = (bf16*)(lds + 39936); bf16* PL = (bf16*)(lds + 50176); float* H = (float*)(lds + 68608);
    { const int wu = __builtin_amdgcn_readfirstlane(wave), z = wu >> 2, dg = wu & 3; float bc[8]; gla_bc(p.g, h, z, dg, lane, wg, bg, bc);
      float q1[8], k1[8], q2[8];
#pragma unroll
      for (int e = 0; e < 8; ++e) { const float rf = __shfl(bc[e], 32); const float qv = bfe(p.g.qraw, e);
          q1[e] = qv * __expf(bc[e] - rf); k1[e] = bfe(p.g.kraw, e) * __expf(rf - bc[e]); q2[e] = qv * __expf(bc[e]); }
      st8(QT + z * (64 * LD32) + lane * LD32 + dg * 8, q1); st8(KT2 + z * (64 * LD32) + lane * LD32 + dg * 8, k1); st8(QH + z * (64 * LD32) + lane * LD32 + dg * 8, q2); }
    *(u32x4*)(VT + (tid >> 3) * LD64 + (tid & 7) * 8) = p.g.vraw;
#pragma unroll
    for (int z = 0; z < 2; ++z)
#pragma unroll
        for (int it = 0; it < 4; ++it) { const int idx = tid + 512 * it, d = idx >> 6, v = idx & 63; ST[z * (64 * LD32) + v * LD32 + d] = f2b(p.st[z][it]); }
    lbar();
    { const int z = wave >> 2, tr = (wave >> 1) & 1, tc = wave & 1;
      f32x16 S;
#pragma unroll
      for (int i = 0; i < 16; ++i) S[i] = 0.f;
#pragma unroll
      for (int ks = 0; ks < 2; ++ks) S = MFMA32(ldfrag(KT2 + z * (64 * LD32), LD32, 32 * tr, 16 * ks, lane), ldfrag(QT + z * (64 * LD32), LD32, 32 * tc, 16 * ks, lane), S);
      const int t = 32 * tc + l32;
#pragma unroll
      for (int g = 0; g < 4; ++g) { float pw[4];
#pragma unroll
          for (int e = 0; e < 4; ++e) { const int s = 32 * tr + 8 * g + 4 * hi + e; const bool ok = z == 0 ? (s <= t) : (s >= t); pw[e] = ok ? S[4 * g + e] : 0.f; }
          *(u32x2*)(PL + z * (64 * LD64) + t * LD64 + 32 * tr + 8 * g + 4 * hi) = (u32x2){pk(pw[0], pw[1]), pk(pw[2], pw[3])}; } }
    lbar();
    { const int z = wave >> 2, vr = (wave >> 1) & 1, tc = wave & 1;
      f32x16 a;
#pragma unroll
      for (int i = 0; i < 16; ++i) a[i] = 0.f;
#pragma unroll
      for (int ks = 0; ks < 4; ++ks) a = MFMA32(ldfrag(VT, LD64, 32 * vr, 16 * ks, lane), ldfrag(PL + z * (64 * LD64), LD64, 32 * tc, 16 * ks, lane), a);
#pragma unroll
      for (int ks = 0; ks < 2; ++ks) a = MFMA32(ldfrag(ST + z * (64 * LD32), LD32, 32 * vr, 16 * ks, lane), ldfrag(QH + z * (64 * LD32), LD32, 32 * tc, 16 * ks, lane), a);
      const int t = 32 * tc + l32;
#pragma unroll
      for (int i = 0; i < 16; ++i) H[z * (64 * HLD) + t * HLD + 32 * vr + crow(i, hi)] = a[i]; }
    lbar();
    chunk_finish(H, ws, m0, 512, h, outn, false, p.gg, p.gg);
    lbar();
}


#ifndef DUP_MASK
#define DUP_MASK 0
#endif
#define XB_TMO      128
#define XB_XCNT(j)  (256  + 64 * (j))
#define XB_XSUB(j)  (1280 + 64 * (j))
#define XB_XGEN(j)  (2304 + 64 * (j))
#define XB_TOP      3328
#define XB_TOPGEN   3392
#define XCD_BAR_WORDS 3456
#define XB_SPIN_CAP (1u << 18)

__device__ __forceinline__ unsigned xb_ld(unsigned* p)              { return __hip_atomic_load(p, __ATOMIC_RELAXED, __HIP_MEMORY_SCOPE_AGENT); }
__device__ __forceinline__ unsigned xb_add(unsigned* p, unsigned v) { return __hip_atomic_fetch_add(p, v, __ATOMIC_RELAXED, __HIP_MEMORY_SCOPE_AGENT); }
__device__ __forceinline__ unsigned xb_xcc_id() { return (unsigned)__builtin_amdgcn_s_getreg((3 << 11) | 20) & 0xFu; }
#define XB_SPIN(cond, bar) do { unsigned _sp = 0; while (cond) { __builtin_amdgcn_s_sleep(1); \
    if ((++_sp & 255u) == 0u) { if (xb_ld(&(bar)[XB_TMO])) break; if (_sp > XB_SPIN_CAP) { atomicAdd(&(bar)[XB_TMO], 1u); break; } } } } while (0)

struct XcdBarrier {
    unsigned* bar; unsigned x;
    volatile unsigned* st;
};

__device__ __forceinline__ XcdBarrier xcd_barrier_post(unsigned* bar, volatile unsigned* st) {
    XcdBarrier b; b.bar = bar; b.x = xb_xcc_id(); b.st = st;
    if (threadIdx.x == 0) (void)xb_add(&bar[XB_XCNT(b.x)], 1u);
    return b;
}
__device__ __forceinline__ void xcd_barrier_complete(unsigned* bar, unsigned x, unsigned& nloc, unsigned& nx) {
    const unsigned G = gridDim.x * gridDim.y * gridDim.z;
    unsigned sum, cnt, mine, sp = 0u;
    for (;;) {
        sum = 0u; cnt = 0u; mine = 0u;
#pragma unroll
        for (unsigned j = 0; j < 16; ++j) { const unsigned c = xb_ld(&bar[XB_XCNT(j)]); sum += c; cnt += (c > 0u) ? 1u : 0u; mine = (j == x) ? c : mine; }
        if (sum == G) break;
        __builtin_amdgcn_s_sleep(1);
        if ((++sp & 255u) == 0u) { if (xb_ld(&bar[XB_TMO])) break; if (sp > XB_SPIN_CAP) { atomicAdd(&bar[XB_TMO], 1u); break; } }
    }
    nloc = mine > 0u ? mine : 1u; nx = cnt > 0u ? cnt : 1u;
}

__device__ __forceinline__ void xcd_barrier(const XcdBarrier& b) {
    asm volatile("s_waitcnt vmcnt(0)" ::: "memory");
    __syncthreads();
    if (threadIdx.x == 0) {
        unsigned* bar = b.bar;
        __builtin_amdgcn_s_waitcnt(0);
        unsigned nloc = b.st[0], nx = b.st[1];
        if (nloc == 0u) { xcd_barrier_complete(bar, b.x, nloc, nx); b.st[0] = nloc; b.st[1] = nx; }
        const unsigned old = xb_add(&bar[XB_XSUB(b.x)], 1u);
        const unsigned gen = old / nloc;
        if (old + 1u == (gen + 1u) * nloc) {
            __builtin_amdgcn_fence(__ATOMIC_RELEASE, "agent");
            asm volatile("s_waitcnt vmcnt(0)" ::: "memory");
            const unsigned og = xb_add(&bar[XB_TOP], 1u);
            const unsigned tg = og / nx;
            if (og + 1u == (tg + 1u) * nx) xb_add(&bar[XB_TOPGEN], 1u);
            else XB_SPIN(xb_ld(&bar[XB_TOPGEN]) == tg, bar);
            __builtin_amdgcn_fence(__ATOMIC_ACQUIRE, "agent");
            xb_add(&bar[XB_XGEN(b.x)], 1u);
            asm volatile("s_waitcnt vmcnt(0)" ::: "memory");
        } else {
            XB_SPIN(xb_ld(&bar[XB_XGEN(b.x)]) == gen, bar);
            __builtin_amdgcn_fence(__ATOMIC_ACQUIRE, "agent");
            asm volatile("s_waitcnt vmcnt(0)" ::: "memory");
        }
    }
    __syncthreads();
}

DI void gbar(unsigned* cnt, unsigned target) {
    asm volatile("s_waitcnt vmcnt(0) lgkmcnt(0)" ::: "memory");
    __syncthreads();
    if (threadIdx.x == 0) {
        __builtin_amdgcn_fence(__ATOMIC_RELEASE, "agent");
        __hip_atomic_fetch_add(cnt, 1u, __ATOMIC_RELAXED, __HIP_MEMORY_SCOPE_AGENT);
        while (__hip_atomic_load(cnt, __ATOMIC_RELAXED, __HIP_MEMORY_SCOPE_AGENT) < target) __builtin_amdgcn_s_sleep(1);
        __builtin_amdgcn_fence(__ATOMIC_ACQUIRE, "agent");
    }
    __syncthreads();
}
#define GSYNC() do { XcdBarrier xb_; xb_.bar = (unsigned*)(ws + WS_XBAR); xb_.x = xb_xcc_id(); xb_.st = (volatile unsigned*)(lds + LDS_BYTES - 64); xcd_barrier(xb_); if ((DUP_MASK) & 256) xcd_barrier(xb_); } while (0)
#define DUPN(bit) (((DUP_MASK) & (bit)) ? 2 : 1)
__global__ void __launch_bounds__(512, 2) fwd_kernel(Args a) {
    extern __shared__ __attribute__((aligned(16))) unsigned char lds[];
    cg::grid_group grid = cg::this_grid();
    unsigned char* ws = a.ws;
    int tid = threadIdx.x, lane = tid & 63, wave = __builtin_amdgcn_readfirstlane(tid >> 6);
    const int G = gridDim.x, bid = blockIdx.x;
    float* MODV = (float*)(ws + WS_MODV); float* MISC = (float*)(ws + WS_MISC);
    if (bid == 0 && tid < 24) ((const float**)(ws + WS_ARGS))[tid] = tid < 23 ? a.in[tid] : (const float*)a.out;
    volatile unsigned* xst = (volatile unsigned*)(lds + LDS_BYTES - 64);
    if (tid < 2) xst[tid] = 0u;
    __syncthreads();
    (void)xcd_barrier_post((unsigned*)(ws + WS_XBAR), xst);


    for (int rep = 0; rep < DUPN(128); ++rep) {
        for (int task = bid; task < 96; task += G) {
            const int l = task / 48, n0 = (task % 48) * 64, n = n0 + lane;
            const float* wm = a.in[4] + (size_t)l * 1024 * 3072; const float* c = a.in[1]; const float* cc = a.in[3];
            float* SV = (float*)lds;
            for (int i = tid; i < 3072; i += 512) { const float x = i < 2048 ? c[i] : cc[i - 2048]; SV[i] = silu_(x); }
            __syncthreads();
            float a0 = 0.f, a1 = 0.f, a2 = 0.f;
            for (int k0 = 0; k0 < 128; k0 += 32) { float w[32];
#pragma unroll
                for (int kk = 0; kk < 32; ++kk) w[kk] = wm[(size_t)(wave * 128 + k0 + kk) * 3072 + n];
#pragma unroll
                for (int kk = 0; kk < 32; ++kk) { const int k = wave * 128 + k0 + kk; a0 += SV[k] * w[kk]; a1 += SV[1024 + k] * w[kk]; a2 += SV[2048 + k] * w[kk]; } }
            float* red = (float*)(lds + 131072);
            red[(wave * 3 + 0) * 64 + lane] = a0; red[(wave * 3 + 1) * 64 + lane] = a1; red[(wave * 3 + 2) * 64 + lane] = a2;
            __syncthreads();
            if (tid < 192) { const int v = tid >> 6; float s = a.in[5][l * 3072 + n0 + lane];
                for (int w = 0; w < 8; ++w) s += red[(w * 3 + v) * 64 + lane];
                MODV[(l * 3 + v) * 3072 + n0 + lane] = s; }
            __syncthreads();
        }
        if (bid == G - 1) {
            float* tabA = (float*)(ws + WS_TABA); float* tabD = (float*)(ws + WS_TABD);
            for (int idx = tid; idx < 128 * 8; idx += 512) { const int pos = idx >> 3, i = idx & 7;
                const float inv = exp2f(-(float)i * (13.287712379549449f / 8.f)); const float ang = (float)pos * inv;
                double rev = (double)ang * 0.15915494309189535; rev -= rint(rev);
                tabA[pos * 16 + i] = __builtin_amdgcn_cosf((float)rev); tabA[pos * 16 + 8 + i] = __builtin_amdgcn_sinf((float)rev); }
            for (int idx = tid; idx < 128 * 16; idx += 512) { const int pos = idx >> 4, i = idx & 15;
                const float inv = exp2f(-(float)i * (13.287712379549449f / 16.f)); const float ang = (float)pos * inv;
                double rev = (double)ang * 0.15915494309189535; rev -= rint(rev);
                tabD[pos * 32 + i] = __builtin_amdgcn_cosf((float)rev); tabD[pos * 32 + 16 + i] = __builtin_amdgcn_sinf((float)rev); }
            if (tid < 2) { const int l = tid; const float* lp = a.in[11] + l * 128; float s1 = 0.f, s2 = 0.f;
                for (int d = 0; d < 32; ++d) { s1 += lp[d] * lp[32 + d]; s2 += lp[64 + d] * lp[96 + d]; }
                const float lam_init = 0.8f - 0.6f * expf(-0.3f * (float)l);
                float gq = 0.f, gk = 0.f, gqd = 0.f, gkd = 0.f, sk = 0.f;
                for (int d = 0; d < 32; ++d) { gq = fmaxf(gq, fabsf(a.in[9][l * 32 + d])); gk = fmaxf(gk, fabsf(a.in[10][l * 32 + d])); }
                for (int d = 0; d < 64; ++d) { gqd = fmaxf(gqd, fabsf(a.in[20][l * 64 + d])); gkd = fmaxf(gkd, fabsf(a.in[21][l * 64 + d])); }
                for (int d = 0; d < 4; ++d) sk = fmaxf(sk, a.in[22][l * 4 + d] * LOG2E);
                MISC[l * 8 + 0] = expf(s1) - expf(s2) + lam_init; MISC[l * 8 + 1] = lam_init;
                MISC[l * 8 + 2] = 5.656854249f * LOG2E * gq * gk * 1.01f; MISC[l * 8 + 3] = fmaxf(8.f * LOG2E * gqd * gkd * 1.01f, sk); }
        }
        float* scr = (float*)(lds + wave * 16384);
        const int gw = bid * 8 + wave, NGW = G * 8;
        for (int it = gw; it < 2048; it += NGW) {
            if (it < 4096) { const int l = it >> 11; transpose_item(a.in[7] + (size_t)l * 1024 * NSRC, NSRC, true, (bf16*)(ws + WS_WIN) + (size_t)l * NP * 1024, 1024, it & 2047, NP / 32, scr, lane); }
            else { const int r = it - 4096, l = r >> 9; transpose_item(a.in[8] + (size_t)l * 1024 * 1024, 1024, false, (bf16*)(ws + WS_WOUT) + (size_t)l * 1024 * 1024, 1024, r & 511, 32, scr, lane); }
        }
    }
    if (a.ws == nullptr) grid.sync();
    GSYNC();

#pragma unroll 1
    for (int l = 0; l < 2; ++l) {
        asm volatile("" : "+s"(ws));
        const float* const* IN = (const float* const*)(ws + WS_ARGS); float* OUT = (float*)IN[23];
        const float* xsrc = l == 0 ? IN[0] : OUT; const float* csrc = l == 0 ? IN[2] : (const float*)(ws + WS_CTX);
        tid = otid(); lane = tid & 63; wave = __builtin_amdgcn_readfirstlane(tid >> 6);
        {
            const int gw = bid * 8 + wave, NGW = G * 8; const float* ng = IN[6] + l * 1024;
            for (int rep = 0; rep < DUPN(1); ++rep)
            for (int m0 = gw; m0 < M; m0 += 2 * NGW) {
                const float* srcs[2]; int vs[2]; bool ok[2]; f32x4 x[2][4];
#pragma unroll
                for (int r = 0; r < 2; ++r) { const int m = m0 + r * NGW; ok[r] = m < M; const int mm = ok[r] ? m : m0;
                    const int b = mm >= TK ? 1 : 0, j = mm - b * TK;
                    if (j < LC) { srcs[r] = csrc + (size_t)(b * LC + j) * D; vs[r] = 2; } else { srcs[r] = xsrc + (size_t)(b * T + j - LC) * D; vs[r] = b; }
#pragma unroll
                    for (int q = 0; q < 4; ++q) x[r][q] = ldg((const f32x4*)srcs[r] + lane + 64 * q); }
#pragma unroll
                for (int r = 0; r < 2; ++r) { if (!ok[r]) continue; const int m = m0 + r * NGW;
                    const float* md = MODV + (l * 3 + vs[r]) * 3072; float ss = 0.f;
#pragma unroll
                    for (int q = 0; q < 4; ++q) ss += (x[r][q].x * x[r][q].x + x[r][q].y * x[r][q].y) + (x[r][q].z * x[r][q].z + x[r][q].w * x[r][q].w);
                    const float rinv = rsqrtf(wave_sum(ss) * (1.f / 1024.f) + EPS);
                    bf16* dst = (bf16*)(ws + WS_HXY) + (size_t)m * D;
#pragma unroll
                    for (int q = 0; q < 4; ++q) { const int col = 4 * (lane + 64 * q);
                        const f32x4 g = ldg((const f32x4*)(ng + col)), sh = ldg((const f32x4*)(md + col)), sc = ldg((const f32x4*)(md + 1024 + col));
                        const f32x4 y = (x[r][q] * rinv) * g * (sc + 1.f) + sh;
                        stg((u32x2*)(dst + col), (u32x2){pk(y.x, y.y), pk(y.z, y.w)}); } }
            }
        }
        GSYNC();
        {
            pg8::Gemm g{(const pg8::bf16_t*)(ws + WS_HXY), (const pg8::bf16_t*)(ws + WS_WIN) + (size_t)l * NP * 1024, M, NP, D};
            pg8::StaticOrder S; S.init(M, NP, G, bid);
            EpiIn E{ws, l};
            for (int rep = 0; rep < DUPN(2); ++rep) pg8::gemm_phase<EpiIn, pg8::StaticOrder, true, true>((PG8_LAS unsigned char*)lds, g, S, E);
        }
        GSYNC();
        {
            const float* misc = MISC + l * 8;
            fill_wcache(lds, IN, l);
            for (int rep = 0; rep < DUPN(4); ++rep) {
                { const float* cw = (const float*)(lds + WC_OFF) + WC_CW; const float* cb = (const float*)(lds + WC_OFF) + WC_CB;
                  int t = bid; MaPre cur = mlstm_a_load(ws, t < 8 * NCH ? t : 0);
                  while (t < 8 * NCH) { const int tn = t + G; MaPre nxt = mlstm_a_load(ws, tn < 8 * NCH ? tn : t); mlstm_a_run(lds, ws, t, cur, cw, cb); cur = nxt; t = tn; } }
                { const float* wg = (const float*)(lds + WC_OFF) + WC_WG; const float* bg = (const float*)(lds + WC_OFF) + WC_BG;
                  int t = bid; GlPre cur = gla_load(ws, t < 8 * NCH ? t : 0, false);
                  while (t < 8 * NCH) { const int tn = t + G; GlPre nxt = gla_load(ws, tn < 8 * NCH ? tn : t, false); gla_a_run(lds, ws, t, cur, wg, bg); cur = nxt; t = tn; } }
            }
            const int nU = l == 0 ? 264 : 256;
            for (int rep = 0; rep < DUPN(8); ++rep)
            for (int u = bid; u < nU; u += G) attnD_unit(lds, ws, u, IN[22] + l * 4, misc);
            for (int rep = 0; rep < DUPN(16); ++rep)
            for (int u = bid; u < nU; u += G) attnA_unit(lds, ws, u, IN[12] + l * 64, misc);
        }
        GSYNC();
        for (int t = bid; t < 208; t += G) scan_b(lds, ws, t);
        if (l == 0) {
            float* scr = (float*)(lds + wave * 16384);
            for (int it = 2048 + bid * 8 + wave; it < 2 * 2048 + 2 * 512; it += G * 8) {
                if (it < 4096) { transpose_item(IN[7] + (size_t)1024 * NSRC, NSRC, true, (bf16*)(ws + WS_WIN) + (size_t)NP * 1024, 1024, it & 2047, NP / 32, scr, lane); }
                else { const int r = it - 4096, ll = r >> 9; transpose_item(IN[8] + (size_t)ll * 1024 * 1024, 1024, false, (bf16*)(ws + WS_WOUT) + (size_t)ll * 1024 * 1024, 1024, r & 511, 32, scr, lane); }
            }
            __syncthreads();
        }
        GSYNC();
        fill_wcache(lds, IN, l);
        for (int rep = 0; rep < DUPN(32); ++rep) {
            const int ncl = l == 0 ? NCH : NCH - 4, ntask = 8 * ncl;
#define C_TASK(u) (((u) / ncl) * NCH + ((u) % ncl) + (NCH - ncl))
            { const float* cw = (const float*)(lds + WC_OFF) + WC_CW; const float* cb = (const float*)(lds + WC_OFF) + WC_CB; const float* on = (const float*)(lds + WC_OFF) + WC_BON;
              int u = bid; McPre cur = mlstm_c_load(ws, C_TASK(u < ntask ? u : 0));
              while (u < ntask) { const int un = u + G; McPre nxt = mlstm_c_load(ws, C_TASK(un < ntask ? un : u)); mlstm_c_run(lds, ws, C_TASK(u), cur, cw, cb, on); cur = nxt; u = un; } }
            { const float* wg = (const float*)(lds + WC_OFF) + WC_WG; const float* bg = (const float*)(lds + WC_OFF) + WC_BG; const float* on = (const float*)(lds + WC_OFF) + WC_CON;
              int u = bid; GcPre cur = gla_c_load(ws, C_TASK(u < ntask ? u : 0));
              while (u < ntask) { const int un = u + G; GcPre nxt = gla_c_load(ws, C_TASK(un < ntask ? un : u)); gla_c_run(lds, ws, C_TASK(u), cur, wg, bg, on); cur = nxt; u = un; } }
        }
        GSYNC();
        {
            pg8::Gemm g{(const pg8::bf16_t*)(ws + WS_HXY), (const pg8::bf16_t*)(ws + WS_WOUT) + (size_t)l * 1024 * 1024, M, D, D};
            EpiOut E{xsrc, csrc, OUT, (float*)(ws + WS_CTX), MODV + l * 3 * 3072};
            if (l == 0) { pg8::StaticOrder S; S.init(M, D, G, bid); for (int rep = 0; rep < DUPN(64); ++rep) pg8::gemm_phase<EpiOut, pg8::StaticOrder, true, true>((PG8_LAS unsigned char*)lds, g, S, E); }
            else { LatOrder S; S.so.init(NB * T, D, G, bid); pg8::gemm_phase<EpiOut, LatOrder, true, true>((PG8_LAS unsigned char*)lds, g, S, E); }
        }
        if (l == 0) GSYNC();
    }
}

extern "C" void kernel_launch(void* const* d_in, const int* in_sizes, int n_in, void* d_out, int out_size, void* d_ws, size_t ws_size, hipStream_t stream) {
    static int grid = 0;
    if (grid == 0) {
        int dev = 0, cus = 0, per_cu = 0;
        if (n_in != 23 || ws_size < 256 * MiB) { fprintf(stderr, "kernel_launch: unexpected inputs (n_in %d, ws %zu)\n", n_in, ws_size); grid = -1; return; }
        hipGetDevice(&dev); hipDeviceGetAttribute(&cus, hipDeviceAttributeMultiprocessorCount, dev);
        if (hipFuncSetAttribute((const void*)fwd_kernel, hipFuncAttributeMaxDynamicSharedMemorySize, LDS_BYTES) != hipSuccess) { fprintf(stderr, "kernel_launch: hipFuncSetAttribute failed\n"); grid = -1; return; }
        if (hipOccupancyMaxActiveBlocksPerMultiprocessor(&per_cu, (const void*)fwd_kernel, 512, LDS_BYTES) != hipSuccess || per_cu < 1) { fprintf(stderr, "kernel_launch: occupancy query says %d\n", per_cu); per_cu = 1; }
        (void)hipGetLastError();
        grid = cus > 0 ? cus : 256;
    }
    if (grid < 0) return;
    Args a{};
    for (int i = 0; i < 23; ++i) a.in[i] = (const float*)d_in[i];
    a.out = (float*)d_out; a.ws = (unsigned char*)d_ws;
    if (hipMemsetAsync((char*)d_ws + WS_XBAR, 0, 16384, stream) != hipSuccess) { fprintf(stderr, "kernel_launch: memset of the barrier word failed\n"); return; }
    void* args[] = {&a};
    hipError_t e = hipLaunchCooperativeKernel((const void*)fwd_kernel, dim3(grid), dim3(512), args, LDS_BYTES, stream);
    if (e != hipSuccess) fprintf(stderr, "kernel_launch: cooperative launch failed: %s (grid %d)\n", hipGetErrorString(e), grid);
}
```

```cpp
#include <hip/hip_runtime.h>
#include <hip/hip_cooperative_groups.h>
#include <cstdio>
#include <cstdint>
namespace cg = cooperative_groups;
#define DUP_MASK 0
#define PAD_NOPS "6"
namespace pg8 {
#define PG8_LAS __attribute__((address_space(3)))
typedef unsigned short bf16_t;
typedef short bf16x8 __attribute__((ext_vector_type(8)));
typedef float f32x4 __attribute__((ext_vector_type(4)));
typedef unsigned u32x4 __attribute__((ext_vector_type(4)));
constexpr int BM = 256, BK = 64, HALF = 128, HTB = HALF * BK * 2  , STAGE_BYTES = 8 * HTB, NXCD = 8, WGM = 8;

__host__ __device__ __forceinline__ int lds_byte(int r, int c) { const int st = (r >> 4) * 2 + (c >> 5), rr = r & 15, cc = c & 31, ob = rr * 64 + cc * 2; return st * 1024 + (ob ^ (((ob >> 9) & 1) << 5)); }
__host__ __device__ __forceinline__ void stage_rc(int b, int& R, int& C) { const int st = b / 1024, sb = b % 1024, swz = sb ^ (((sb >> 9) & 1) << 5); R = (st >> 1) * 16 + swz / 64; C = (st & 1) * 32 + (swz % 64) / 2; }
__host__ __device__ __forceinline__ int perm32(int rho) { const int n = rho >> 4, i = rho & 15; return 8 * (i >> 2) + 4 * n + (i & 3); }

struct Unit { int pm, pn; };
struct Gemm { const bf16_t* A; const bf16_t* Bt; int M, N, K; };

struct StaticOrder {
    int nM, nN, nwg, G, c;
    __host__ __device__ void init(int M, int N, int G_, int c_) { nM = M / BM; nN = N / BM; nwg = nM * nN; G = G_; c = c_; }
    __host__ __device__ bool next(int i, Unit& u) const {
        const long L = (long)i * G + c; if (L >= nwg) return false;
        int wgid = (int)L; { const int q = nwg / NXCD, r = nwg % NXCD, xcd = wgid % NXCD, off = wgid / NXCD; wgid = (xcd < r ? xcd * (q + 1) : r * (q + 1) + (xcd - r) * q) + off; }
        const int nig = WGM * nN, gid = wgid / nig, fm = gid * WGM, gsz = (nM - fm) < WGM ? (nM - fm) : WGM;
        u.pm = fm + ((wgid % nig) % gsz); u.pn = (wgid % nig) / gsz; return true;
    }
    __device__ __forceinline__ void a_ready(const Unit&) const {}
    __device__ __forceinline__ void done(const Unit&) const {}
};

__device__ __forceinline__ unsigned cvt_pk_bf16(float lo, float hi) { unsigned r; asm volatile("v_cvt_pk_bf16_f32 %0, %1, %2" : "=v"(r) : "v"(lo), "v"(hi)); return r; }
typedef float f32x2 __attribute__((ext_vector_type(2)));
template <class Epi, class Sched, bool ALIGN_EPI = false, bool SP2 = false>
__device__ __forceinline__ void gemm_phase(PG8_LAS unsigned char* lds, const Gemm g, const Sched& S, const Epi& E) {
    int tid_ = threadIdx.x; asm volatile("" : "+v"(tid_)); const int tid = tid_, wid = __builtin_amdgcn_readfirstlane(tid >> 6), lane = tid & 63, wr = wid >> 2, wc = wid & 3, fr = lane & 15, fq = lane >> 4;
    const int K = g.K, nt = K / BK;
    unsigned voffA[2], voffB[2];
#pragma unroll
    for (int i = 0; i < 2; ++i) { int R, C; stage_rc(tid * 16 + i * 8192, R, C); const int Rb = Epi::PERM ? ((R & ~31) + perm32(R & 31)) : R;
        voffA[i] = (unsigned)(R * K + C) * 2u; voffB[i] = (unsigned)(Rb * K + C) * 2u; }
    const size_t kstep = (size_t)(BK * 2);
    const size_t hstep = (size_t)HALF * K * 2;
    const size_t tstep = 2 * hstep;
    const unsigned ldsw = (unsigned)wid * 1024u;
    const int aoff = lds_byte(wr * 64 + fr, fq * 8), boff = lds_byte(wc * 32 + fr, fq * 8);
#define PG8_SA(b, h) (((b) * 2 + (h)) * HTB)
#define PG8_SB(b, h) ((4 + (b) * 2 + (h)) * HTB)
#define PG8_STAGE(bufoff, gbase, voff) do { _Pragma("unroll") for (int _i = 0; _i < 2; ++_i) \
        __builtin_amdgcn_global_load_lds((const unsigned*)((const char*)(gbase) + (voff)[_i]), (PG8_LAS unsigned*)(lds + (bufoff) + ldsw + _i * 8192), 16, 0, 0); } while (0)
#define PG8_LDA(dst, b, h) do { _Pragma("unroll") for (int m = 0; m < 4; ++m) _Pragma("unroll") for (int k = 0; k < 2; ++k) dst[m][k] = *(const PG8_LAS bf16x8*)(lds + PG8_SA(b, h) + aoff + m * 2048 + k * 1024); } while (0)
#define PG8_LDB(dst, b, h) do { _Pragma("unroll") for (int n = 0; n < 2; ++n) _Pragma("unroll") for (int k = 0; k < 2; ++k) dst[n][k] = *(const PG8_LAS bf16x8*)(lds + PG8_SB(b, h) + boff + n * 2048 + k * 1024); } while (0)
#define PG8_MMA(ai, bj, At, Bt) do { __builtin_amdgcn_s_setprio(1); _Pragma("unroll") for (int m = 0; m < 4; ++m) _Pragma("unroll") for (int n = 0; n < 2; ++n) _Pragma("unroll") for (int k = 0; k < 2; ++k) \
        acc[ai][bj][m][n] = __builtin_amdgcn_mfma_f32_16x16x32_bf16(Bt[n][k], At[m][k], acc[ai][bj][m][n], 0, 0, 0); __builtin_amdgcn_s_setprio(0); } while (0)
#define PG8_WAIT_V(n) asm volatile("s_waitcnt vmcnt(" #n ")" ::: "memory")
#define PG8_WAIT_L(n) asm volatile("s_waitcnt lgkmcnt(" #n ")" ::: "memory")
#define PG8_BAR __builtin_amdgcn_s_barrier()
#define PG8_SCHED __builtin_amdgcn_sched_barrier(0)
    Unit cur, nxt; int ui = 0;
    if (!S.next(0, cur)) return;
    f32x4 acc[2][2][4][2];
#pragma unroll
    for (int a = 0; a < 2; ++a)
#pragma unroll
        for (int b = 0; b < 2; ++b)
#pragma unroll
            for (int m = 0; m < 4; ++m)
#pragma unroll
                for (int n = 0; n < 2; ++n) acc[a][b][m][n] = (f32x4){0.f, 0.f, 0.f, 0.f};
    bf16x8 At[4][2], B0[2][2], B1[2][2];
    const char* cA = (const char*)g.A + (size_t)cur.pm * tstep; const char* cB = (const char*)g.Bt + (size_t)cur.pn * tstep;
    S.a_ready(cur);
    if constexpr (SP2) {
        PG8_STAGE(PG8_SB(0, 0), cB, voffB); PG8_STAGE(PG8_SB(0, 1), cB + hstep, voffB); PG8_STAGE(PG8_SA(0, 0), cA, voffA); PG8_STAGE(PG8_SA(0, 1), cA + hstep, voffA);
        if (wr == 1) PG8_BAR;
        PG8_WAIT_V(2); PG8_BAR;
        PG8_STAGE(PG8_SB(1, 0), cB + kstep, voffB); PG8_STAGE(PG8_SA(1, 0), cA + kstep, voffA); PG8_STAGE(PG8_SB(1, 1), cB + hstep + kstep, voffB);
        PG8_WAIT_V(6); PG8_BAR;
    } else {
        PG8_STAGE(PG8_SB(0, 0), cB, voffB); PG8_STAGE(PG8_SA(0, 0), cA, voffA); PG8_STAGE(PG8_SB(0, 1), cB + hstep, voffB); PG8_STAGE(PG8_SA(0, 1), cA + hstep, voffA);
        if (wr == 1) PG8_BAR;
        PG8_WAIT_V(4); PG8_BAR;
        PG8_STAGE(PG8_SB(1, 0), cB + kstep, voffB); PG8_STAGE(PG8_SA(1, 0), cA + kstep, voffA); PG8_STAGE(PG8_SB(1, 1), cB + hstep + kstep, voffB);
        PG8_WAIT_V(6); PG8_BAR;
    }
#ifdef PAD_G
    asm volatile("s_nop 0");
#endif
    for (;;) {
        const bool has_next = S.next(ui + 1, nxt);
        const char* nA = has_next ? (const char*)g.A + (size_t)nxt.pm * tstep : cA; const char* nB = has_next ? (const char*)g.Bt + (size_t)nxt.pn * tstep : cB;
        for (int t = 0; t < nt; t += 2) {
            const bool last = (t == nt - 2);
            const char* a1 = cA + (size_t)(t + 1) * kstep;
            const char* a2 = last ? nA : cA + (size_t)(t + 2) * kstep; const char* b2 = last ? nB : cB + (size_t)(t + 2) * kstep;
            const char* a3 = a2 + kstep; const char* b3 = b2 + kstep;
            if (last && has_next) S.a_ready(nxt);
            if constexpr (SP2) {
            PG8_LDB(B0, 0, 0); PG8_LDB(B1, 0, 1); PG8_SCHED; PG8_LDA(At, 0, 0); PG8_STAGE(PG8_SA(1, 1), a1 + hstep, voffA);
            PG8_WAIT_V(8); PG8_WAIT_L(0); PG8_BAR; PG8_MMA(0, 0, At, B0); PG8_MMA(0, 1, At, B1); PG8_BAR; PG8_SCHED;
            PG8_LDA(At, 0, 1); PG8_STAGE(PG8_SB(0, 0), b2, voffB); PG8_STAGE(PG8_SB(0, 1), b2 + hstep, voffB); PG8_STAGE(PG8_SA(0, 0), a2, voffA);
            PG8_WAIT_V(8); PG8_WAIT_L(0); PG8_BAR; PG8_MMA(1, 0, At, B0); PG8_MMA(1, 1, At, B1); PG8_BAR; PG8_SCHED;
            PG8_LDB(B0, 1, 0); PG8_LDB(B1, 1, 1); PG8_SCHED; PG8_LDA(At, 1, 0); PG8_STAGE(PG8_SA(0, 1), a2 + hstep, voffA);
            PG8_WAIT_V(8); PG8_WAIT_L(0); PG8_BAR; PG8_MMA(0, 0, At, B0); PG8_MMA(0, 1, At, B1); PG8_BAR; PG8_SCHED;
            PG8_LDA(At, 1, 1); PG8_STAGE(PG8_SB(1, 0), b3, voffB); PG8_STAGE(PG8_SB(1, 1), b3 + hstep, voffB); PG8_STAGE(PG8_SA(1, 0), a3, voffA);
            PG8_WAIT_V(8); PG8_WAIT_L(0); PG8_BAR; PG8_MMA(1, 0, At, B0); PG8_MMA(1, 1, At, B1); PG8_BAR; PG8_SCHED;
            } else {
            PG8_LDB(B0, 0, 0); PG8_SCHED; PG8_LDA(At, 0, 0); PG8_STAGE(PG8_SA(1, 1), a1 + hstep, voffA);
            PG8_WAIT_L(8); PG8_BAR; PG8_WAIT_L(0); PG8_MMA(0, 0, At, B0); PG8_BAR; PG8_SCHED;
            PG8_LDB(B1, 0, 1); PG8_STAGE(PG8_SB(0, 0), b2, voffB);
            PG8_BAR; PG8_WAIT_L(0); PG8_MMA(0, 1, At, B1); PG8_BAR;
            PG8_LDA(At, 0, 1); PG8_STAGE(PG8_SA(0, 0), a2, voffA);
            PG8_BAR; PG8_WAIT_L(0); PG8_MMA(1, 0, At, B0); PG8_BAR; PG8_SCHED;
            PG8_STAGE(PG8_SB(0, 1), b2 + hstep, voffB);
            PG8_WAIT_V(6); PG8_BAR; PG8_MMA(1, 1, At, B1); PG8_BAR;
            PG8_LDB(B0, 1, 0); PG8_SCHED; PG8_LDA(At, 1, 0); PG8_STAGE(PG8_SA(0, 1), a2 + hstep, voffA);
            PG8_WAIT_L(8); PG8_BAR; PG8_WAIT_L(0); PG8_MMA(0, 0, At, B0); PG8_BAR; PG8_SCHED;
            PG8_LDB(B1, 1, 1); PG8_STAGE(PG8_SB(1, 0), b3, voffB);
            PG8_BAR; PG8_WAIT_L(0); PG8_MMA(0, 1, At, B1); PG8_BAR;
            PG8_LDA(At, 1, 1); PG8_STAGE(PG8_SA(1, 0), a3, voffA);
            PG8_BAR; PG8_WAIT_L(0); PG8_MMA(1, 0, At, B0); PG8_BAR; PG8_SCHED;
            PG8_STAGE(PG8_SB(1, 1), b3 + hstep, voffB);
            PG8_WAIT_V(6); PG8_BAR; PG8_MMA(1, 1, At, B1); PG8_BAR;
            }
        }
        if constexpr (ALIGN_EPI) { if (wr == 0) PG8_BAR; }
        if constexpr (!Epi::AFTER_DRAIN) { E(acc, cur, wr, wc, fr, fq); S.done(cur); }
        if (!has_next) break;
#pragma unroll
        for (int a = 0; a < 2; ++a)
#pragma unroll
            for (int b = 0; b < 2; ++b)
#pragma unroll
                for (int m = 0; m < 4; ++m)
#pragma unroll
                    for (int n = 0; n < 2; ++n) acc[a][b][m][n] = (f32x4){0.f, 0.f, 0.f, 0.f};
        cur = nxt; cA = nA; cB = nB; ++ui;
        if constexpr (ALIGN_EPI) { if (wr == 1) PG8_BAR; }
    }
#ifdef PAD_G
    asm volatile("s_nop 0");
#endif
    PG8_WAIT_V(0);
    if constexpr (!ALIGN_EPI) { if (wr == 0) PG8_BAR; }
    PG8_BAR;
    if constexpr (Epi::AFTER_DRAIN) { E.fused(acc, cur, wr, wc, fr, fq, lds, wid, lane); S.done(cur); }
#undef PG8_SA
#undef PG8_SB
#undef PG8_STAGE
#undef PG8_LDA
#undef PG8_LDB
#undef PG8_MMA
#undef PG8_WAIT_V
#undef PG8_WAIT_L
#undef PG8_BAR
#undef PG8_SCHED
}
}

#define DI __device__ __forceinline__
typedef unsigned short bf16;
typedef short bf16x8 __attribute__((ext_vector_type(8)));
typedef float f32x4 __attribute__((ext_vector_type(4)));
typedef float f32x16 __attribute__((ext_vector_type(16)));
typedef unsigned u32x4 __attribute__((ext_vector_type(4)));
typedef unsigned u32x2 __attribute__((ext_vector_type(2)));
typedef __bf16 bf16x2_t __attribute__((ext_vector_type(2)));
typedef float f32x2_t __attribute__((ext_vector_type(2)));
#define MFMA32(a, b, c) __builtin_amdgcn_mfma_f32_32x32x16_bf16((a), (b), (c), 0, 0, 0)

constexpr int NB = 2, T = 8192, LC = 256, TK = 8448, M = NB * TK, D = 1024, NSRC = 3888, NP = 4096, NCH = 132;
constexpr float EPS = 1e-6f, LOG2E = 1.4426950408889634f;
constexpr int LDS_BYTES = 147456;

constexpr size_t MiB = 1u << 20;
constexpr size_t S8 = (size_t)M * 256 * 2, S4 = S8 / 2;
constexpr size_t WS_ARGS = 512 * 1024, WS_XBAR = 64 * 1024;
constexpr size_t WS_MODV = 1 * MiB, WS_TABA = WS_MODV + 131072, WS_TABD = WS_TABA + 8192, WS_MISC = WS_TABD + 16384;
constexpr size_t WS_WIN = 2 * MiB, WS_WOUT = 18 * MiB, WS_CTX = 22 * MiB, WS_HXY = 24 * MiB;
constexpr size_t WS_QA = 57 * MiB, WS_KA = WS_QA + S8, WS_VAT = WS_KA + S8, WS_QB = WS_VAT + S8, WS_KB = WS_QB + S8, WS_VBT = WS_KB + S8, WS_OB = WS_VBT + S8;
constexpr size_t WS_QC = WS_OB + S8, WS_KC = WS_QC + S4, WS_VCT = WS_KC + S4, WS_QD = WS_VCT + S8, WS_KD = WS_QD + S8, WS_VDT = WS_KD + S4, WS_GATE = WS_VDT + S4;
constexpr size_t WS_SMALL = WS_GATE + 4 * S8;
constexpr size_t WS_CST = 184 * MiB, WS_NST = 217 * MiB, WS_SSC = WS_NST + 768 * 1024, WS_SST = 218 * MiB, WS_GD = WS_SST + (size_t)16 * NCH * 2048 * 4;
static_assert(WS_SMALL + (size_t)M * 48 * 4 <= WS_CST, "ws map");
static_assert(WS_CST + (size_t)16 * NCH * 4096 * 4 <= WS_NST, "ws map");
static_assert(WS_GD + (size_t)16 * NCH * 32 * 4 <= 256 * MiB, "ws map");

DI unsigned pk(float lo, float hi) { f32x2_t v = {lo, hi}; bf16x2_t b = __builtin_convertvector(v, bf16x2_t); return __builtin_bit_cast(unsigned, b); }
DI bf16 f2b(float x) { return (bf16)(pk(x, 0.f) & 0xffffu); }
DI float b2f(bf16 x) { return __uint_as_float((unsigned)x << 16); }
DI float bfe(const u32x4& v, int e) { const unsigned w = v[e >> 1]; return __uint_as_float((e & 1) ? (w & 0xffff0000u) : (w << 16)); }
DI float bfe2(const u32x2& v, int e) { const unsigned w = v[e >> 1]; return __uint_as_float((e & 1) ? (w & 0xffff0000u) : (w << 16)); }
DI void st8(bf16* p, const float* v) { u32x4 w; w.x = pk(v[0], v[1]); w.y = pk(v[2], v[3]); w.z = pk(v[4], v[5]); w.w = pk(v[6], v[7]); *(u32x4*)p = w; }
DI void st8g(bf16* p, const float* v) { u32x4 w; w.x = pk(v[0], v[1]); w.y = pk(v[2], v[3]); w.z = pk(v[4], v[5]); w.w = pk(v[6], v[7]); *(__attribute__((address_space(1))) u32x4*)p = w; }
DI void st8t(bf16* p, const float* v) {
#pragma unroll
    for (int e = 0; e < 8; ++e) *(__attribute__((address_space(1))) bf16*)(p + (size_t)e * TK) = f2b(v[e]); }
DI float sigmoid_(float x) { return 1.f / (1.f + __expf(-x)); }
DI float silu_(float x) { return x * sigmoid_(x); }
DI float logsigmoid_(float x) { return fminf(x, 0.f) - log1pf(expf(-fabsf(x))); }
DI int crow(int r, int hi) { return (r & 3) + 8 * (r >> 2) + 4 * hi; }
DI float wave_sum(float v) {
#pragma unroll
    for (int o = 1; o < 64; o <<= 1) v += __shfl_xor(v, o);
    return v; }
DI void getv(const f32x4& a, const f32x4& b, float* v) { v[0] = a[0]; v[1] = a[1]; v[2] = a[2]; v[3] = a[3]; v[4] = b[0]; v[5] = b[1]; v[6] = b[2]; v[7] = b[3]; }
DI bf16x8 ldfrag(const bf16* X, int ld, int r0, int k0, int lane) { return *(const bf16x8*)(X + (r0 + (lane & 31)) * ld + k0 + 8 * (lane >> 5)); }

DI int otid() { int t = threadIdx.x; asm volatile("" : "+v"(t)); return t; }
template <class T> DI T ldg(const T* p) { return *(const __attribute__((address_space(1))) T*)p; }
template <class T> DI void stg(T* p, const T& v) { *(__attribute__((address_space(1))) T*)p = v; }
DI void lbar() { asm volatile("s_waitcnt lgkmcnt(0)" ::: "memory"); __builtin_amdgcn_s_barrier(); asm volatile("" ::: "memory"); }
struct Args { const float* in[23]; float* out; unsigned char* ws; };

DI int srccol(int n) {
    const int tile = n >> 8, p = n & 255;
    if (tile < 6) return n;
    if (tile == 6) return 1552 + p;
    if (tile == 7) return 1808 + p;
    if (tile == 8) return 2064 + p;
    if (tile == 9 || tile == 10) {
        const int hh = (p >> 5) & 3, d = ((p >> 7) << 5) + (p & 31);
        if (tile == 9) return 2352 + hh * 64 + d;
        return hh < 2 ? 2608 + hh * 64 + d : 2736 + (hh - 2) * 64 + d;
    }
    if (tile < 15) return 2864 + (n - 11 * 256);
    if (p < 16) return 1536 + p;
    if (p < 48) return 2320 + (p - 16);
    return -1;
}

DI void transpose_item(const float* W, int Nsrc, bool perm, bf16* WT, int K, int item, int nblk, float* scr, int lane) {
    const int kb = item / nblk, nb = item - kb * nblk, k0 = 64 * kb, n0 = 32 * nb;
    const int n = n0 + (lane & 31); const int sc = perm ? srccol(n) : n;
#pragma unroll 8
    for (int i = 0; i < 32; ++i) { const int kk = 2 * i + (lane >> 5); scr[kk * 33 + (lane & 31)] = sc >= 0 ? W[(size_t)(k0 + kk) * Nsrc + sc] : 0.f; }
    asm volatile("s_waitcnt lgkmcnt(0)" ::: "memory");
    const int c = lane & 7;
#pragma unroll
    for (int j = 0; j < 4; ++j) { const int nn = (lane >> 3) + 8 * j; const float* s = scr + (8 * c) * 33 + nn;
        u32x4 o; o.x = pk(s[0 * 33], s[1 * 33]); o.y = pk(s[2 * 33], s[3 * 33]); o.z = pk(s[4 * 33], s[5 * 33]); o.w = pk(s[6 * 33], s[7 * 33]);
        *(u32x4*)(WT + (size_t)(n0 + nn) * K + k0 + 8 * c) = o; }
    asm volatile("s_waitcnt lgkmcnt(0)" ::: "memory");
}

DI void a_head(float* v, const float* gn, bool rope, const float* tab, int fq, float scale) {
    float ss = 0.f;
#pragma unroll
    for (int e = 0; e < 8; ++e) ss += v[e] * v[e];
    ss += __shfl_xor(ss, 16); ss += __shfl_xor(ss, 32);
    const float rinv = rsqrtf(ss * (1.f / 32.f) + EPS);
#pragma unroll
    for (int e = 0; e < 8; ++e) v[e] *= rinv * gn[e];
    if (rope) {
        const f32x4 ca = ldg((const f32x4*)tab), cb = ldg((const f32x4*)(tab + 4)), sa = ldg((const f32x4*)(tab + 8)), sb = ldg((const f32x4*)(tab + 12));
        float c[8], sn[8]; getv(ca, cb, c); getv(sa, sb, sn);
#pragma unroll
        for (int e = 0; e < 8; ++e) { const float p = __shfl_xor(v[e], 16); v[e] = (fq & 1) ? (p * sn[e] + v[e] * c[e]) : (v[e] * c[e] - p * sn[e]); }
    }
#pragma unroll
    for (int e = 0; e < 8; ++e) v[e] *= scale;
}
DI void d_head(float* v0, float* v1, const float* g0, const float* g1, bool rope, const float* tabr, const float* tabc, int fq, float scale) {
    float ss = 0.f;
#pragma unroll
    for (int e = 0; e < 8; ++e) ss += v0[e] * v0[e] + v1[e] * v1[e];
    ss += __shfl_xor(ss, 16); ss += __shfl_xor(ss, 32);
    const float rinv = rsqrtf(ss * (1.f / 64.f) + EPS);
#pragma unroll
    for (int e = 0; e < 8; ++e) { v0[e] *= rinv * g0[e]; v1[e] *= rinv * g1[e]; }
    if (rope) {
        const int fi = 8 * (fq & 1);
        { const f32x4 ca = ldg((const f32x4*)(tabr + fi)), cb = ldg((const f32x4*)(tabr + fi + 4)), sa = ldg((const f32x4*)(tabr + 16 + fi)), sb = ldg((const f32x4*)(tabr + 16 + fi + 4));
          float c[8], sn[8]; getv(ca, cb, c); getv(sa, sb, sn);
#pragma unroll
          for (int e = 0; e < 8; ++e) { const float p0 = __shfl_xor(v0[e], 32); v0[e] = (fq >= 2) ? (p0 * sn[e] + v0[e] * c[e]) : (v0[e] * c[e] - p0 * sn[e]); } }
        asm volatile("" ::: "memory");
        { const f32x4 ca = ldg((const f32x4*)(tabc + fi)), cb = ldg((const f32x4*)(tabc + fi + 4)), sa = ldg((const f32x4*)(tabc + 16 + fi)), sb = ldg((const f32x4*)(tabc + 16 + fi + 4));
          float c[8], sn[8]; getv(ca, cb, c); getv(sa, sb, sn);
#pragma unroll
          for (int e = 0; e < 8; ++e) { const float p1 = __shfl_xor(v1[e], 32); v1[e] = (fq >= 2) ? (p1 * sn[e] + v1[e] * c[e]) : (v1[e] * c[e] - p1 * sn[e]); } }
    }
#pragma unroll
    for (int e = 0; e < 8; ++e) { v0[e] *= scale; v1[e] *= scale; }
}

struct EpiIn {
    static constexpr bool PERM = true, AFTER_DRAIN = false;
    unsigned char* ws; int l;
    DI void operator()(const pg8::f32x4 (&acc)[2][2][4][2], const pg8::Unit& u, int wr, int wc, int fr_, int fq_) const {
        int fr = fr_, fq = fq_; asm volatile("" : "+v"(fr), "+v"(fq));
        const int b = u.pm >= 33 ? 1 : 0, pmi = u.pm - 33 * b; const bool is_ctx = (pmi == 0);
        const int j00 = pmi * 256 + wr * 64 + fr, pn = u.pn;
        const float* tabA = (const float*)(ws + WS_TABA); const float* tabD = (const float*)(ws + WS_TABD);
        const float* const* IN = (const float* const*)(ws + WS_ARGS);
#define ROWS_BEGIN _Pragma("unroll") for (int ai = 0; ai < 2; ++ai) _Pragma("unroll") for (int m = 0; m < 4; ++m) { \
        float v0[8], v1[8]; getv(acc[ai][0][m][0], acc[ai][0][m][1], v0); getv(acc[ai][1][m][0], acc[ai][1][m][1], v1); \
        const int j = j00 + ai * 128 + m * 16; const size_t mrow = (size_t)b * TK + j; const int t = is_ctx ? 0 : j - LC; (void)mrow; (void)t;
#define ROWS_END asm volatile("" ::: "memory"); }
        if (pn == 0 || pn == 1) {
            const float* gsrc = IN[pn == 0 ? 9 : 10] + l * 32 + 8 * fq;
            const float scale = pn == 0 ? 0.17677669529663687f * LOG2E : 1.f;
            bf16* dstb = (bf16*)(ws + (pn == 0 ? WS_QA : WS_KA));
            ROWS_BEGIN
                const float* tab = tabA + ((fq < 2) ? (t >> 6) : (t & 63)) * 16;
                float gn[8]; getv(ldg((const f32x4*)gsrc), ldg((const f32x4*)(gsrc + 4)), gn);
                a_head(v0, gn, !is_ctx, tab, fq, scale); a_head(v1, gn, !is_ctx, tab, fq, scale);
                { const int gi = wc, h = gi >> 1, c = gi & 1; st8g(dstb + (((b * 4 + h) * TK + j) * 64 + c * 32 + 8 * fq), v0); }
                { const int gi = 4 + wc, h = gi >> 1, c = gi & 1; st8g(dstb + (((b * 4 + h) * TK + j) * 64 + c * 32 + 8 * fq), v1); }
            ROWS_END
        } else if (pn == 2 || pn == 5 || pn == 8) {
            bf16* dstb = (bf16*)(ws + (pn == 2 ? WS_VAT : (pn == 5 ? WS_VBT : WS_VCT)));
            const int dv0 = (wc & 1) * 32 + 8 * fq;
            ROWS_BEGIN
                st8t(dstb + ((size_t)(b * 4 + (wc >> 1)) * 64 + dv0) * TK + j, v0);
                st8t(dstb + ((size_t)(b * 4 + 2 + (wc >> 1)) * 64 + dv0) * TK + j, v1);
            ROWS_END
        } else if (pn == 3 || pn == 4 || pn == 6) {
            bf16* dstb = (bf16*)(ws + (pn == 3 ? WS_QB : (pn == 4 ? WS_KB : WS_OB)));
            const int c0 = wc * 32 + 8 * fq;
            ROWS_BEGIN
                if (pn == 6) {
#pragma unroll
                    for (int e = 0; e < 8; ++e) { v0[e] = sigmoid_(v0[e]); v1[e] = sigmoid_(v1[e]); } }
                st8g(dstb + mrow * 256 + c0, v0); st8g(dstb + mrow * 256 + 128 + c0, v1);
            ROWS_END
        } else if (pn == 7) {
            bf16* dq = (bf16*)(ws + WS_QC); bf16* dk = (bf16*)(ws + WS_KC); const int c0 = wc * 32 + 8 * fq;
            ROWS_BEGIN
#pragma unroll
                for (int e = 0; e < 8; ++e) v0[e] *= 0.17677669529663687f;
                st8g(dq + mrow * 128 + c0, v0); st8g(dk + mrow * 128 + c0, v1);
            ROWS_END
        } else if (pn == 9) {
            bf16* dstb = (bf16*)(ws + WS_QD); const float* d_qn = IN[20] + l * 64;
            ROWS_BEGIN
                float g0[8], g1[8]; getv(ldg((const f32x4*)(d_qn + 8 * fq)), ldg((const f32x4*)(d_qn + 8 * fq + 4)), g0); getv(ldg((const f32x4*)(d_qn + 32 + 8 * fq)), ldg((const f32x4*)(d_qn + 36 + 8 * fq)), g1);
                d_head(v0, v1, g0, g1, !is_ctx, tabD + (t >> 6) * 32, tabD + (t & 63) * 32, fq, 0.125f * LOG2E);
                bf16* p = dstb + ((((b * 2 + (wc >> 1)) * 2 + (wc & 1)) * TK + j) * 64 + 8 * fq);
                st8g(p, v0); st8g(p + 32, v1);
            ROWS_END
        } else if (pn == 10) {
            if (wc < 2) {
                bf16* dstb = (bf16*)(ws + WS_KD); const float* d_kn = IN[21] + l * 64;
                ROWS_BEGIN
                    float g0[8], g1[8]; getv(ldg((const f32x4*)(d_kn + 8 * fq)), ldg((const f32x4*)(d_kn + 8 * fq + 4)), g0); getv(ldg((const f32x4*)(d_kn + 32 + 8 * fq)), ldg((const f32x4*)(d_kn + 36 + 8 * fq)), g1);
                    d_head(v0, v1, g0, g1, !is_ctx, tabD + (t >> 6) * 32, tabD + (t & 63) * 32, fq, 1.f);
                    bf16* p = dstb + (((b * 2 + wc) * TK + j) * 64 + 8 * fq);
                    st8g(p, v0); st8g(p + 32, v1);
                ROWS_END
            } else {
                bf16* dstb = (bf16*)(ws + WS_VDT);
                ROWS_BEGIN
                    bf16* p = dstb + ((size_t)(b * 2 + (wc - 2)) * 64 + 8 * fq) * TK + j;
                    st8t(p, v0); st8t(p + (size_t)32 * TK, v1);
                ROWS_END
            }
        } else if (pn < 15) {
            bf16* dstb = (bf16*)(ws + WS_GATE); const int c0 = (pn - 11) * 256 + wc * 32 + 8 * fq;
            ROWS_BEGIN
#pragma unroll
                for (int e = 0; e < 8; ++e) { v0[e] = silu_(v0[e]); v1[e] = silu_(v1[e]); }
                st8g(dstb + mrow * 1024 + c0, v0); st8g(dstb + mrow * 1024 + 128 + c0, v1);
            ROWS_END
        } else {
            float* dstb = (float*)(ws + WS_SMALL); const int p0 = wc * 32 + 8 * fq; const float* gate_b = IN[15] + l * 16;
            if (p0 < 48) {
                ROWS_BEGIN
                    if (p0 < 16) {
#pragma unroll
                        for (int e = 0; e < 8; ++e) { const int p = p0 + e, type = p >> 2; float x = v0[e] + ldg(gate_b + p); if (type & 1) x = logsigmoid_(x); v0[e] = x; } }
                    float* o = dstb + mrow * 48 + p0;
                    stg((f32x4*)o, (f32x4){v0[0], v0[1], v0[2], v0[3]}); stg((f32x4*)(o + 4), (f32x4){v0[4], v0[5], v0[6], v0[7]});
                ROWS_END
            }
        }
    }
};

struct EpiOut {
    static constexpr bool PERM = true, AFTER_DRAIN = false;
    const float* xsrc; const float* csrc; float* xdst; float* cdst; const float* modv;
    DI void operator()(const pg8::f32x4 (&acc)[2][2][4][2], const pg8::Unit& u, int wr, int wc, int fr_, int fq_) const {
        int fr = fr_, fq = fq_; asm volatile("" : "+v"(fr), "+v"(fq));
        const int b = u.pm >= 33 ? 1 : 0, pmi = u.pm - 33 * b; const bool is_ctx = (pmi == 0);
        const int j00 = pmi * 256 + wr * 64 + fr, col0 = u.pn * 256 + wc * 32 + 8 * fq;
        const float* gt = modv + (is_ctx ? 2 : b) * 3072 + 2048 + col0;
        f32x4 g[2][2];
#pragma unroll
        for (int bj = 0; bj < 2; ++bj) { g[bj][0] = ldg((const f32x4*)(gt + bj * 128)); g[bj][1] = ldg((const f32x4*)(gt + bj * 128 + 4)); }
#pragma unroll
        for (int ai = 0; ai < 2; ++ai)
#pragma unroll
            for (int m = 0; m < 4; ++m) {
                const int j = j00 + ai * 128 + m * 16;
                const size_t off = (is_ctx ? (size_t)(b * LC + j) : (size_t)(b * T + j - LC)) * D + col0;
                const float* s = (is_ctx ? csrc : xsrc) + off; float* d = (is_ctx ? cdst : xdst) + off;
#pragma unroll
                for (int bj = 0; bj < 2; ++bj) {
                    const f32x4 r0 = ldg((const f32x4*)(s + bj * 128)), r1 = ldg((const f32x4*)(s + bj * 128 + 4));
                    stg((f32x4*)(d + bj * 128), (f32x4)(r0 + g[bj][0] * acc[ai][bj][m][0]));
                    stg((f32x4*)(d + bj * 128 + 4), (f32x4)(r1 + g[bj][1] * acc[ai][bj][m][1]));
                }
            }
    }
};
struct LatOrder {
    pg8::StaticOrder so;
    DI bool next(int i, pg8::Unit& u) const { if (!so.next(i, u)) return false; u.pm += 1 + (u.pm >= 32 ? 1 : 0); return true; }
    DI void a_ready(const pg8::Unit&) const {}
    DI void done(const pg8::Unit&) const {}
};

constexpr int KS_LD = 72, VS_LD = 68, KS_BYTES = 64 * KS_LD * 2, VS_BYTES = 64 * VS_LD * 2;
template <int MODE>
DI void attn_core(unsigned char* lds, const bf16* qrow, const bf16* Kb, const bf16* Vt, int n1, int js, int nt, int qpos, float negM,
                  f32x16 (&O)[MODE == 0 ? 2 : 1][2], float (&lsum)[MODE == 0 ? 2 : 1]) {
    constexpr int NC = MODE == 0 ? 2 : 1, KS = MODE == 0 ? 2 : 4;
    const int tid = otid(), lane = tid & 63, l32 = lane & 31, hi = lane >> 5;
    bf16* Ksm = (bf16*)lds; bf16* Vsm = (bf16*)(lds + 2 * KS_BYTES);
    bf16x8 qf[NC][KS];
#pragma unroll
    for (int c = 0; c < NC; ++c)
#pragma unroll
        for (int ks = 0; ks < KS; ++ks) qf[c][ks] = ldg((const bf16x8*)(qrow + c * (KS * 16) + 16 * ks + 8 * hi));
#pragma unroll
    for (int c = 0; c < NC; ++c) { lsum[c] = 0.f;
#pragma unroll
        for (int d = 0; d < 2; ++d)
#pragma unroll
            for (int i = 0; i < 16; ++i) O[c][d][i] = 0.f; }
    const int lr = tid >> 3, lc = (tid & 7) * 8;
    f32x16 L1;
#pragma unroll
    for (int i = 0; i < 16; ++i) L1[i] = 0.f;
    f32x16 L0;
#pragma unroll
    for (int i = 0; i < 16; ++i) L0[i] = 0.f;
    const bf16x8 ones = (bf16x8){0x3F80, 0x3F80, 0x3F80, 0x3F80, 0x3F80, 0x3F80, 0x3F80, 0x3F80};
    f32x16 CNEG;
#pragma unroll
    for (int i = 0; i < 16; ++i) CNEG[i] = negM;
    asm volatile("" : "+v"(CNEG));
    u32x4 kreg, vreg;
    { const int j0 = (0 < n1) ? 0 : js;
      kreg = ldg((const u32x4*)(Kb + (size_t)(j0 + lr) * 64 + lc)); vreg = ldg((const u32x4*)(Vt + (size_t)lr * TK + j0 + lc));
      *(u32x4*)(Ksm + lr * KS_LD + lc) = kreg; *(u32x2*)(Vsm + lr * VS_LD + lc) = (u32x2){vreg.x, vreg.y}; *(u32x2*)(Vsm + lr * VS_LD + lc + 4) = (u32x2){vreg.z, vreg.w}; }
    lbar();
#ifdef PAD_A
    asm volatile("s_nop 0");
#endif
    for (int it = 0; it < nt; ++it) {
        const int buf = it & 1; const int j0 = (it < n1) ? 64 * it : js + 64 * (it - n1);
        const bool more = (it + 1 < nt);
        if (more) { const int jn = (it + 1 < n1) ? 64 * (it + 1) : js + 64 * (it + 1 - n1);
            kreg = ldg((const u32x4*)(Kb + (size_t)(jn + lr) * 64 + lc)); vreg = ldg((const u32x4*)(Vt + (size_t)lr * TK + jn + lc)); }
        const bf16* Kc = Ksm + buf * (64 * KS_LD); const bf16* Vc = Vsm + buf * (64 * VS_LD);
        const bool masked = (MODE == 1) && (it >= n1);
#pragma unroll
        for (int kb = 0; kb < 2; ++kb) {
            bf16x8 pf[NC][2];
#pragma unroll
            for (int c = 0; c < NC; ++c) {
                f32x16 S;
#pragma unroll
                for (int ks = 0; ks < KS; ++ks) { const bf16x8 a = *(const bf16x8*)(Kc + (32 * kb + l32) * KS_LD + c * (KS * 16) + 16 * ks + 8 * hi); S = MFMA32(a, qf[c][ks], ks == 0 ? CNEG : S); }
                float p[16];
#pragma unroll
                for (int i = 0; i < 16; ++i) p[i] = __builtin_amdgcn_exp2f(S[i]);
                if (MODE == 1) { if (masked) { const int kp0 = j0 - LC + 32 * kb + 4 * hi - qpos;
#pragma unroll
                    for (int i = 0; i < 16; ++i) { const int dlt = kp0 + (i & 3) + 8 * (i >> 2); p[i] = (dlt >= -128 && dlt <= 128) ? p[i] : 0.f; } } }
                if (c != 0) { float ps = 0.f;
#pragma unroll
                    for (int i = 8; i < 16; ++i) ps += p[i];
                    lsum[c] += ps; }
#pragma unroll
                for (int s = 0; s < 2; ++s) { u32x4 w; w.x = pk(p[8 * s], p[8 * s + 1]); w.y = pk(p[8 * s + 2], p[8 * s + 3]); w.z = pk(p[8 * s + 4], p[8 * s + 5]); w.w = pk(p[8 * s + 6], p[8 * s + 7]); pf[c][s] = __builtin_bit_cast(bf16x8, w); }
            }
#pragma unroll
            for (int dvb = 0; dvb < 2; ++dvb)
#pragma unroll
                for (int s = 0; s < 2; ++s) {
                    const bf16* vp = Vc + (32 * dvb + l32) * VS_LD + 32 * kb + 16 * s + 4 * hi;
                    const u32x2 lo = *(const u32x2*)vp, hh = *(const u32x2*)(vp + 8);
                    const bf16x8 va = __builtin_bit_cast(bf16x8, (u32x4){lo.x, lo.y, hh.x, hh.y});
#pragma unroll
                    for (int c = 0; c < NC; ++c) O[c][dvb] = MFMA32(va, pf[c][s], O[c][dvb]);
                    if (dvb == 0) L0 = MFMA32(ones, pf[0][s], L0);
                    if (dvb == 1 && s == 0 && NC == 2) L1 = MFMA32(ones, pf[NC - 1][0], L1);
                }
        }
        if (more) { bf16* Kn = Ksm + (buf ^ 1) * (64 * KS_LD); bf16* Vn = Vsm + (buf ^ 1) * (64 * VS_LD);
            *(u32x4*)(Kn + lr * KS_LD + lc) = kreg; *(u32x2*)(Vn + lr * VS_LD + lc) = (u32x2){vreg.x, vreg.y}; *(u32x2*)(Vn + lr * VS_LD + lc + 4) = (u32x2){vreg.z, vreg.w}; }
        lbar();
    }
#ifdef PAD_A
    asm volatile("s_nop 0");
#endif
    lsum[0] = 0.5f * L0[0];
    if (NC == 2) lsum[NC - 1] += 0.5f * L1[0];
}

DI void attnA_unit(unsigned char* lds, unsigned char* ws, int u, const float* subln, const float* misc) {
    const int tid = otid(), lane = tid & 63, wave = tid >> 6, l32 = lane & 31, hi = lane >> 5;
    int bh, jq0, nt;
    if (u < 256) { bh = u & 7; jq0 = LC + 256 * (u >> 3); nt = TK / 64; } else { bh = u - 256; jq0 = 0; nt = LC / 64; }
    const int b = bh >> 2, h = bh & 3, jq = jq0 + 32 * wave + l32;
    const bf16* qrow = (const bf16*)(ws + WS_QA) + ((size_t)bh * TK + jq) * 64;
    const bf16* Kb = (const bf16*)(ws + WS_KA) + (size_t)bh * TK * 64;
    const bf16* Vt = (const bf16*)(ws + WS_VAT) + (size_t)bh * 64 * TK;
    f32x16 O[2][2]; float lsum[2];
    attn_core<0>(lds, qrow, Kb, Vt, nt, 0, nt, 0, -misc[2], O, lsum);
    const float lam = misc[0], lam_init = misc[1];
    const float l0 = lsum[0] + __shfl_xor(lsum[0], 32), l1 = lsum[1] + __shfl_xor(lsum[1], 32);
    const float i0 = 1.f / l0, i1 = lam / l1;
    float ss = 0.f;
#pragma unroll
    for (int d = 0; d < 2; ++d)
#pragma unroll
        for (int i = 0; i < 16; ++i) { const float a = O[0][d][i] * i0 - O[1][d][i] * i1; O[0][d][i] = a; ss += a * a; }
    ss += __shfl_xor(ss, 32);
    const float rinv = rsqrtf(ss * (1.f / 64.f) + EPS) * (1.f - lam_init);
    const size_t mrow = (size_t)b * TK + jq;
    const bf16* gate = (const bf16*)(ws + WS_GATE) + mrow * 1024 + h * 64;
    bf16* y = (bf16*)(ws + WS_HXY) + mrow * 1024 + h * 64;
#pragma unroll
    for (int d = 0; d < 2; ++d)
#pragma unroll
        for (int g = 0; g < 4; ++g) {
            const int dv = 32 * d + 8 * g + 4 * hi;
            const u32x2 gg = ldg((const u32x2*)(gate + dv)); const f32x4 sb = ldg((const f32x4*)(subln + dv));
            u32x2 o; o.x = pk(O[0][d][4 * g] * rinv * sb[0] * bfe2(gg, 0), O[0][d][4 * g + 1] * rinv * sb[1] * bfe2(gg, 1));
            o.y = pk(O[0][d][4 * g + 2] * rinv * sb[2] * bfe2(gg, 2), O[0][d][4 * g + 3] * rinv * sb[3] * bfe2(gg, 3));
            stg((u32x2*)(y + dv), o);
        }
}

DI void attnD_unit(unsigned char* lds, unsigned char* ws, int u, const float* sink, const float* misc) {
    const int tid = otid(), lane = tid & 63, wave = tid >> 6, l32 = lane & 31, hi = lane >> 5;
    int b, kv, jq0, n1 = LC / 64, js = 0, nt = LC / 64, qpos = 0;
    if (u < 256) { const int x = u & 7; b = x >> 2; kv = (x >> 1) & 1; const int qblk = (x & 1) * 32 + (u >> 3), q0 = qblk * 128;
        jq0 = LC + q0; const int p0 = q0 - 128 < 0 ? 0 : q0 - 128, p1 = q0 + 256 > T ? T : q0 + 256; js = LC + p0; nt = n1 + (p1 - p0) / 64; qpos = q0 + 32 * (wave & 3) + l32; }
    else { const int x = u - 256; b = x >> 2; kv = (x >> 1) & 1; jq0 = 128 * (x & 1); }
    const int g = wave >> 2, jq = jq0 + 32 * (wave & 3) + l32;
    const bf16* qrow = (const bf16*)(ws + WS_QD) + ((size_t)((b * 2 + kv) * 2 + g) * TK + jq) * 64;
    const bf16* Kb = (const bf16*)(ws + WS_KD) + (size_t)(b * 2 + kv) * TK * 64;
    const bf16* Vt = (const bf16*)(ws + WS_VDT) + (size_t)(b * 2 + kv) * 64 * TK;
    f32x16 O[1][2]; float lsum[1];
    attn_core<1>(lds, qrow, Kb, Vt, n1, js, nt, qpos, -misc[3], O, lsum);
    const float l = lsum[0] + __shfl_xor(lsum[0], 32) + __builtin_amdgcn_exp2f(sink[kv * 2 + g] * LOG2E - misc[3]);
    const float inv = 1.f / l;
    const size_t mrow = (size_t)b * TK + jq; const int hc = 768 + (kv * 2 + g) * 64;
    const bf16* gate = (const bf16*)(ws + WS_GATE) + mrow * 1024 + hc;
    bf16* y = (bf16*)(ws + WS_HXY) + mrow * 1024 + hc;
#pragma unroll
    for (int d = 0; d < 2; ++d)
#pragma unroll
        for (int gq = 0; gq < 4; ++gq) {
            const int dv = 32 * d + 8 * gq + 4 * hi;
            const u32x2 gg = ldg((const u32x2*)(gate + dv));
            u32x2 o; o.x = pk(O[0][d][4 * gq] * inv * bfe2(gg, 0), O[0][d][4 * gq + 1] * inv * bfe2(gg, 1));
            o.y = pk(O[0][d][4 * gq + 2] * inv * bfe2(gg, 2), O[0][d][4 * gq + 3] * inv * bfe2(gg, 3));
            stg((u32x2*)(y + dv), o);
        }
}

DI int ord_cidx(int dir, int step) { return dir == 0 ? step : (step < 4 ? 3 - step : 135 - step); }
constexpr int LD64 = 72, LD32 = 40, HLD = 68;
constexpr int WC_OFF = 110592, WC_CW = 0, WC_CB = 1536, WC_BON = 2048, WC_CON = 2112, WC_WG = 2176, WC_BG = 6272, WC_N = 6528;
DI void fill_wcache(unsigned char* lds, const float* const* IN, int l) {
    float* WC = (float*)(lds + WC_OFF); const int tid = otid();
    const float* cw = IN[13] + l * 1536; const float* cb = IN[14] + l * 512; const float* bo = IN[16] + l * 64; const float* co = IN[19] + l * 64; const float* wg = IN[17] + l * 4096; const float* bg = IN[18] + l * 256;
    for (int i = tid; i < WC_N; i += 512) { float v;
        if (i < WC_CB) v = ldg(cw + i); else if (i < WC_BON) v = ldg(cb + i - WC_CB); else if (i < WC_CON) v = ldg(bo + i - WC_BON); else if (i < WC_WG) v = ldg(co + i - WC_CON);
        else if (i < WC_BG) v = ldg(wg + i - WC_WG); else v = ldg(bg + i - WC_BG);
        WC[i] = v; }
    lbar();
}

struct ScanPtrs { float *CST, *NST, *SB, *SG, *SM, *SST, *GD; };
DI ScanPtrs scan_ptrs(unsigned char* ws) { ScanPtrs p; p.CST = (float*)(ws + WS_CST); p.NST = (float*)(ws + WS_NST); p.SB = (float*)(ws + WS_SSC); p.SG = p.SB + 16 * NCH; p.SM = p.SG + 16 * NCH;
    p.SST = (float*)(ws + WS_SST); p.GD = (float*)(ws + WS_GD); return p; }


DI float wscan_add(float v, int lane, bool rev) {
#pragma unroll
    for (int off = 1; off < 64; off <<= 1) { const float t = rev ? __shfl_down(v, off) : __shfl_up(v, off); const bool ok = rev ? (lane + off < 64) : (lane >= off); v += ok ? t : 0.f; }
    return v; }
DI float wscan_max(float v, int lane, bool rev) {
#pragma unroll
    for (int off = 1; off < 64; off <<= 1) { const float t = rev ? __shfl_down(v, off) : __shfl_up(v, off); const bool ok = rev ? (lane + off < 64) : (lane >= off); v = ok ? fmaxf(v, t) : v; }
    return v; }
DI float wave_max(float v) {
#pragma unroll
    for (int o = 1; o < 64; o <<= 1) v = fmaxf(v, __shfl_xor(v, o));
    return v; }

DI void conv8r(const u32x4& pv, const u32x4& c, const u32x4& nv, const float* w  , const float* cb, float mul, float* o) {
    float w0[8], w1[8], w2[8], bb[8];
    getv(*(const f32x4*)w, *(const f32x4*)(w + 4), w0); getv(*(const f32x4*)(w + 512), *(const f32x4*)(w + 516), w1);
    getv(*(const f32x4*)(w + 1024), *(const f32x4*)(w + 1028), w2); getv(*(const f32x4*)cb, *(const f32x4*)(cb + 4), bb);
#pragma unroll
    for (int e = 0; e < 8; ++e) { const float y = w0[e] * bfe(pv, e) + w1[e] * bfe(c, e) + w2[e] * bfe(nv, e) + bb[e]; o[e] = silu_(y) * mul; }
}
DI void load3(const bf16* p, bool hasp, bool hasn, u32x4& pv, u32x4& c, u32x4& nv) {
    c = ldg((const u32x4*)p); pv = (u32x4){0u, 0u, 0u, 0u}; nv = pv;
    if (hasp) pv = ldg((const u32x4*)(p - 256));
    if (hasn) nv = ldg((const u32x4*)(p + 256));
}

struct MaPre { float lf, li; u32x4 kp, kc, kn, vraw; };
DI MaPre mlstm_a_load(unsigned char* ws, int tsk) {
    const int bh = tsk / NCH, cidx = tsk - bh * NCH, b = bh >> 2, h = bh & 3, tid = otid();
    const size_t m0 = (size_t)b * TK + cidx * 64; MaPre p; p.lf = 0.f; p.li = 0.f;
    if (tid < 128) { const int dir = tid >> 6, s = tid & 63; const float* sm = (const float*)(ws + WS_SMALL) + (m0 + s) * 48; p.lf = ldg(sm + (2 * dir + 1) * 4 + h); p.li = ldg(sm + (2 * dir) * 4 + h); }
    const int s = tid >> 3, d0 = (tid & 7) * 8;
    const bool hasp = (s > 0) || (cidx != 0 && cidx != 4), hasn = (s < 63) || (cidx != 3 && cidx != NCH - 1);
    load3((const bf16*)(ws + WS_KB) + (m0 + s) * 256 + h * 64 + d0, hasp, hasn, p.kp, p.kc, p.kn);
    p.vraw = ldg((const u32x4*)((const bf16*)(ws + WS_VBT) + ((size_t)bh * 64 + s) * TK + cidx * 64 + d0));
    return p;
}
DI void mlstm_a_run(unsigned char* lds, unsigned char* ws, int tsk, const MaPre& p, const float* conv_w, const float* conv_b) {
    const int bh = tsk / NCH, cidx = tsk - bh * NCH, h = bh & 3;
    const int tid = otid(), lane = tid & 63, wave = tid >> 6; const ScanPtrs sp = scan_ptrs(ws);
    bf16* KT = (bf16*)lds; bf16* VW = (bf16*)(lds + 9216); float* WE = (float*)(lds + 27648);
    if (wave < 2) { const int dir = wave; const float tot = wave_sum(p.lf), pre = wscan_add(p.lf, lane, false);
        const float g = (dir == 0 ? tot - pre : pre - p.lf) + p.li; const float G = wave_max(g);
        WE[dir * 64 + lane] = expf(g - G);
        if (lane == 0) { stg(sp.SB + (bh * 2 + dir) * NCH + cidx, tot); stg(sp.SG + (bh * 2 + dir) * NCH + cidx, G); } }
    { const int s = tid >> 3, d0 = (tid & 7) * 8; float kv[8];
      conv8r(p.kp, p.kc, p.kn, conv_w + 256 + h * 64 + d0, conv_b + 256 + h * 64 + d0, 0.125f, kv);
#pragma unroll
      for (int e = 0; e < 8; ++e) KT[(d0 + e) * LD64 + s] = f2b(kv[e]); }
    lbar();
    { const int v = tid >> 3, s0 = (tid & 7) * 8;
#pragma unroll
      for (int dir = 0; dir < 2; ++dir) { float o[8];
#pragma unroll
          for (int e = 0; e < 8; ++e) o[e] = bfe(p.vraw, e) * WE[dir * 64 + s0 + e];
          st8(VW + dir * (64 * LD64) + v * LD64 + s0, o); } }
    { const int o = tid >> 2, part = tid & 3, dir = o >> 6, d = o & 63; float a = 0.f;
#pragma unroll
      for (int q = 0; q < 16; ++q) { const int s = part * 16 + q; a += WE[dir * 64 + s] * b2f(KT[d * LD64 + s]); }
      a += __shfl_xor(a, 1); a += __shfl_xor(a, 2);
      if (part == 0) stg(sp.NST + ((size_t)(bh * 2 + dir) * NCH + cidx) * 64 + d, a); }
    lbar();
    { const int dir = wave >> 2, tr = (wave >> 1) & 1, tc = wave & 1, l32 = lane & 31, hi = lane >> 5;
      f32x16 acc;
#pragma unroll
      for (int i = 0; i < 16; ++i) acc[i] = 0.f;
#pragma unroll
      for (int ks = 0; ks < 4; ++ks) acc = MFMA32(ldfrag(VW + dir * (64 * LD64), LD64, 32 * tr, 16 * ks, lane), ldfrag(KT, LD64, 32 * tc, 16 * ks, lane), acc);
      float* dst = sp.CST + ((size_t)(bh * 2 + dir) * NCH + cidx) * 4096;
#pragma unroll
      for (int i = 0; i < 16; ++i) stg(dst + (32 * tr + crow(i, hi)) * 64 + 32 * tc + l32, acc[i]); }
    lbar();
}

struct GlPre { f32x4 lr[4]; u32x4 kraw, qraw, vraw; };
DI GlPre gla_load(unsigned char* ws, int tsk, bool need_q) {
    const int bh = tsk / NCH, cidx = tsk - bh * NCH, b = bh >> 2, h = bh & 3, tid = otid(), lane = tid & 63, wave = tid >> 6, z = wave >> 2, dg = wave & 3;
    const size_t m0 = (size_t)b * TK + cidx * 64; GlPre p;
    const float* sm = (const float*)(ws + WS_SMALL) + (m0 + lane) * 48 + 16 + z * 16;
#pragma unroll
    for (int q = 0; q < 4; ++q) p.lr[q] = ldg((const f32x4*)(sm + 4 * q));
    p.kraw = ldg((const u32x4*)((const bf16*)(ws + WS_KC) + (m0 + lane) * 128 + h * 32 + dg * 8));
    p.qraw = (u32x4){0u, 0u, 0u, 0u}; if (need_q) p.qraw = ldg((const u32x4*)((const bf16*)(ws + WS_QC) + (m0 + lane) * 128 + h * 32 + dg * 8));
    p.vraw = ldg((const u32x4*)((const bf16*)(ws + WS_VCT) + ((size_t)bh * 64 + (tid >> 3)) * TK + cidx * 64 + (tid & 7) * 8));
    return p;
}
DI void gla_bc(const GlPre& p, int h, int z, int dg, int lane, const float* wg, const float* bg, float* bc) {
    const float* wgp = wg + (z * 16) * 128 + h * 32 + dg * 8;
#pragma unroll
    for (int e = 0; e < 8; ++e) bc[e] = bg[z * 128 + h * 32 + dg * 8 + e];
#pragma unroll
    for (int r = 0; r < 16; ++r) { const float lr = p.lr[r >> 2][r & 3];
#pragma unroll
        for (int e = 0; e < 8; ++e) bc[e] += lr * wgp[r * 128 + e]; }
#pragma unroll
    for (int e = 0; e < 8; ++e) bc[e] = wscan_add((fminf(bc[e], 0.f) - __logf(1.f + __expf(-fabsf(bc[e])))) * (1.f / 16.f), lane, z == 1);
}
DI void gla_a_run(unsigned char* lds, unsigned char* ws, int tsk, const GlPre& p, const float* wg, const float* bg) {
    const int bh = tsk / NCH, cidx = tsk - bh * NCH, h = bh & 3;
    const int tid = otid(), lane = tid & 63, wave = __builtin_amdgcn_readfirstlane(tid >> 6), z = wave >> 2, dg = wave & 3; const ScanPtrs sp = scan_ptrs(ws);
    bf16* KH = (bf16*)lds; bf16* VT = (bf16*)(lds + 9216);
    float bc[8]; gla_bc(p, h, z, dg, lane, wg, bg, bc);
#pragma unroll
    for (int e = 0; e < 8; ++e) { const float bend = __shfl(bc[e], z == 0 ? 63 : 0);
        KH[z * (32 * LD64) + (dg * 8 + e) * LD64 + lane] = f2b(bfe(p.kraw, e) * expf(bend - bc[e]));
        if (lane == 0) stg(sp.GD + ((size_t)(bh * 2 + z) * NCH + cidx) * 32 + dg * 8 + e, expf(bend)); }
    *(u32x4*)(VT + (tid >> 3) * LD64 + (tid & 7) * 8) = p.vraw;
    lbar();
    if (wave < 4) { const int zz = wave >> 1, vc = wave & 1, l32 = lane & 31, hi = lane >> 5;
      f32x16 acc;
#pragma unroll
      for (int i = 0; i < 16; ++i) acc[i] = 0.f;
#pragma unroll
      for (int ks = 0; ks < 4; ++ks) acc = MFMA32(ldfrag(KH + zz * (32 * LD64), LD64, 0, 16 * ks, lane), ldfrag(VT, LD64, 32 * vc, 16 * ks, lane), acc);
      float* dst = sp.SST + ((size_t)(bh * 2 + zz) * NCH + cidx) * 2048;
#pragma unroll
      for (int i = 0; i < 16; ++i) stg(dst + crow(i, hi) * 64 + 32 * vc + l32, acc[i]); }
    lbar();
}
DI void scan_b(unsigned char* lds, unsigned char* ws, int t) {
    const int tid = otid(); const ScanPtrs sp = scan_ptrs(ws);
    float* DEC = (float*)lds; float* SCL = DEC + 256; float* XA = SCL + 256; float* XB = XA + 256; float* GS = XB + 256; float* BS = GS + 256; float* GDs = (float*)lds;
    if (t < 144) {
        const int scan = t < 128 ? (t >> 3) : (t - 128), dir = scan & 1;
        float bv = 0.f, gv = 0.f;
        if (tid < 132) { const int cidx = ord_cidx(dir, tid); bv = ldg(sp.SB + scan * NCH + cidx); gv = ldg(sp.SG + scan * NCH + cidx); }
        if (tid < 256) { XA[tid] = bv; BS[tid] = bv; GS[tid] = gv; }
        lbar();
        for (int off = 1; off < 256; off <<= 1) { float v = 0.f; if (tid < 256 && tid >= off) v = XA[tid - off]; lbar(); if (tid < 256) XA[tid] += v; lbar(); }
        if (tid < 256) XB[tid] = tid < 132 ? GS[tid] - XA[tid] : -INFINITY;
        lbar();
        for (int off = 1; off < 256; off <<= 1) { float v = -INFINITY; if (tid < 256 && tid >= off) v = XB[tid - off]; lbar(); if (tid < 256) XB[tid] = fmaxf(XB[tid], v); lbar(); }
        if (tid < 132) {
            const float m0 = tid == 0 ? 0.f : XA[tid - 1] + fmaxf(0.f, XB[tid - 1]);
            const float m1 = XA[tid] + fmaxf(0.f, XB[tid]);
            DEC[tid] = expf(BS[tid] + m0 - m1); SCL[tid] = expf(GS[tid] - m1);
            if (t >= 128) stg(sp.SM + scan * NCH + ord_cidx(dir, tid), m0);
        }
        lbar();
        if (t < 128 || tid < 64) {
            const int stride = t < 128 ? 4096 : 64;
            float* buf = (t < 128 ? sp.CST + (size_t)scan * NCH * 4096 + (t & 7) * 512 : sp.NST + (size_t)scan * NCH * 64) + tid;
            float run = 0.f;
            for (int s0 = 0; s0 < 132; s0 += 33) { float dl[33];
#pragma unroll
                for (int u = 0; u < 33; ++u) dl[u] = ldg(buf + (size_t)ord_cidx(dir, s0 + u) * stride);
#pragma unroll
                for (int u = 0; u < 33; ++u) { stg(buf + (size_t)ord_cidx(dir, s0 + u) * stride, run); run = DEC[s0 + u] * run + SCL[s0 + u] * dl[u]; } }
        }
        lbar();
    } else {
        const int scan = (t - 144) >> 2, dir = scan & 1, elem = ((t - 144) & 3) * 512 + tid, d = elem >> 6;
        for (int idx = tid; idx < 132 * 32; idx += 512) GDs[idx] = ldg(sp.GD + ((size_t)scan * NCH + ord_cidx(dir, idx >> 5)) * 32 + (idx & 31));
        lbar();
        float* buf = sp.SST + (size_t)scan * NCH * 2048 + elem; float run = 0.f;
        for (int s0 = 0; s0 < 132; s0 += 33) { float dl[33];
#pragma unroll
            for (int u = 0; u < 33; ++u) dl[u] = ldg(buf + (size_t)ord_cidx(dir, s0 + u) * 2048);
#pragma unroll
            for (int u = 0; u < 33; ++u) { stg(buf + (size_t)ord_cidx(dir, s0 + u) * 2048, run); run = GDs[(s0 + u) * 32 + d] * run + dl[u]; } }
        lbar();
    }
}

DI void chunk_finish(const float* H, unsigned char* ws, size_t m0, int colbase, int h, const float* outn, bool use_o, const u32x4& gg, const u32x4& og) {
    const int tid = otid(), t = tid >> 3, v8 = (tid & 7) * 8;
    float hs[8]; float ss = 0.f;
#pragma unroll
    for (int e = 0; e < 8; ++e) { hs[e] = H[t * HLD + v8 + e] + H[64 * HLD + t * HLD + v8 + e]; ss += hs[e] * hs[e]; }
    ss += __shfl_xor(ss, 1); ss += __shfl_xor(ss, 2); ss += __shfl_xor(ss, 4);
    const float rinv = rsqrtf(ss * (1.f / 64.f) + EPS);
    const size_t mrow = m0 + t;
    float o[8];
#pragma unroll
    for (int e = 0; e < 8; ++e) { float x = hs[e] * rinv * outn[v8 + e] * bfe(gg, e); if (use_o) x *= bfe(og, e); o[e] = x; }
    st8g((bf16*)(ws + WS_HXY) + mrow * 1024 + colbase + h * 64 + v8, o);
}

struct McPre { float lf, li, nl, mp; u32x4 qp, qc, qn, kp, kc, kn, vraw, gg, og; f32x4 c[2][2]; };
DI McPre mlstm_c_load(unsigned char* ws, int tsk) {
    const int bh = tsk / NCH, cidx = tsk - bh * NCH, b = bh >> 2, h = bh & 3, tid = otid();
    const size_t m0 = (size_t)b * TK + cidx * 64; const ScanPtrs sp = scan_ptrs(ws); McPre p; p.lf = 0.f; p.li = 0.f; p.nl = 0.f; p.mp = 0.f;
    if (tid < 128) { const int dir = tid >> 6, s = tid & 63; const float* sm = (const float*)(ws + WS_SMALL) + (m0 + s) * 48; p.lf = ldg(sm + (2 * dir + 1) * 4 + h); p.li = ldg(sm + (2 * dir) * 4 + h);
        p.nl = ldg(sp.NST + ((size_t)(bh * 2 + dir) * NCH + cidx) * 64 + s); p.mp = ldg(sp.SM + (bh * 2 + dir) * NCH + cidx); }
    const int s = tid >> 3, d0 = (tid & 7) * 8;
    const bool hasp = (s > 0) || (cidx != 0 && cidx != 4), hasn = (s < 63) || (cidx != 3 && cidx != NCH - 1);
    load3((const bf16*)(ws + WS_QB) + (m0 + s) * 256 + h * 64 + d0, hasp, hasn, p.qp, p.qc, p.qn);
    load3((const bf16*)(ws + WS_KB) + (m0 + s) * 256 + h * 64 + d0, hasp, hasn, p.kp, p.kc, p.kn);
    p.vraw = ldg((const u32x4*)((const bf16*)(ws + WS_VBT) + ((size_t)bh * 64 + s) * TK + cidx * 64 + d0));
#pragma unroll
    for (int dir = 0; dir < 2; ++dir) { const float* src = sp.CST + ((size_t)(bh * 2 + dir) * NCH + cidx) * 4096 + s * 64 + d0; p.c[dir][0] = ldg((const f32x4*)src); p.c[dir][1] = ldg((const f32x4*)(src + 4)); }
    p.gg = ldg((const u32x4*)((const bf16*)(ws + WS_GATE) + (m0 + s) * 1024 + 256 + h * 64 + d0));
    p.og = ldg((const u32x4*)((const bf16*)(ws + WS_OB) + (m0 + s) * 256 + h * 64 + d0));
    return p;
}
DI void mlstm_c_run(unsigned char* lds, unsigned char* ws, int tsk, const McPre& p, const float* conv_w, const float* conv_b, const float* outn) {
    const int bh = tsk / NCH, cidx = tsk - bh * NCH, b = bh >> 2, h = bh & 3;
    const int tid = otid(), lane = tid & 63, wave = tid >> 6, l32 = lane & 31, hi = lane >> 5;
    const size_t m0 = (size_t)b * TK + cidx * 64;
    bf16* QS = (bf16*)lds; bf16* KSm = (bf16*)(lds + 9216); bf16* VT = (bf16*)(lds + 18432); bf16* CB = (bf16*)(lds + 27648); bf16* PL = (bf16*)(lds + 46080);
    float* H = (float*)(lds + 64512); float* AA = (float*)(lds + 99328); float* MU = AA + 128; float* GI = MU + 128; float* EN = GI + 128;
    float* NQ = EN + 128; float* RS = NQ + 128; float* NL = RS + 256;
    if (wave < 2) { const int dir = wave; const bool rev = dir == 1;
        const float bcum = wscan_add(p.lf, lane, rev), a = p.li - bcum, cm = wscan_max(a, lane, rev), mu = fmaxf(p.mp, cm);
        AA[dir * 64 + lane] = a; MU[dir * 64 + lane] = mu; GI[dir * 64 + lane] = expf(p.mp - mu); EN[dir * 64 + lane] = expf(-bcum - mu); NL[dir * 64 + lane] = p.nl; }
    { const int s = tid >> 3, d0 = (tid & 7) * 8; float qv[8], kv[8];
      conv8r(p.qp, p.qc, p.qn, conv_w + h * 64 + d0, conv_b + h * 64 + d0, 1.f, qv);
      conv8r(p.kp, p.kc, p.kn, conv_w + 256 + h * 64 + d0, conv_b + 256 + h * 64 + d0, 0.125f, kv);
      st8(QS + s * LD64 + d0, qv); st8(KSm + s * LD64 + d0, kv);
      *(u32x4*)(VT + s * LD64 + d0) = p.vraw;
#pragma unroll
      for (int dir = 0; dir < 2; ++dir) { float cv[8]; getv(p.c[dir][0], p.c[dir][1], cv); st8(CB + dir * (64 * LD64) + s * LD64 + d0, cv); } }
    lbar();
    { const int o = tid >> 2, part = tid & 3, dir = o >> 6, t = o & 63; float a = 0.f;
#pragma unroll
      for (int q = 0; q < 16; ++q) { const int d = part * 16 + q; a += NL[dir * 64 + d] * b2f(QS[t * LD64 + d]); }
      a += __shfl_xor(a, 1); a += __shfl_xor(a, 2);
      if (part == 0) NQ[dir * 64 + t] = a; }
    { const int dir = wave >> 2, tr = (wave >> 1) & 1, tc = wave & 1;
      f32x16 S;
#pragma unroll
      for (int i = 0; i < 16; ++i) S[i] = 0.f;
#pragma unroll
      for (int ks = 0; ks < 4; ++ks) S = MFMA32(ldfrag(KSm, LD64, 32 * tr, 16 * ks, lane), ldfrag(QS, LD64, 32 * tc, 16 * ks, lane), S);
      const int t = 32 * tc + l32; const float mu = MU[dir * 64 + t]; float rs = 0.f;
#pragma unroll
      for (int g = 0; g < 4; ++g) { float pw[4];
#pragma unroll
          for (int e = 0; e < 4; ++e) { const int s = 32 * tr + 8 * g + 4 * hi + e; const bool ok = dir == 0 ? (s <= t) : (s >= t);
              pw[e] = ok ? S[4 * g + e] * __expf(AA[dir * 64 + s] - mu) : 0.f; rs += pw[e]; }
          *(u32x2*)(PL + dir * (64 * LD64) + t * LD64 + 32 * tr + 8 * g + 4 * hi) = (u32x2){pk(pw[0], pw[1]), pk(pw[2], pw[3])}; }
      rs += __shfl_xor(rs, 32);
      if (hi == 0) RS[(dir * 2 + tr) * 64 + t] = rs; }
    lbar();
    { const int dir = wave >> 2, vr = (wave >> 1) & 1, tc = wave & 1;
      f32x16 aP, aC;
#pragma unroll
      for (int i = 0; i < 16; ++i) { aP[i] = 0.f; aC[i] = 0.f; }
#pragma unroll
      for (int ks = 0; ks < 4; ++ks) { aP = MFMA32(ldfrag(VT, LD64, 32 * vr, 16 * ks, lane), ldfrag(PL + dir * (64 * LD64), LD64, 32 * tc, 16 * ks, lane), aP);
          aC = MFMA32(ldfrag(CB + dir * (64 * LD64), LD64, 32 * vr, 16 * ks, lane), ldfrag(QS, LD64, 32 * tc, 16 * ks, lane), aC); }
      const int t = 32 * tc + l32; const float gi = GI[dir * 64 + t];
      const float nq = RS[(dir * 2) * 64 + t] + RS[(dir * 2 + 1) * 64 + t] + gi * NQ[dir * 64 + t];
      const float inv = 1.f / fmaxf(fabsf(nq), EN[dir * 64 + t]);
#pragma unroll
      for (int i = 0; i < 16; ++i) H[dir * (64 * HLD) + t * HLD + 32 * vr + crow(i, hi)] = (aP[i] + gi * aC[i]) * inv; }
    lbar();
    chunk_finish(H, ws, m0, 256, h, outn, true, p.gg, p.og);
    lbar();
}

struct GcPre { GlPre g; u32x4 gg; float st[2][4]; };
DI GcPre gla_c_load(unsigned char* ws, int tsk) {
    const int bh = tsk / NCH, cidx = tsk - bh * NCH, b = bh >> 2, h = bh & 3, tid = otid(); const ScanPtrs sp = scan_ptrs(ws);
    const size_t m0 = (size_t)b * TK + cidx * 64; GcPre p; p.g = gla_load(ws, tsk, true);
    p.gg = ldg((const u32x4*)((const bf16*)(ws + WS_GATE) + (m0 + (tid >> 3)) * 1024 + 512 + h * 64 + (tid & 7) * 8));
#pragma unroll
    for (int z = 0; z < 2; ++z) { const float* src = sp.SST + ((size_t)(bh * 2 + z) * NCH + cidx) * 2048;
#pragma unroll
        for (int it = 0; it < 4; ++it) p.st[z][it] = ldg(src + tid + 512 * it); }
    return p;
}
DI void gla_c_run(unsigned char* lds, unsigned char* ws, int tsk, const GcPre& p, const float* wg, const float* bg, const float* outn) {
    const int bh = tsk / NCH, cidx = tsk - bh * NCH, b = bh >> 2, h = bh & 3;
    const int tid = otid(), lane = tid & 63, wave = tid >> 6, l32 = lane & 31, hi = lane >> 5;
    const size_t m0 = (size_t)b * TK + cidx * 64;
    bf16* QT = (bf16*)lds; bf16* KT2 = (bf16*)(lds + 10240); bf16* QH = (bf16*)(lds + 20480); bf16* VT = (bf16*)(lds + 30720);
    bf16* ST = (bf16*)(lds + 39936); bf16* PL = (bf16*)(lds + 50176); float* H = (float*)(lds + 68608);
    { const int wu = __builtin_amdgcn_readfirstlane(wave), z = wu >> 2, dg = wu & 3; float bc[8]; gla_bc(p.g, h, z, dg, lane, wg, bg, bc);
      float q1[8], k1[8], q2[8];
#pragma unroll
      for (int e = 0; e < 8; ++e) { const float rf = __shfl(bc[e], 32); const float qv = bfe(p.g.qraw, e);
          q1[e] = qv * __expf(bc[e] - rf); k1[e] = bfe(p.g.kraw, e) * __expf(rf - bc[e]); q2[e] = qv * __expf(bc[e]); }
      st8(QT + z * (64 * LD32) + lane * LD32 + dg * 8, q1); st8(KT2 + z * (64 * LD32) + lane * LD32 + dg * 8, k1); st8(QH + z * (64 * LD32) + lane * LD32 + dg * 8, q2); }
    *(u32x4*)(VT + (tid >> 3) * LD64 + (tid & 7) * 8) = p.g.vraw;
#pragma unroll
    for (int z = 0; z < 2; ++z)
#pragma unroll
        for (int it = 0; it < 4; ++it) { const int idx = tid + 512 * it, d = idx >> 6, v = idx & 63; ST[z * (64 * LD32) + v * LD32 + d] = f2b(p.st[z][it]); }
    lbar();
    { const int z = wave >> 2, tr = (wave >> 1) & 1, tc = wave & 1;
      f32x16 S;
#pragma unroll
      for (int i = 0; i < 16; ++i) S[i] = 0.f;
#pragma unroll
      for (int ks = 0; ks < 2; ++ks) S = MFMA32(ldfrag(KT2 + z * (64 * LD32), LD32, 32 * tr, 16 * ks, lane), ldfrag(QT + z * (64 * LD32), LD32, 32 * tc, 16 * ks, lane), S);
      const int t = 32 * tc + l32;
#pragma unroll
      for (int g = 0; g < 4; ++g) { float pw[4];
#pragma unroll
          for (int e = 0; e < 4; ++e) { const int s = 32 * tr + 8 * g + 4 * hi + e; const bool ok = z == 0 ? (s <= t) : (s >= t); pw[e] = ok ? S[4 * g + e] : 0.f; }
          *(u32x2*)(PL + z * (64 * LD64) + t * LD64 + 32 * tr + 8 * g + 4 * hi) = (u32x2){pk(pw[0], pw[1]), pk(pw[2], pw[3])}; } }
    lbar();
    { const int z = wave >> 2, vr = (wave >> 1) & 1, tc = wave & 1;
      f32x16 a;
#pragma unroll
      for (int i = 0; i < 16; ++i) a[i] = 0.f;
#pragma unroll
      for (int ks = 0; ks < 4; ++ks) a = MFMA32(ldfrag(VT, LD64, 32 * vr, 16 * ks, lane), ldfrag(PL + z * (64 * LD64), LD64, 32 * tc, 16 * ks, lane), a);
#pragma unroll
      for (int ks = 0; ks < 2; ++ks) a = MFMA32(ldfrag(ST + z * (64 * LD32), LD32, 32 * vr, 16 * ks, lane), ldfrag(QH + z * (64 * LD32), LD32, 32 * tc, 16 * ks, lane), a);
      const int t = 32 * tc + l32;
#pragma unroll
      for (int i = 0; i < 16; ++i) H[z * (64 * HLD) + t * HLD + 32 * vr + crow(i, hi)] = a[i]; }
    lbar();
    chunk_finish(H, ws, m0, 512, h, outn, false, p.gg, p.gg);
    lbar();
}


#ifndef DUP_MASK
#define DUP_MASK 0
#endif
#define XB_TMO      128
#define XB_XCNT(j)  (256  + 64 * (j))
#define XB_XSUB(j)  (1280 + 64 * (j))
#define XB_XGEN(j)  (2304 + 64 * (j))
#define XB_TOP      3328
#define XB_TOPGEN   3392
#define XCD_BAR_WORDS 3456
#define XB_SPIN_CAP (1u << 18)

__device__ __forceinline__ unsigned xb_ld(unsigned* p)              { return __hip_atomic_load(p, __ATOMIC_RELAXED, __HIP_MEMORY_SCOPE_AGENT); }
__device__ __forceinline__ unsigned xb_add(unsigned* p, unsigned v) { return __hip_atomic_fetch_add(p, v, __ATOMIC_RELAXED, __HIP_MEMORY_SCOPE_AGENT); }
__device__ __forceinline__ unsigned xb_xcc_id() { return (unsigned)__builtin_amdgcn_s_getreg((3 << 11) | 20) & 0xFu; }
#define XB_SPIN(cond, bar) do { unsigned _sp = 0; while (cond) { __builtin_amdgcn_s_sleep(1); \
    if ((++_sp & 255u) == 0u) { if (xb_ld(&(bar)[XB_TMO])) break; if (_sp > XB_SPIN_CAP) { atomicAdd(&(bar)[XB_TMO], 1u); break; } } } } while (0)

struct XcdBarrier {
    unsigned* bar; unsigned x;
    volatile unsigned* st;
};

__device__ __forceinline__ XcdBarrier xcd_barrier_post(unsigned* bar, volatile unsigned* st) {
    XcdBarrier b; b.bar = bar; b.x = xb_xcc_id(); b.st = st;
    if (threadIdx.x == 0) (void)xb_add(&bar[XB_XCNT(b.x)], 1u);
    return b;
}
__device__ __forceinline__ void xcd_barrier_complete(unsigned* bar, unsigned x, unsigned& nloc, unsigned& nx) {
    const unsigned G = gridDim.x * gridDim.y * gridDim.z;
    unsigned sum, cnt, mine, sp = 0u;
    for (;;) {
        sum = 0u; cnt = 0u; mine = 0u;
#pragma unroll
        for (unsigned j = 0; j < 16; ++j) { const unsigned c = xb_ld(&bar[XB_XCNT(j)]); sum += c; cnt += (c > 0u) ? 1u : 0u; mine = (j == x) ? c : mine; }
        if (sum == G) break;
        __builtin_amdgcn_s_sleep(1);
        if ((++sp & 255u) == 0u) { if (xb_ld(&bar[XB_TMO])) break; if (sp > XB_SPIN_CAP) { atomicAdd(&bar[XB_TMO], 1u); break; } }
    }
    nloc = mine > 0u ? mine : 1u; nx = cnt > 0u ? cnt : 1u;
}

__device__ __forceinline__ void xcd_barrier(const XcdBarrier& b) {
    asm volatile("s_waitcnt vmcnt(0)" ::: "memory");
    __syncthreads();
    if (threadIdx.x == 0) {
        unsigned* bar = b.bar;
        __builtin_amdgcn_s_waitcnt(0);
        unsigned nloc = b.st[0], nx = b.st[1];
        if (nloc == 0u) { xcd_barrier_complete(bar, b.x, nloc, nx); b.st[0] = nloc; b.st[1] = nx; }
        const unsigned old = xb_add(&bar[XB_XSUB(b.x)], 1u);
        const unsigned gen = old / nloc;
        if (old + 1u == (gen + 1u) * nloc) {
            __builtin_amdgcn_fence(__ATOMIC_RELEASE, "agent");
            asm volatile("s_waitcnt vmcnt(0)" ::: "memory");
            const unsigned og = xb_add(&bar[XB_TOP], 1u);
            const unsigned tg = og / nx;
            if (og + 1u == (tg + 1u) * nx) xb_add(&bar[XB_TOPGEN], 1u);
            else XB_SPIN(xb_ld(&bar[XB_TOPGEN]) == tg, bar);
            __builtin_amdgcn_fence(__ATOMIC_ACQUIRE, "agent");
            xb_add(&bar[XB_XGEN(b.x)], 1u);
            asm volatile("s_waitcnt vmcnt(0)" ::: "memory");
        } else {
            XB_SPIN(xb_ld(&bar[XB_XGEN(b.x)]) == gen, bar);
            __builtin_amdgcn_fence(__ATOMIC_ACQUIRE, "agent");
            asm volatile("s_waitcnt vmcnt(0)" ::: "memory");
        }
    }
    __syncthreads();
}

DI void gbar(unsigned* cnt, unsigned target) {
    asm volatile("s_waitcnt vmcnt(0) lgkmcnt(0)" ::: "memory");
    __syncthreads();
    if (threadIdx.x == 0) {
        __builtin_amdgcn_fence(__ATOMIC_RELEASE, "agent");
        __hip_atomic_fetch_add(cnt, 1u, __ATOMIC_RELAXED, __HIP_MEMORY_SCOPE_AGENT);
        while (__hip_atomic_load(cnt, __ATOMIC_RELAXED, __HIP_MEMORY_SCOPE_AGENT) < target) __builtin_amdgcn_s_sleep(1);
        __builtin_amdgcn_fence(__ATOMIC_ACQUIRE, "agent");
    }
    __syncthreads();
}
#define GSYNC() do { XcdBarrier xb_; xb_.bar = (unsigned*)(ws + WS_XBAR); xb_.x = xb_xcc_id(); xb_.st = (volatile unsigned*)(lds + LDS_BYTES - 64); xcd_barrier(xb_); if ((DUP_MASK) & 256) xcd_barrier(xb_); } while (0)
#define DUPN(bit) (((DUP_MASK) & (bit)) ? 2 : 1)
__global__ void __launch_bounds__(512, 2) fwd_kernel(Args a) {
    extern __shared__ __attribute__((aligned(16))) unsigned char lds[];
    cg::grid_group grid = cg::this_grid();
#ifdef PAD_NOPS
    asm volatile(".rept " PAD_NOPS "\n s_nop 0\n .endr" ::: );
#endif
    unsigned char* ws = a.ws;
    int tid = threadIdx.x, lane = tid & 63, wave = __builtin_amdgcn_readfirstlane(tid >> 6);
    const int G = gridDim.x, bid = blockIdx.x;
    float* MODV = (float*)(ws + WS_MODV); float* MISC = (float*)(ws + WS_MISC);
    if (bid == 0 && tid < 24) ((const float**)(ws + WS_ARGS))[tid] = tid < 23 ? a.in[tid] : (const float*)a.out;
    volatile unsigned* xst = (volatile unsigned*)(lds + LDS_BYTES - 64);
    if (tid < 2) xst[tid] = 0u;
    __syncthreads();
    (void)xcd_barrier_post((unsigned*)(ws + WS_XBAR), xst);


    for (int rep = 0; rep < DUPN(128); ++rep) {
        for (int task = bid; task < 96; task += G) {
            const int l = task / 48, n0 = (task % 48) * 64, n = n0 + lane;
            const float* wm = a.in[4] + (size_t)l * 1024 * 3072; const float* c = a.in[1]; const float* cc = a.in[3];
            float* SV = (float*)lds;
            for (int i = tid; i < 3072; i += 512) { const float x = i < 2048 ? c[i] : cc[i - 2048]; SV[i] = silu_(x); }
            __syncthreads();
            float a0 = 0.f, a1 = 0.f, a2 = 0.f;
            for (int k0 = 0; k0 < 128; k0 += 32) { float w[32];
#pragma unroll
                for (int kk = 0; kk < 32; ++kk) w[kk] = wm[(size_t)(wave * 128 + k0 + kk) * 3072 + n];
#pragma unroll
                for (int kk = 0; kk < 32; ++kk) { const int k = wave * 128 + k0 + kk; a0 += SV[k] * w[kk]; a1 += SV[1024 + k] * w[kk]; a2 += SV[2048 + k] * w[kk]; } }
            float* red = (float*)(lds + 131072);
            red[(wave * 3 + 0) * 64 + lane] = a0; red[(wave * 3 + 1) * 64 + lane] = a1; red[(wave * 3 + 2) * 64 + lane] = a2;
            __syncthreads();
            if (tid < 192) { const int v = tid >> 6; float s = a.in[5][l * 3072 + n0 + lane];
                for (int w = 0; w < 8; ++w) s += red[(w * 3 + v) * 64 + lane];
                MODV[(l * 3 + v) * 3072 + n0 + lane] = s; }
            __syncthreads();
        }
        if (bid == G - 1) {
            float* tabA = (float*)(ws + WS_TABA); float* tabD = (float*)(ws + WS_TABD);
            for (int idx = tid; idx < 128 * 8; idx += 512) { const int pos = idx >> 3, i = idx & 7;
                const float inv = exp2f(-(float)i * (13.287712379549449f / 8.f)); const float ang = (float)pos * inv;
                double rev = (double)ang * 0.15915494309189535; rev -= rint(rev);
                tabA[pos * 16 + i] = __builtin_amdgcn_cosf((float)rev); tabA[pos * 16 + 8 + i] = __builtin_amdgcn_sinf((float)rev); }
            for (int idx = tid; idx < 128 * 16; idx += 512) { const int pos = idx >> 4, i = idx & 15;
                const float inv = exp2f(-(float)i * (13.287712379549449f / 16.f)); const float ang = (float)pos * inv;
                double rev = (double)ang * 0.15915494309189535; rev -= rint(rev);
                tabD[pos * 32 + i] = __builtin_amdgcn_cosf((float)rev); tabD[pos * 32 + 16 + i] = __builtin_amdgcn_sinf((float)rev); }
            if (tid < 2) { const int l = tid; const float* lp = a.in[11] + l * 128; float s1 = 0.f, s2 = 0.f;
                for (int d = 0; d < 32; ++d) { s1 += lp[d] * lp[32 + d]; s2 += lp[64 + d] * lp[96 + d]; }
                const float lam_init = 0.8f - 0.6f * expf(-0.3f * (float)l);
                float gq = 0.f, gk = 0.f, gqd = 0.f, gkd = 0.f, sk = 0.f;
                for (int d = 0; d < 32; ++d) { gq = fmaxf(gq, fabsf(a.in[9][l * 32 + d])); gk = fmaxf(gk, fabsf(a.in[10][l * 32 + d])); }
                for (int d = 0; d < 64; ++d) { gqd = fmaxf(gqd, fabsf(a.in[20][l * 64 + d])); gkd = fmaxf(gkd, fabsf(a.in[21][l * 64 + d])); }
                for (int d = 0; d < 4; ++d) sk = fmaxf(sk, a.in[22][l * 4 + d] * LOG2E);
                MISC[l * 8 + 0] = expf(s1) - expf(s2) + lam_init; MISC[l * 8 + 1] = lam_init;
                MISC[l * 8 + 2] = 5.656854249f * LOG2E * gq * gk * 1.01f; MISC[l * 8 + 3] = fmaxf(8.f * LOG2E * gqd * gkd * 1.01f, sk); }
        }
        float* scr = (float*)(lds + wave * 16384);
        const int gw = bid * 8 + wave, NGW = G * 8;
        for (int it = gw; it < 2048; it += NGW) {
            if (it < 4096) { const int l = it >> 11; transpose_item(a.in[7] + (size_t)l * 1024 * NSRC, NSRC, true, (bf16*)(ws + WS_WIN) + (size_t)l * NP * 1024, 1024, it & 2047, NP / 32, scr, lane); }
            else { const int r = it - 4096, l = r >> 9; transpose_item(a.in[8] + (size_t)l * 1024 * 1024, 1024, false, (bf16*)(ws + WS_WOUT) + (size_t)l * 1024 * 1024, 1024, r & 511, 32, scr, lane); }
        }
    }
    if (a.ws == nullptr) grid.sync();
    GSYNC();

#pragma unroll 1
    for (int l = 0; l < 2; ++l) {
        asm volatile("" : "+s"(ws));
        const float* const* IN = (const float* const*)(ws + WS_ARGS); float* OUT = (float*)IN[23];
        const float* xsrc = l == 0 ? IN[0] : OUT; const float* csrc = l == 0 ? IN[2] : (const float*)(ws + WS_CTX);
        tid = otid(); lane = tid & 63; wave = __builtin_amdgcn_readfirstlane(tid >> 6);
        {
            const int gw = bid * 8 + wave, NGW = G * 8; const float* ng = IN[6] + l * 1024;
            for (int rep = 0; rep < DUPN(1); ++rep)
            for (int m0 = gw; m0 < M; m0 += 2 * NGW) {
                const float* srcs[2]; int vs[2]; bool ok[2]; f32x4 x[2][4];
#pragma unroll
                for (int r = 0; r < 2; ++r) { const int m = m0 + r * NGW; ok[r] = m < M; const int mm = ok[r] ? m : m0;
                    const int b = mm >= TK ? 1 : 0, j = mm - b * TK;
                    if (j < LC) { srcs[r] = csrc + (size_t)(b * LC + j) * D; vs[r] = 2; } else { srcs[r] = xsrc + (size_t)(b * T + j - LC) * D; vs[r] = b; }
#pragma unroll
                    for (int q = 0; q < 4; ++q) x[r][q] = ldg((const f32x4*)srcs[r] + lane + 64 * q); }
#pragma unroll
                for (int r = 0; r < 2; ++r) { if (!ok[r]) continue; const int m = m0 + r * NGW;
                    const float* md = MODV + (l * 3 + vs[r]) * 3072; float ss = 0.f;
#pragma unroll
                    for (int q = 0; q < 4; ++q) ss += (x[r][q].x * x[r][q].x + x[r][q].y * x[r][q].y) + (x[r][q].z * x[r][q].z + x[r][q].w * x[r][q].w);
                    const float rinv = rsqrtf(wave_sum(ss) * (1.f / 1024.f) + EPS);
                    bf16* dst = (bf16*)(ws + WS_HXY) + (size_t)m * D;
#pragma unroll
                    for (int q = 0; q < 4; ++q) { const int col = 4 * (lane + 64 * q);
                        const f32x4 g = ldg((const f32x4*)(ng + col)), sh = ldg((const f32x4*)(md + col)), sc = ldg((const f32x4*)(md + 1024 + col));
                        const f32x4 y = (x[r][q] * rinv) * g * (sc + 1.f) + sh;
                        stg((u32x2*)(dst + col), (u32x2){pk(y.x, y.y), pk(y.z, y.w)}); } }
            }
        }
        GSYNC();
        {
            pg8::Gemm g{(const pg8::bf16_t*)(ws + WS_HXY), (const pg8::bf16_t*)(ws + WS_WIN) + (size_t)l * NP * 1024, M, NP, D};
            pg8::StaticOrder S; S.init(M, NP, G, bid);
            EpiIn E{ws, l};
            for (int rep = 0; rep < DUPN(2); ++rep) pg8::gemm_phase<EpiIn, pg8::StaticOrder, true, true>((PG8_LAS unsigned char*)lds, g, S, E);
        }
        GSYNC();
        {
            const float* misc = MISC + l * 8;
            fill_wcache(lds, IN, l);
            for (int rep = 0; rep < DUPN(4); ++rep) {
                { const float* cw = (const float*)(lds + WC_OFF) + WC_CW; const float* cb = (const float*)(lds + WC_OFF) + WC_CB;
                  int t = bid; MaPre cur = mlstm_a_load(ws, t < 8 * NCH ? t : 0);
                  while (t < 8 * NCH) { const int tn = t + G; MaPre nxt = mlstm_a_load(ws, tn < 8 * NCH ? tn : t); mlstm_a_run(lds, ws, t, cur, cw, cb); cur = nxt; t = tn; } }
                { const float* wg = (const float*)(lds + WC_OFF) + WC_WG; const float* bg = (const float*)(lds + WC_OFF) + WC_BG;
                  int t = bid; GlPre cur = gla_load(ws, t < 8 * NCH ? t : 0, false);
                  while (t < 8 * NCH) { const int tn = t + G; GlPre nxt = gla_load(ws, tn < 8 * NCH ? tn : t, false); gla_a_run(lds, ws, t, cur, wg, bg); cur = nxt; t = tn; } }
            }
            const int nU = l == 0 ? 264 : 256;
            for (int rep = 0; rep < DUPN(8); ++rep)
            for (int u = bid; u < nU; u += G) attnD_unit(lds, ws, u, IN[22] + l * 4, misc);
            for (int rep = 0; rep < DUPN(16); ++rep)
            for (int u = bid; u < nU; u += G) attnA_unit(lds, ws, u, IN[12] + l * 64, misc);
        }
        GSYNC();
        for (int t = bid; t < 208; t += G) scan_b(lds, ws, t);
        if (l == 0) {
            float* scr = (float*)(lds + wave * 16384);
            for (int it = 2048 + bid * 8 + wave; it < 2 * 2048 + 2 * 512; it += G * 8) {
                if (it < 4096) { transpose_item(IN[7] + (size_t)1024 * NSRC, NSRC, true, (bf16*)(ws + WS_WIN) + (size_t)NP * 1024, 1024, it & 2047, NP / 32, scr, lane); }
                else { const int r = it - 4096, ll = r >> 9; transpose_item(IN[8] + (size_t)ll * 1024 * 1024, 1024, false, (bf16*)(ws + WS_WOUT) + (size_t)ll * 1024 * 1024, 1024, r & 511, 32, scr, lane); }
            }
            __syncthreads();
        }
        GSYNC();
        fill_wcache(lds, IN, l);
        for (int rep = 0; rep < DUPN(32); ++rep) {
            const int ncl = l == 0 ? NCH : NCH - 4, ntask = 8 * ncl;
#define C_TASK(u) (((u) / ncl) * NCH + ((u) % ncl) + (NCH - ncl))
            { const float* cw = (const float*)(lds + WC_OFF) + WC_CW; const float* cb = (const float*)(lds + WC_OFF) + WC_CB; const float* on = (const float*)(lds + WC_OFF) + WC_BON;
              int u = bid; McPre cur = mlstm_c_load(ws, C_TASK(u < ntask ? u : 0));
              while (u < ntask) { const int un = u + G; McPre nxt = mlstm_c_load(ws, C_TASK(un < ntask ? un : u)); mlstm_c_run(lds, ws, C_TASK(u), cur, cw, cb, on); cur = nxt; u = un; } }
            { const float* wg = (const float*)(lds + WC_OFF) + WC_WG; const float* bg = (const float*)(lds + WC_OFF) + WC_BG; const float* on = (const float*)(lds + WC_OFF) + WC_CON;
              int u = bid; GcPre cur = gla_c_load(ws, C_TASK(u < ntask ? u : 0));
              while (u < ntask) { const int un = u + G; GcPre nxt = gla_c_load(ws, C_TASK(un < ntask ? un : u)); gla_c_run(lds, ws, C_TASK(u), cur, wg, bg, on); cur = nxt; u = un; } }
        }
        GSYNC();
        {
            pg8::Gemm g{(const pg8::bf16_t*)(ws + WS_HXY), (const pg8::bf16_t*)(ws + WS_WOUT) + (size_t)l * 1024 * 1024, M, D, D};
            EpiOut E{xsrc, csrc, OUT, (float*)(ws + WS_CTX), MODV + l * 3 * 3072};
            if (l == 0) { pg8::StaticOrder S; S.init(M, D, G, bid); for (int rep = 0; rep < DUPN(64); ++rep) pg8::gemm_phase<EpiOut, pg8::StaticOrder, true, true>((PG8_LAS unsigned char*)lds, g, S, E); }
            else { LatOrder S; S.so.init(NB * T, D, G, bid); pg8::gemm_phase<EpiOut, LatOrder, true, true>((PG8_LAS unsigned char*)lds, g, S, E); }
        }
        if (l == 0) GSYNC();
    }
}

extern "C" void kernel_launch(void* const* d_in, const int* in_sizes, int n_in, void* d_out, int out_size, void* d_ws, size_t ws_size, hipStream_t stream) {
    static int grid = 0;
    if (grid == 0) {
        int dev = 0, cus = 0, per_cu = 0;
        if (n_in != 23 || ws_size < 256 * MiB) { fprintf(stderr, "kernel_launch: unexpected inputs (n_in %d, ws %zu)\n", n_in, ws_size); grid = -1; return; }
        hipGetDevice(&dev); hipDeviceGetAttribute(&cus, hipDeviceAttributeMultiprocessorCount, dev);
        if (hipFuncSetAttribute((const void*)fwd_kernel, hipFuncAttributeMaxDynamicSharedMemorySize, LDS_BYTES) != hipSuccess) { fprintf(stderr, "kernel_launch: hipFuncSetAttribute failed\n"); grid = -1; return; }
        if (hipOccupancyMaxActiveBlocksPerMultiprocessor(&per_cu, (const void*)fwd_kernel, 512, LDS_BYTES) != hipSuccess || per_cu < 1) { fprintf(stderr, "kernel_launch: occupancy query says %d\n", per_cu); per_cu = 1; }
        (void)hipGetLastError();
        grid = cus > 0 ? cus : 256;
    }
    if (grid < 0) return;
    Args a{};
    for (int i = 0; i < 23; ++i) a.in[i] = (const float*)d_in[i];
    a.out = (float*)d_out; a.ws = (unsigned char*)d_ws;
    if (hipMemsetAsync((char*)d_ws + WS_XBAR, 0, 16384, stream) != hipSuccess) { fprintf(stderr, "kernel_launch: memset of the barrier word failed\n"); return; }
    void* args[] = {&a};
    hipError_t e = hipLaunchCooperativeKernel((const void*)fwd_kernel, dim3(grid), dim3(512), args, LDS_BYTES, stream);
    if (e != hipSuccess) fprintf(stderr, "kernel_launch: cooperative launch failed: %s (grid %d)\n", hipGetErrorString(e), grid);
}
```

```cpp
#include <hip/hip_runtime.h>
#include <hip/hip_cooperative_groups.h>
#include <cstdio>
#include <cstdint>
namespace cg = cooperative_groups;
#define DUP_MASK 0
#define PAD_NOPS "7"
#define USE_MINI
namespace pg8 {
#define PG8_LAS __attribute__((address_space(3)))
typedef unsigned short bf16_t;
typedef short bf16x8 __attribute__((ext_vector_type(8)));
typedef float f32x4 __attribute__((ext_vector_type(4)));
typedef unsigned u32x4 __attribute__((ext_vector_type(4)));
constexpr int BM = 256, BK = 64, HALF = 128, HTB = HALF * BK * 2  , STAGE_BYTES = 8 * HTB, NXCD = 8, WGM = 8;

__host__ __device__ __forceinline__ int lds_byte(int r, int c) { const int st = (r >> 4) * 2 + (c >> 5), rr = r & 15, cc = c & 31, ob = rr * 64 + cc * 2; return st * 1024 + (ob ^ (((ob >> 9) & 1) << 5)); }
__host__ __device__ __forceinline__ void stage_rc(int b, int& R, int& C) { const int st = b / 1024, sb = b % 1024, swz = sb ^ (((sb >> 9) & 1) << 5); R = (st >> 1) * 16 + swz / 64; C = (st & 1) * 32 + (swz % 64) / 2; }
__host__ __device__ __forceinline__ int perm32(int rho) { const int n = rho >> 4, i = rho & 15; return 8 * (i >> 2) + 4 * n + (i & 3); }

struct Unit { int pm, pn; };
struct Gemm { const bf16_t* A; const bf16_t* Bt; int M, N, K; };

struct StaticOrder {
    int nM, nN, nwg, G, c;
    __host__ __device__ void init(int M, int N, int G_, int c_) { nM = M / BM; nN = N / BM; nwg = nM * nN; G = G_; c = c_; }
    __host__ __device__ bool next(int i, Unit& u) const {
        const long L = (long)i * G + c; if (L >= nwg) return false;
        int wgid = (int)L; { const int q = nwg / NXCD, r = nwg % NXCD, xcd = wgid % NXCD, off = wgid / NXCD; wgid = (xcd < r ? xcd * (q + 1) : r * (q + 1) + (xcd - r) * q) + off; }
        const int nig = WGM * nN, gid = wgid / nig, fm = gid * WGM, gsz = (nM - fm) < WGM ? (nM - fm) : WGM;
        u.pm = fm + ((wgid % nig) % gsz); u.pn = (wgid % nig) / gsz; return true;
    }
    __device__ __forceinline__ void a_ready(const Unit&) const {}
    __device__ __forceinline__ void done(const Unit&) const {}
};

__device__ __forceinline__ unsigned cvt_pk_bf16(float lo, float hi) { unsigned r; asm volatile("v_cvt_pk_bf16_f32 %0, %1, %2" : "=v"(r) : "v"(lo), "v"(hi)); return r; }
typedef float f32x2 __attribute__((ext_vector_type(2)));
template <class Epi, class Sched, bool ALIGN_EPI = false, bool SP2 = false>
__device__ __forceinline__ void gemm_phase(PG8_LAS unsigned char* lds, const Gemm g, const Sched& S, const Epi& E) {
    int tid_ = threadIdx.x; asm volatile("" : "+v"(tid_)); const int tid = tid_, wid = __builtin_amdgcn_readfirstlane(tid >> 6), lane = tid & 63, wr = wid >> 2, wc = wid & 3, fr = lane & 15, fq = lane >> 4;
    const int K = g.K, nt = K / BK;
    unsigned voffA[2], voffB[2];
#pragma unroll
    for (int i = 0; i < 2; ++i) { int R, C; stage_rc(tid * 16 + i * 8192, R, C); const int Rb = Epi::PERM ? ((R & ~31) + perm32(R & 31)) : R;
        voffA[i] = (unsigned)(R * K + C) * 2u; voffB[i] = (unsigned)(Rb * K + C) * 2u; }
    const size_t kstep = (size_t)(BK * 2);
    const size_t hstep = (size_t)HALF * K * 2;
    const size_t tstep = 2 * hstep;
    const unsigned ldsw = (unsigned)wid * 1024u;
    const int aoff = lds_byte(wr * 64 + fr, fq * 8), boff = lds_byte(wc * 32 + fr, fq * 8);
#define PG8_SA(b, h) (((b) * 2 + (h)) * HTB)
#define PG8_SB(b, h) ((4 + (b) * 2 + (h)) * HTB)
#define PG8_STAGE(bufoff, gbase, voff) do { _Pragma("unroll") for (int _i = 0; _i < 2; ++_i) \
        __builtin_amdgcn_global_load_lds((const unsigned*)((const char*)(gbase) + (voff)[_i]), (PG8_LAS unsigned*)(lds + (bufoff) + ldsw + _i * 8192), 16, 0, 0); } while (0)
#define PG8_LDA(dst, b, h) do { _Pragma("unroll") for (int m = 0; m < 4; ++m) _Pragma("unroll") for (int k = 0; k < 2; ++k) dst[m][k] = *(const PG8_LAS bf16x8*)(lds + PG8_SA(b, h) + aoff + m * 2048 + k * 1024); } while (0)
#define PG8_LDB(dst, b, h) do { _Pragma("unroll") for (int n = 0; n < 2; ++n) _Pragma("unroll") for (int k = 0; k < 2; ++k) dst[n][k] = *(const PG8_LAS bf16x8*)(lds + PG8_SB(b, h) + boff + n * 2048 + k * 1024); } while (0)
#define PG8_MMA(ai, bj, At, Bt) do { __builtin_amdgcn_s_setprio(1); _Pragma("unroll") for (int m = 0; m < 4; ++m) _Pragma("unroll") for (int n = 0; n < 2; ++n) _Pragma("unroll") for (int k = 0; k < 2; ++k) \
        acc[ai][bj][m][n] = __builtin_amdgcn_mfma_f32_16x16x32_bf16(Bt[n][k], At[m][k], acc[ai][bj][m][n], 0, 0, 0); __builtin_amdgcn_s_setprio(0); } while (0)
#define PG8_WAIT_V(n) asm volatile("s_waitcnt vmcnt(" #n ")" ::: "memory")
#define PG8_WAIT_L(n) asm volatile("s_waitcnt lgkmcnt(" #n ")" ::: "memory")
#define PG8_BAR __builtin_amdgcn_s_barrier()
#define PG8_SCHED __builtin_amdgcn_sched_barrier(0)
    Unit cur, nxt; int ui = 0;
    if (!S.next(0, cur)) return;
    f32x4 acc[2][2][4][2];
#pragma unroll
    for (int a = 0; a < 2; ++a)
#pragma unroll
        for (int b = 0; b < 2; ++b)
#pragma unroll
            for (int m = 0; m < 4; ++m)
#pragma unroll
                for (int n = 0; n < 2; ++n) acc[a][b][m][n] = (f32x4){0.f, 0.f, 0.f, 0.f};
    bf16x8 At[4][2], B0[2][2], B1[2][2];
    const char* cA = (const char*)g.A + (size_t)cur.pm * tstep; const char* cB = (const char*)g.Bt + (size_t)cur.pn * tstep;
    S.a_ready(cur);
    if constexpr (SP2) {
        PG8_STAGE(PG8_SB(0, 0), cB, voffB); PG8_STAGE(PG8_SB(0, 1), cB + hstep, voffB); PG8_STAGE(PG8_SA(0, 0), cA, voffA); PG8_STAGE(PG8_SA(0, 1), cA + hstep, voffA);
        if (wr == 1) PG8_BAR;
        PG8_WAIT_V(2); PG8_BAR;
        PG8_STAGE(PG8_SB(1, 0), cB + kstep, voffB); PG8_STAGE(PG8_SA(1, 0), cA + kstep, voffA); PG8_STAGE(PG8_SB(1, 1), cB + hstep + kstep, voffB);
        PG8_WAIT_V(6); PG8_BAR;
    } else {
        PG8_STAGE(PG8_SB(0, 0), cB, voffB); PG8_STAGE(PG8_SA(0, 0), cA, voffA); PG8_STAGE(PG8_SB(0, 1), cB + hstep, voffB); PG8_STAGE(PG8_SA(0, 1), cA + hstep, voffA);
        if (wr == 1) PG8_BAR;
        PG8_WAIT_V(4); PG8_BAR;
        PG8_STAGE(PG8_SB(1, 0), cB + kstep, voffB); PG8_STAGE(PG8_SA(1, 0), cA + kstep, voffA); PG8_STAGE(PG8_SB(1, 1), cB + hstep + kstep, voffB);
        PG8_WAIT_V(6); PG8_BAR;
    }
#ifdef PAD_G
    if constexpr (Epi::PADK) asm volatile("s_nop 0");
#endif
    for (;;) {
        const bool has_next = S.next(ui + 1, nxt);
        const char* nA = has_next ? (const char*)g.A + (size_t)nxt.pm * tstep : cA; const char* nB = has_next ? (const char*)g.Bt + (size_t)nxt.pn * tstep : cB;
        for (int t = 0; t < nt; t += 2) {
            const bool last = (t == nt - 2);
            const char* a1 = cA + (size_t)(t + 1) * kstep;
            const char* a2 = last ? nA : cA + (size_t)(t + 2) * kstep; const char* b2 = last ? nB : cB + (size_t)(t + 2) * kstep;
            const char* a3 = a2 + kstep; const char* b3 = b2 + kstep;
            if (last && has_next) S.a_ready(nxt);
            if constexpr (SP2) {
            PG8_LDB(B0, 0, 0); PG8_LDB(B1, 0, 1); PG8_SCHED; PG8_LDA(At, 0, 0); PG8_STAGE(PG8_SA(1, 1), a1 + hstep, voffA);
            PG8_WAIT_V(8); PG8_WAIT_L(0); PG8_BAR; PG8_MMA(0, 0, At, B0); PG8_MMA(0, 1, At, B1); PG8_BAR; PG8_SCHED;
            PG8_LDA(At, 0, 1); PG8_STAGE(PG8_SB(0, 0), b2, voffB); PG8_STAGE(PG8_SB(0, 1), b2 + hstep, voffB); PG8_STAGE(PG8_SA(0, 0), a2, voffA);
            PG8_WAIT_V(8); PG8_WAIT_L(0); PG8_BAR; PG8_MMA(1, 0, At, B0); PG8_MMA(1, 1, At, B1); PG8_BAR; PG8_SCHED;
            PG8_LDB(B0, 1, 0); PG8_LDB(B1, 1, 1); PG8_SCHED; PG8_LDA(At, 1, 0); PG8_STAGE(PG8_SA(0, 1), a2 + hstep, voffA);
            PG8_WAIT_V(8); PG8_WAIT_L(0); PG8_BAR; PG8_MMA(0, 0, At, B0); PG8_MMA(0, 1, At, B1); PG8_BAR; PG8_SCHED;
            PG8_LDA(At, 1, 1); PG8_STAGE(PG8_SB(1, 0), b3, voffB); PG8_STAGE(PG8_SB(1, 1), b3 + hstep, voffB); PG8_STAGE(PG8_SA(1, 0), a3, voffA);
            PG8_WAIT_V(8); PG8_WAIT_L(0); PG8_BAR; PG8_MMA(1, 0, At, B0); PG8_MMA(1, 1, At, B1); PG8_BAR; PG8_SCHED;
            } else {
            PG8_LDB(B0, 0, 0); PG8_SCHED; PG8_LDA(At, 0, 0); PG8_STAGE(PG8_SA(1, 1), a1 + hstep, voffA);
            PG8_WAIT_L(8); PG8_BAR; PG8_WAIT_L(0); PG8_MMA(0, 0, At, B0); PG8_BAR; PG8_SCHED;
            PG8_LDB(B1, 0, 1); PG8_STAGE(PG8_SB(0, 0), b2, voffB);
            PG8_BAR; PG8_WAIT_L(0); PG8_MMA(0, 1, At, B1); PG8_BAR;
            PG8_LDA(At, 0, 1); PG8_STAGE(PG8_SA(0, 0), a2, voffA);
            PG8_BAR; PG8_WAIT_L(0); PG8_MMA(1, 0, At, B0); PG8_BAR; PG8_SCHED;
            PG8_STAGE(PG8_SB(0, 1), b2 + hstep, voffB);
            PG8_WAIT_V(6); PG8_BAR; PG8_MMA(1, 1, At, B1); PG8_BAR;
            PG8_LDB(B0, 1, 0); PG8_SCHED; PG8_LDA(At, 1, 0); PG8_STAGE(PG8_SA(0, 1), a2 + hstep, voffA);
            PG8_WAIT_L(8); PG8_BAR; PG8_WAIT_L(0); PG8_MMA(0, 0, At, B0); PG8_BAR; PG8_SCHED;
            PG8_LDB(B1, 1, 1); PG8_STAGE(PG8_SB(1, 0), b3, voffB);
            PG8_BAR; PG8_WAIT_L(0); PG8_MMA(0, 1, At, B1); PG8_BAR;
            PG8_LDA(At, 1, 1); PG8_STAGE(PG8_SA(1, 0), a3, voffA);
            PG8_BAR; PG8_WAIT_L(0); PG8_MMA(1, 0, At, B0); PG8_BAR; PG8_SCHED;
            PG8_STAGE(PG8_SB(1, 1), b3 + hstep, voffB);
            PG8_WAIT_V(6); PG8_BAR; PG8_MMA(1, 1, At, B1); PG8_BAR;
            }
        }
        if constexpr (ALIGN_EPI) { if (wr == 0) PG8_BAR; }
        if constexpr (!Epi::AFTER_DRAIN) { E(acc, cur, wr, wc, fr, fq); S.done(cur); }
        if (!has_next) break;
#pragma unroll
        for (int a = 0; a < 2; ++a)
#pragma unroll
            for (int b = 0; b < 2; ++b)
#pragma unroll
                for (int m = 0; m < 4; ++m)
#pragma unroll
                    for (int n = 0; n < 2; ++n) acc[a][b][m][n] = (f32x4){0.f, 0.f, 0.f, 0.f};
        cur = nxt; cA = nA; cB = nB; ++ui;
        if constexpr (ALIGN_EPI) { if (wr == 1) PG8_BAR; }
    }
#ifdef PAD_G
    if constexpr (Epi::PADK) asm volatile("s_nop 0");
#endif
    PG8_WAIT_V(0);
    if constexpr (!ALIGN_EPI) { if (wr == 0) PG8_BAR; }
    PG8_BAR;
    if constexpr (Epi::AFTER_DRAIN) { E.fused(acc, cur, wr, wc, fr, fq, lds, wid, lane); S.done(cur); }
#undef PG8_SA
#undef PG8_SB
#undef PG8_STAGE
#undef PG8_LDA
#undef PG8_LDB
#undef PG8_MMA
#undef PG8_WAIT_V
#undef PG8_WAIT_L
#undef PG8_BAR
#undef PG8_SCHED
}
}

#define DI __device__ __forceinline__
typedef unsigned short bf16;
typedef short bf16x8 __attribute__((ext_vector_type(8)));
typedef float f32x4 __attribute__((ext_vector_type(4)));
typedef float f32x16 __attribute__((ext_vector_type(16)));
typedef unsigned u32x4 __attribute__((ext_vector_type(4)));
typedef unsigned u32x2 __attribute__((ext_vector_type(2)));
typedef __bf16 bf16x2_t __attribute__((ext_vector_type(2)));
typedef float f32x2_t __attribute__((ext_vector_type(2)));
#define MFMA32(a, b, c) __builtin_amdgcn_mfma_f32_32x32x16_bf16((a), (b), (c), 0, 0, 0)

constexpr int NB = 2, T = 8192, LC = 256, TK = 8448, M = NB * TK, D = 1024, NSRC = 3888, NP = 4096, NCH = 132;
constexpr float EPS = 1e-6f, LOG2E = 1.4426950408889634f;
constexpr int LDS_BYTES = 147456;

constexpr size_t MiB = 1u << 20;
constexpr size_t S8 = (size_t)M * 256 * 2, S4 = S8 / 2;
constexpr size_t WS_ARGS = 512 * 1024, WS_XBAR = 64 * 1024;
constexpr size_t WS_MODV = 1 * MiB, WS_TABA = WS_MODV + 131072, WS_TABD = WS_TABA + 8192, WS_MISC = WS_TABD + 16384;
constexpr size_t WS_WIN = 2 * MiB, WS_WOUT = 18 * MiB, WS_CTX = 22 * MiB, WS_HXY = 24 * MiB;
constexpr size_t WS_QA = 57 * MiB, WS_KA = WS_QA + S8, WS_VAT = WS_KA + S8, WS_QB = WS_VAT + S8, WS_KB = WS_QB + S8, WS_VBT = WS_KB + S8, WS_OB = WS_VBT + S8;
constexpr size_t WS_QC = WS_OB + S8, WS_KC = WS_QC + S4, WS_VCT = WS_KC + S4, WS_QD = WS_VCT + S8, WS_KD = WS_QD + S8, WS_VDT = WS_KD + S4, WS_GATE = WS_VDT + S4;
constexpr size_t WS_SMALL = WS_GATE + 4 * S8;
constexpr size_t WS_CST = 184 * MiB, WS_NST = 217 * MiB, WS_SSC = WS_NST + 768 * 1024, WS_SST = 218 * MiB, WS_GD = WS_SST + (size_t)16 * NCH * 2048 * 4;
static_assert(WS_SMALL + (size_t)M * 48 * 4 <= WS_CST, "ws map");
static_assert(WS_CST + (size_t)16 * NCH * 4096 * 4 <= WS_NST, "ws map");
static_assert(WS_GD + (size_t)16 * NCH * 32 * 4 <= 256 * MiB, "ws map");

DI unsigned pk(float lo, float hi) { f32x2_t v = {lo, hi}; bf16x2_t b = __builtin_convertvector(v, bf16x2_t); return __builtin_bit_cast(unsigned, b); }
DI bf16 f2b(float x) { return (bf16)(pk(x, 0.f) & 0xffffu); }
DI float b2f(bf16 x) { return __uint_as_float((unsigned)x << 16); }
DI float bfe(const u32x4& v, int e) { const unsigned w = v[e >> 1]; return __uint_as_float((e & 1) ? (w & 0xffff0000u) : (w << 16)); }
DI float bfe2(const u32x2& v, int e) { const unsigned w = v[e >> 1]; return __uint_as_float((e & 1) ? (w & 0xffff0000u) : (w << 16)); }
DI void st8(bf16* p, const float* v) { u32x4 w; w.x = pk(v[0], v[1]); w.y = pk(v[2], v[3]); w.z = pk(v[4], v[5]); w.w = pk(v[6], v[7]); *(u32x4*)p = w; }
DI void st8g(bf16* p, const float* v) { u32x4 w; w.x = pk(v[0], v[1]); w.y = pk(v[2], v[3]); w.z = pk(v[4], v[5]); w.w = pk(v[6], v[7]); *(__attribute__((address_space(1))) u32x4*)p = w; }
DI void st8t(bf16* p, const float* v) {
#pragma unroll
    for (int e = 0; e < 8; ++e) *(__attribute__((address_space(1))) bf16*)(p + (size_t)e * TK) = f2b(v[e]); }
DI float sigmoid_(float x) { return 1.f / (1.f + __expf(-x)); }
DI float silu_(float x) { return x * sigmoid_(x); }
DI float logsigmoid_(float x) { return fminf(x, 0.f) - log1pf(expf(-fabsf(x))); }
DI int crow(int r, int hi) { return (r & 3) + 8 * (r >> 2) + 4 * hi; }
DI float wave_sum(float v) {
#pragma unroll
    for (int o = 1; o < 64; o <<= 1) v += __shfl_xor(v, o);
    return v; }
DI void getv(const f32x4& a, const f32x4& b, float* v) { v[0] = a[0]; v[1] = a[1]; v[2] = a[2]; v[3] = a[3]; v[4] = b[0]; v[5] = b[1]; v[6] = b[2]; v[7] = b[3]; }
DI bf16x8 ldfrag(const bf16* X, int ld, int r0, int k0, int lane) { return *(const bf16x8*)(X + (r0 + (lane & 31)) * ld + k0 + 8 * (lane >> 5)); }

DI int otid() { int t = threadIdx.x; asm volatile("" : "+v"(t)); return t; }
template <class T> DI T ldg(const T* p) { return *(const __attribute__((address_space(1))) T*)p; }
template <class T> DI void stg(T* p, const T& v) { *(__attribute__((address_space(1))) T*)p = v; }
DI void lbar() { asm volatile("s_waitcnt lgkmcnt(0)" ::: "memory"); __builtin_amdgcn_s_barrier(); asm volatile("" ::: "memory"); }
struct Args { const float* in[23]; float* out; unsigned char* ws; };

DI int srccol(int n) {
    const int tile = n >> 8, p = n & 255;
    if (tile < 6) return n;
    if (tile == 6) return 1552 + p;
    if (tile == 7) return 1808 + p;
    if (tile == 8) return 2064 + p;
    if (tile == 9 || tile == 10) {
        const int hh = (p >> 5) & 3, d = ((p >> 7) << 5) + (p & 31);
        if (tile == 9) return 2352 + hh * 64 + d;
        return hh < 2 ? 2608 + hh * 64 + d : 2736 + (hh - 2) * 64 + d;
    }
    if (tile < 15) return 2864 + (n - 11 * 256);
    if (p < 16) return 1536 + p;
    if (p < 48) return 2320 + (p - 16);
    return -1;
}

DI void transpose_item(const float* W, int Nsrc, bool perm, bf16* WT, int K, int item, int nblk, float* scr, int lane) {
    const int kb = item / nblk, nb = item - kb * nblk, k0 = 64 * kb, n0 = 32 * nb;
    const int n = n0 + (lane & 31); const int sc = perm ? srccol(n) : n;
#pragma unroll 8
    for (int i = 0; i < 32; ++i) { const int kk = 2 * i + (lane >> 5); scr[kk * 33 + (lane & 31)] = sc >= 0 ? W[(size_t)(k0 + kk) * Nsrc + sc] : 0.f; }
    asm volatile("s_waitcnt lgkmcnt(0)" ::: "memory");
    const int c = lane & 7;
#pragma unroll
    for (int j = 0; j < 4; ++j) { const int nn = (lane >> 3) + 8 * j; const float* s = scr + (8 * c) * 33 + nn;
        u32x4 o; o.x = pk(s[0 * 33], s[1 * 33]); o.y = pk(s[2 * 33], s[3 * 33]); o.z = pk(s[4 * 33], s[5 * 33]); o.w = pk(s[6 * 33], s[7 * 33]);
        *(u32x4*)(WT + (size_t)(n0 + nn) * K + k0 + 8 * c) = o; }
    asm volatile("s_waitcnt lgkmcnt(0)" ::: "memory");
}

DI void a_head(float* v, const float* gn, bool rope, const float* tab, int fq, float scale) {
    float ss = 0.f;
#pragma unroll
    for (int e = 0; e < 8; ++e) ss += v[e] * v[e];
    ss += __shfl_xor(ss, 16); ss += __shfl_xor(ss, 32);
    const float rinv = rsqrtf(ss * (1.f / 32.f) + EPS);
#pragma unroll
    for (int e = 0; e < 8; ++e) v[e] *= rinv * gn[e];
    if (rope) {
        const f32x4 ca = ldg((const f32x4*)tab), cb = ldg((const f32x4*)(tab + 4)), sa = ldg((const f32x4*)(tab + 8)), sb = ldg((const f32x4*)(tab + 12));
        float c[8], sn[8]; getv(ca, cb, c); getv(sa, sb, sn);
#pragma unroll
        for (int e = 0; e < 8; ++e) { const float p = __shfl_xor(v[e], 16); v[e] = (fq & 1) ? (p * sn[e] + v[e] * c[e]) : (v[e] * c[e] - p * sn[e]); }
    }
#pragma unroll
    for (int e = 0; e < 8; ++e) v[e] *= scale;
}
DI void d_head(float* v0, float* v1, const float* g0, const float* g1, bool rope, const float* tabr, const float* tabc, int fq, float scale) {
    float ss = 0.f;
#pragma unroll
    for (int e = 0; e < 8; ++e) ss += v0[e] * v0[e] + v1[e] * v1[e];
    ss += __shfl_xor(ss, 16); ss += __shfl_xor(ss, 32);
    const float rinv = rsqrtf(ss * (1.f / 64.f) + EPS);
#pragma unroll
    for (int e = 0; e < 8; ++e) { v0[e] *= rinv * g0[e]; v1[e] *= rinv * g1[e]; }
    if (rope) {
        const int fi = 8 * (fq & 1);
        { const f32x4 ca = ldg((const f32x4*)(tabr + fi)), cb = ldg((const f32x4*)(tabr + fi + 4)), sa = ldg((const f32x4*)(tabr + 16 + fi)), sb = ldg((const f32x4*)(tabr + 16 + fi + 4));
          float c[8], sn[8]; getv(ca, cb, c); getv(sa, sb, sn);
#pragma unroll
          for (int e = 0; e < 8; ++e) { const float p0 = __shfl_xor(v0[e], 32); v0[e] = (fq >= 2) ? (p0 * sn[e] + v0[e] * c[e]) : (v0[e] * c[e] - p0 * sn[e]); } }
        asm volatile("" ::: "memory");
        { const f32x4 ca = ldg((const f32x4*)(tabc + fi)), cb = ldg((const f32x4*)(tabc + fi + 4)), sa = ldg((const f32x4*)(tabc + 16 + fi)), sb = ldg((const f32x4*)(tabc + 16 + fi + 4));
          float c[8], sn[8]; getv(ca, cb, c); getv(sa, sb, sn);
#pragma unroll
          for (int e = 0; e < 8; ++e) { const float p1 = __shfl_xor(v1[e], 32); v1[e] = (fq >= 2) ? (p1 * sn[e] + v1[e] * c[e]) : (v1[e] * c[e] - p1 * sn[e]); } }
    }
#pragma unroll
    for (int e = 0; e < 8; ++e) { v0[e] *= scale; v1[e] *= scale; }
}

struct EpiIn {
    static constexpr bool PERM = true, AFTER_DRAIN = false;
#ifdef PAD_GIN
    static constexpr bool PADK = true;
#else
    static constexpr bool PADK = false;
#endif
    unsigned char* ws; int l;
    DI void operator()(const pg8::f32x4 (&acc)[2][2][4][2], const pg8::Unit& u, int wr, int wc, int fr_, int fq_) const {
        int fr = fr_, fq = fq_; asm volatile("" : "+v"(fr), "+v"(fq));
        const int b = u.pm >= 33 ? 1 : 0, pmi = u.pm - 33 * b; const bool is_ctx = (pmi == 0);
        const int j00 = pmi * 256 + wr * 64 + fr, pn = u.pn;
        const float* tabA = (const float*)(ws + WS_TABA); const float* tabD = (const float*)(ws + WS_TABD);
        const float* const* IN = (const float* const*)(ws + WS_ARGS);
#define ROWS_BEGIN _Pragma("unroll") for (int ai = 0; ai < 2; ++ai) _Pragma("unroll") for (int m = 0; m < 4; ++m) { \
        float v0[8], v1[8]; getv(acc[ai][0][m][0], acc[ai][0][m][1], v0); getv(acc[ai][1][m][0], acc[ai][1][m][1], v1); \
        const int j = j00 + ai * 128 + m * 16; const size_t mrow = (size_t)b * TK + j; const int t = is_ctx ? 0 : j - LC; (void)mrow; (void)t;
#define ROWS_END asm volatile("" ::: "memory"); }
        if (pn == 0 || pn == 1) {
            const float* gsrc = IN[pn == 0 ? 9 : 10] + l * 32 + 8 * fq;
            const float scale = pn == 0 ? 0.17677669529663687f * LOG2E : 1.f;
            bf16* dstb = (bf16*)(ws + (pn == 0 ? WS_QA : WS_KA));
            ROWS_BEGIN
                const float* tab = tabA + ((fq < 2) ? (t >> 6) : (t & 63)) * 16;
                float gn[8]; getv(ldg((const f32x4*)gsrc), ldg((const f32x4*)(gsrc + 4)), gn);
                a_head(v0, gn, !is_ctx, tab, fq, scale); a_head(v1, gn, !is_ctx, tab, fq, scale);
                { const int gi = wc, h = gi >> 1, c = gi & 1; st8g(dstb + (((b * 4 + h) * TK + j) * 64 + c * 32 + 8 * fq), v0); }
                { const int gi = 4 + wc, h = gi >> 1, c = gi & 1; st8g(dstb + (((b * 4 + h) * TK + j) * 64 + c * 32 + 8 * fq), v1); }
            ROWS_END
        } else if (pn == 2 || pn == 5 || pn == 8) {
            bf16* dstb = (bf16*)(ws + (pn == 2 ? WS_VAT : (pn == 5 ? WS_VBT : WS_VCT)));
            const int dv0 = (wc & 1) * 32 + 8 * fq;
            ROWS_BEGIN
                st8t(dstb + ((size_t)(b * 4 + (wc >> 1)) * 64 + dv0) * TK + j, v0);
                st8t(dstb + ((size_t)(b * 4 + 2 + (wc >> 1)) * 64 + dv0) * TK + j, v1);
            ROWS_END
        } else if (pn == 3 || pn == 4 || pn == 6) {
            bf16* dstb = (bf16*)(ws + (pn == 3 ? WS_QB : (pn == 4 ? WS_KB : WS_OB)));
            const int c0 = wc * 32 + 8 * fq;
            ROWS_BEGIN
                if (pn == 6) {
#pragma unroll
                    for (int e = 0; e < 8; ++e) { v0[e] = sigmoid_(v0[e]); v1[e] = sigmoid_(v1[e]); } }
                st8g(dstb + mrow * 256 + c0, v0); st8g(dstb + mrow * 256 + 128 + c0, v1);
            ROWS_END
        } else if (pn == 7) {
            bf16* dq = (bf16*)(ws + WS_QC); bf16* dk = (bf16*)(ws + WS_KC); const int c0 = wc * 32 + 8 * fq;
            ROWS_BEGIN
#pragma unroll
                for (int e = 0; e < 8; ++e) v0[e] *= 0.17677669529663687f;
                st8g(dq + mrow * 128 + c0, v0); st8g(dk + mrow * 128 + c0, v1);
            ROWS_END
        } else if (pn == 9) {
            bf16* dstb = (bf16*)(ws + WS_QD); const float* d_qn = IN[20] + l * 64;
            ROWS_BEGIN
                float g0[8], g1[8]; getv(ldg((const f32x4*)(d_qn + 8 * fq)), ldg((const f32x4*)(d_qn + 8 * fq + 4)), g0); getv(ldg((const f32x4*)(d_qn + 32 + 8 * fq)), ldg((const f32x4*)(d_qn + 36 + 8 * fq)), g1);
                d_head(v0, v1, g0, g1, !is_ctx, tabD + (t >> 6) * 32, tabD + (t & 63) * 32, fq, 0.125f * LOG2E);
                bf16* p = dstb + ((((b * 2 + (wc >> 1)) * 2 + (wc & 1)) * TK + j) * 64 + 8 * fq);
                st8g(p, v0); st8g(p + 32, v1);
            ROWS_END
        } else if (pn == 10) {
            if (wc < 2) {
                bf16* dstb = (bf16*)(ws + WS_KD); const float* d_kn = IN[21] + l * 64;
                ROWS_BEGIN
                    float g0[8], g1[8]; getv(ldg((const f32x4*)(d_kn + 8 * fq)), ldg((const f32x4*)(d_kn + 8 * fq + 4)), g0); getv(ldg((const f32x4*)(d_kn + 32 + 8 * fq)), ldg((const f32x4*)(d_kn + 36 + 8 * fq)), g1);
                    d_head(v0, v1, g0, g1, !is_ctx, tabD + (t >> 6) * 32, tabD + (t & 63) * 32, fq, 1.f);
                    bf16* p = dstb + (((b * 2 + wc) * TK + j) * 64 + 8 * fq);
                    st8g(p, v0); st8g(p + 32, v1);
                ROWS_END
            } else {
                bf16* dstb = (bf16*)(ws + WS_VDT);
                ROWS_BEGIN
                    bf16* p = dstb + ((size_t)(b * 2 + (wc - 2)) * 64 + 8 * fq) * TK + j;
                    st8t(p, v0); st8t(p + (size_t)32 * TK, v1);
                ROWS_END
            }
        } else if (pn < 15) {
            bf16* dstb = (bf16*)(ws + WS_GATE); const int c0 = (pn - 11) * 256 + wc * 32 + 8 * fq;
            ROWS_BEGIN
#pragma unroll
                for (int e = 0; e < 8; ++e) { v0[e] = silu_(v0[e]); v1[e] = silu_(v1[e]); }
                st8g(dstb + mrow * 1024 + c0, v0); st8g(dstb + mrow * 1024 + 128 + c0, v1);
            ROWS_END
        } else {
            float* dstb = (float*)(ws + WS_SMALL); const int p0 = wc * 32 + 8 * fq; const float* gate_b = IN[15] + l * 16;
            if (p0 < 48) {
                ROWS_BEGIN
                    if (p0 < 16) {
#pragma unroll
                        for (int e = 0; e < 8; ++e) { const int p = p0 + e, type = p >> 2; float x = v0[e] + ldg(gate_b + p); if (type & 1) x = logsigmoid_(x); v0[e] = x; } }
                    float* o = dstb + mrow * 48 + p0;
                    stg((f32x4*)o, (f32x4){v0[0], v0[1], v0[2], v0[3]}); stg((f32x4*)(o + 4), (f32x4){v0[4], v0[5], v0[6], v0[7]});
                ROWS_END
            }
        }
    }
};

struct EpiOut {
    static constexpr bool PERM = true, AFTER_DRAIN = false;
#ifdef PAD_GOUT
    static constexpr bool PADK = true;
#else
    static constexpr bool PADK = false;
#endif
    const float* xsrc; const float* csrc; float* xdst; float* cdst; const float* modv;
    DI void operator()(const pg8::f32x4 (&acc)[2][2][4][2], const pg8::Unit& u, int wr, int wc, int fr_, int fq_) const {
        int fr = fr_, fq = fq_; asm volatile("" : "+v"(fr), "+v"(fq));
        const int b = u.pm >= 33 ? 1 : 0, pmi = u.pm - 33 * b; const bool is_ctx = (pmi == 0);
        const int j00 = pmi * 256 + wr * 64 + fr, col0 = u.pn * 256 + wc * 32 + 8 * fq;
        const float* gt = modv + (is_ctx ? 2 : b) * 3072 + 2048 + col0;
        f32x4 g[2][2];
#pragma unroll
        for (int bj = 0; bj < 2; ++bj) { g[bj][0] = ldg((const f32x4*)(gt + bj * 128)); g[bj][1] = ldg((const f32x4*)(gt + bj * 128 + 4)); }
#pragma unroll
        for (int ai = 0; ai < 2; ++ai)
#pragma unroll
            for (int m = 0; m < 4; ++m) {
                const int j = j00 + ai * 128 + m * 16;
                const size_t off = (is_ctx ? (size_t)(b * LC + j) : (size_t)(b * T + j - LC)) * D + col0;
                const float* s = (is_ctx ? csrc : xsrc) + off; float* d = (is_ctx ? cdst : xdst) + off;
#pragma unroll
                for (int bj = 0; bj < 2; ++bj) {
                    const f32x4 r0 = ldg((const f32x4*)(s + bj * 128)), r1 = ldg((const f32x4*)(s + bj * 128 + 4));
                    stg((f32x4*)(d + bj * 128), (f32x4)(r0 + g[bj][0] * acc[ai][bj][m][0]));
                    stg((f32x4*)(d + bj * 128 + 4), (f32x4)(r1 + g[bj][1] * acc[ai][bj][m][1]));
                }
            }
    }
};
struct LatOrder {
    pg8::StaticOrder so;
    DI bool next(int i, pg8::Unit& u) const { if (!so.next(i, u)) return false; u.pm += 1 + (u.pm >= 32 ? 1 : 0); return true; }
    DI void a_ready(const pg8::Unit&) const {}
    DI void done(const pg8::Unit&) const {}
};

constexpr int KS_LD = 72, VS_LD = 68, KS_BYTES = 64 * KS_LD * 2, VS_BYTES = 64 * VS_LD * 2;
template <int MODE>
DI void attn_core(unsigned char* lds, const bf16* qrow, const bf16* Kb, const bf16* Vt, int n1, int js, int nt, int qpos, float negM,
                  f32x16 (&O)[MODE == 0 ? 2 : 1][2], float (&lsum)[MODE == 0 ? 2 : 1]) {
    constexpr int NC = MODE == 0 ? 2 : 1, KS = MODE == 0 ? 2 : 4;
    const int tid = otid(), lane = tid & 63, l32 = lane & 31, hi = lane >> 5;
    bf16* Ksm = (bf16*)lds; bf16* Vsm = (bf16*)(lds + 2 * KS_BYTES);
    bf16x8 qf[NC][KS];
#pragma unroll
    for (int c = 0; c < NC; ++c)
#pragma unroll
        for (int ks = 0; ks < KS; ++ks) qf[c][ks] = ldg((const bf16x8*)(qrow + c * (KS * 16) + 16 * ks + 8 * hi));
#pragma unroll
    for (int c = 0; c < NC; ++c) { lsum[c] = 0.f;
#pragma unroll
        for (int d = 0; d < 2; ++d)
#pragma unroll
            for (int i = 0; i < 16; ++i) O[c][d][i] = 0.f; }
    const int lr = tid >> 3, lc = (tid & 7) * 8;
    f32x16 L1;
#pragma unroll
    for (int i = 0; i < 16; ++i) L1[i] = 0.f;
    f32x16 L0;
#pragma unroll
    for (int i = 0; i < 16; ++i) L0[i] = 0.f;
    const bf16x8 ones = (bf16x8){0x3F80, 0x3F80, 0x3F80, 0x3F80, 0x3F80, 0x3F80, 0x3F80, 0x3F80};
    f32x16 CNEG;
#pragma unroll
    for (int i = 0; i < 16; ++i) CNEG[i] = negM;
    asm volatile("" : "+v"(CNEG));
    u32x4 kreg, vreg;
    { const int j0 = (0 < n1) ? 0 : js;
      kreg = ldg((const u32x4*)(Kb + (size_t)(j0 + lr) * 64 + lc)); vreg = ldg((const u32x4*)(Vt + (size_t)lr * TK + j0 + lc));
      *(u32x4*)(Ksm + lr * KS_LD + lc) = kreg; *(u32x2*)(Vsm + lr * VS_LD + lc) = (u32x2){vreg.x, vreg.y}; *(u32x2*)(Vsm + lr * VS_LD + lc + 4) = (u32x2){vreg.z, vreg.w}; }
    lbar();
#ifdef PAD_A
    asm volatile("s_nop 0");
#endif
    for (int it = 0; it < nt; ++it) {
        const int buf = it & 1; const int j0 = (it < n1) ? 64 * it : js + 64 * (it - n1);
        const bool more = (it + 1 < nt);
        if (more) { const int jn = (it + 1 < n1) ? 64 * (it + 1) : js + 64 * (it + 1 - n1);
            kreg = ldg((const u32x4*)(Kb + (size_t)(jn + lr) * 64 + lc)); vreg = ldg((const u32x4*)(Vt + (size_t)lr * TK + jn + lc)); }
        const bf16* Kc = Ksm + buf * (64 * KS_LD); const bf16* Vc = Vsm + buf * (64 * VS_LD);
        const bool masked = (MODE == 1) && (it >= n1);
#pragma unroll
        for (int kb = 0; kb < 2; ++kb) {
#ifdef PAD_KB
            if (kb == 1) asm volatile("s_nop 0");
#endif
            bf16x8 pf[NC][2];
#pragma unroll
            for (int c = 0; c < NC; ++c) {
                f32x16 S;
#pragma unroll
                for (int ks = 0; ks < KS; ++ks) { const bf16x8 a = *(const bf16x8*)(Kc + (32 * kb + l32) * KS_LD + c * (KS * 16) + 16 * ks + 8 * hi); S = MFMA32(a, qf[c][ks], ks == 0 ? CNEG : S); }
                float p[16];
#pragma unroll
                for (int i = 0; i < 16; ++i) p[i] = __builtin_amdgcn_exp2f(S[i]);
                if (MODE == 1) { if (masked) { const int kp0 = j0 - LC + 32 * kb + 4 * hi - qpos;
#pragma unroll
                    for (int i = 0; i < 16; ++i) { const int dlt = kp0 + (i & 3) + 8 * (i >> 2); p[i] = (dlt >= -128 && dlt <= 128) ? p[i] : 0.f; } } }
                if (c != 0) { float ps = 0.f;
#pragma unroll
                    for (int i = 8; i < 16; ++i) ps += p[i];
                    lsum[c] += ps; }
#pragma unroll
                for (int s = 0; s < 2; ++s) { u32x4 w; w.x = pk(p[8 * s], p[8 * s + 1]); w.y = pk(p[8 * s + 2], p[8 * s + 3]); w.z = pk(p[8 * s + 4], p[8 * s + 5]); w.w = pk(p[8 * s + 6], p[8 * s + 7]); pf[c][s] = __builtin_bit_cast(bf16x8, w); }
            }
#pragma unroll
            for (int dvb = 0; dvb < 2; ++dvb)
#pragma unroll
                for (int s = 0; s < 2; ++s) {
                    const bf16* vp = Vc + (32 * dvb + l32) * VS_LD + 32 * kb + 16 * s + 4 * hi;
                    const u32x2 lo = *(const u32x2*)vp, hh = *(const u32x2*)(vp + 8);
                    const bf16x8 va = __builtin_bit_cast(bf16x8, (u32x4){lo.x, lo.y, hh.x, hh.y});
#pragma unroll
                    for (int c = 0; c < NC; ++c) O[c][dvb] = MFMA32(va, pf[c][s], O[c][dvb]);
                    if (dvb == 0) L0 = MFMA32(ones, pf[0][s], L0);
                    if (dvb == 1 && s == 0 && NC == 2) L1 = MFMA32(ones, pf[NC - 1][0], L1);
                }
        }
        if (more) { bf16* Kn = Ksm + (buf ^ 1) * (64 * KS_LD); bf16* Vn = Vsm + (buf ^ 1) * (64 * VS_LD);
            *(u32x4*)(Kn + lr * KS_LD + lc) = kreg; *(u32x2*)(Vn + lr * VS_LD + lc) = (u32x2){vreg.x, vreg.y}; *(u32x2*)(Vn + lr * VS_LD + lc + 4) = (u32x2){vreg.z, vreg.w}; }
        lbar();
    }
#ifdef PAD_A
    asm volatile("s_nop 0");
#endif
    lsum[0] = 0.5f * L0[0];
    if (NC == 2) lsum[NC - 1] += 0.5f * L1[0];
}

DI void attnA_unit(unsigned char* lds, unsigned char* ws, int u, const float* subln, const float* misc) {
    const int tid = otid(), lane = tid & 63, wave = tid >> 6, l32 = lane & 31, hi = lane >> 5;
    int bh, jq0, nt;
    if (u < 256) { bh = u & 7; jq0 = LC + 256 * (u >> 3); nt = TK / 64; } else { bh = u - 256; jq0 = 0; nt = LC / 64; }
    const int b = bh >> 2, h = bh & 3, jq = jq0 + 32 * wave + l32;
    const bf16* qrow = (const bf16*)(ws + WS_QA) + ((size_t)bh * TK + jq) * 64;
    const bf16* Kb = (const bf16*)(ws + WS_KA) + (size_t)bh * TK * 64;
    const bf16* Vt = (const bf16*)(ws + WS_VAT) + (size_t)bh * 64 * TK;
    f32x16 O[2][2]; float lsum[2];
    attn_core<0>(lds, qrow, Kb, Vt, nt, 0, nt, 0, -misc[2], O, lsum);
    const float lam = misc[0], lam_init = misc[1];
    const float l0 = lsum[0] + __shfl_xor(lsum[0], 32), l1 = lsum[1] + __shfl_xor(lsum[1], 32);
    const float i0 = 1.f / l0, i1 = lam / l1;
    float ss = 0.f;
#pragma unroll
    for (int d = 0; d < 2; ++d)
#pragma unroll
        for (int i = 0; i < 16; ++i) { const float a = O[0][d][i] * i0 - O[1][d][i] * i1; O[0][d][i] = a; ss += a * a; }
    ss += __shfl_xor(ss, 32);
    const float rinv = rsqrtf(ss * (1.f / 64.f) + EPS) * (1.f - lam_init);
    const size_t mrow = (size_t)b * TK + jq;
    const bf16* gate = (const bf16*)(ws + WS_GATE) + mrow * 1024 + h * 64;
    bf16* y = (bf16*)(ws + WS_HXY) + mrow * 1024 + h * 64;
#pragma unroll
    for (int d = 0; d < 2; ++d)
#pragma unroll
        for (int g = 0; g < 4; ++g) {
            const int dv = 32 * d + 8 * g + 4 * hi;
            const u32x2 gg = ldg((const u32x2*)(gate + dv)); const f32x4 sb = ldg((const f32x4*)(subln + dv));
            u32x2 o; o.x = pk(O[0][d][4 * g] * rinv * sb[0] * bfe2(gg, 0), O[0][d][4 * g + 1] * rinv * sb[1] * bfe2(gg, 1));
            o.y = pk(O[0][d][4 * g + 2] * rinv * sb[2] * bfe2(gg, 2), O[0][d][4 * g + 3] * rinv * sb[3] * bfe2(gg, 3));
            stg((u32x2*)(y + dv), o);
        }
}

DI void attnD_unit(unsigned char* lds, unsigned char* ws, int u, const float* sink, const float* misc) {
    const int tid = otid(), lane = tid & 63, wave = tid >> 6, l32 = lane & 31, hi = lane >> 5;
    int b, kv, jq0, n1 = LC / 64, js = 0, nt = LC / 64, qpos = 0;
    if (u < 256) { const int x = u & 7; b = x >> 2; kv = (x >> 1) & 1; const int qblk = (x & 1) * 32 + (u >> 3), q0 = qblk * 128;
        jq0 = LC + q0; const int p0 = q0 - 128 < 0 ? 0 : q0 - 128, p1 = q0 + 256 > T ? T : q0 + 256; js = LC + p0; nt = n1 + (p1 - p0) / 64; qpos = q0 + 32 * (wave & 3) + l32; }
    else { const int x = u - 256; b = x >> 2; kv = (x >> 1) & 1; jq0 = 128 * (x & 1); }
    const int g = wave >> 2, jq = jq0 + 32 * (wave & 3) + l32;
    const bf16* qrow = (const bf16*)(ws + WS_QD) + ((size_t)((b * 2 + kv) * 2 + g) * TK + jq) * 64;
    const bf16* Kb = (const bf16*)(ws + WS_KD) + (size_t)(b * 2 + kv) * TK * 64;
    const bf16* Vt = (const bf16*)(ws + WS_VDT) + (size_t)(b * 2 + kv) * 64 * TK;
    f32x16 O[1][2]; float lsum[1];
    attn_core<1>(lds, qrow, Kb, Vt, n1, js, nt, qpos, -misc[3], O, lsum);
    const float l = lsum[0] + __shfl_xor(lsum[0], 32) + __builtin_amdgcn_exp2f(sink[kv * 2 + g] * LOG2E - misc[3]);
    const float inv = 1.f / l;
    const size_t mrow = (size_t)b * TK + jq; const int hc = 768 + (kv * 2 + g) * 64;
    const bf16* gate = (const bf16*)(ws + WS_GATE) + mrow * 1024 + hc;
    bf16* y = (bf16*)(ws + WS_HXY) + mrow * 1024 + hc;
#pragma unroll
    for (int d = 0; d < 2; ++d)
#pragma unroll
        for (int gq = 0; gq < 4; ++gq) {
            const int dv = 32 * d + 8 * gq + 4 * hi;
            const u32x2 gg = ldg((const u32x2*)(gate + dv));
            u32x2 o; o.x = pk(O[0][d][4 * gq] * inv * bfe2(gg, 0), O[0][d][4 * gq + 1] * inv * bfe2(gg, 1));
            o.y = pk(O[0][d][4 * gq + 2] * inv * bfe2(gg, 2), O[0][d][4 * gq + 3] * inv * bfe2(gg, 3));
            stg((u32x2*)(y + dv), o);
        }
}

DI int ord_cidx(int dir, int step) { return dir == 0 ? step : (step < 4 ? 3 - step : 135 - step); }
constexpr int LD64 = 72, LD32 = 40, HLD = 68;
constexpr int WC_OFF = 110592, WC_CW = 0, WC_CB = 1536, WC_BON = 2048, WC_CON = 2112, WC_WG = 2176, WC_BG = 6272, WC_N = 6528;
DI void fill_wcache(unsigned char* lds, const float* const* IN, int l) {
    float* WC = (float*)(lds + WC_OFF); const int tid = otid();
    const float* cw = IN[13] + l * 1536; const float* cb = IN[14] + l * 512; const float* bo = IN[16] + l * 64; const float* co = IN[19] + l * 64; const float* wg = IN[17] + l * 4096; const float* bg = IN[18] + l * 256;
    for (int i = tid; i < WC_N; i += 512) { float v;
        if (i < WC_CB) v = ldg(cw + i); else if (i < WC_BON) v = ldg(cb + i - WC_CB); else if (i < WC_CON) v = ldg(bo + i - WC_BON); else if (i < WC_WG) v = ldg(co + i - WC_CON);
        else if (i < WC_BG) v = ldg(wg + i - WC_WG); else v = ldg(bg + i - WC_BG);
        WC[i] = v; }
    lbar();
}

struct ScanPtrs { float *CST, *NST, *SB, *SG, *SM, *SST, *GD; };
DI ScanPtrs scan_ptrs(unsigned char* ws) { ScanPtrs p; p.CST = (float*)(ws + WS_CST); p.NST = (float*)(ws + WS_NST); p.SB = (float*)(ws + WS_SSC); p.SG = p.SB + 16 * NCH; p.SM = p.SG + 16 * NCH;
    p.SST = (float*)(ws + WS_SST); p.GD = (float*)(ws + WS_GD); return p; }


DI float wscan_add(float v, int lane, bool rev) {
#pragma unroll
    for (int off = 1; off < 64; off <<= 1) { const float t = rev ? __shfl_down(v, off) : __shfl_up(v, off); const bool ok = rev ? (lane + off < 64) : (lane >= off); v += ok ? t : 0.f; }
    return v; }
DI float wscan_max(float v, int lane, bool rev) {
#pragma unroll
    for (int off = 1; off < 64; off <<= 1) { const float t = rev ? __shfl_down(v, off) : __shfl_up(v, off); const bool ok = rev ? (lane + off < 64) : (lane >= off); v = ok ? fmaxf(v, t) : v; }
    return v; }
DI float wave_max(float v) {
#pragma unroll
    for (int o = 1; o < 64; o <<= 1) v = fmaxf(v, __shfl_xor(v, o));
    return v; }

DI void conv8r(const u32x4& pv, const u32x4& c, const u32x4& nv, const float* w  , const float* cb, float mul, float* o) {
    float w0[8], w1[8], w2[8], bb[8];
    getv(*(const f32x4*)w, *(const f32x4*)(w + 4), w0); getv(*(const f32x4*)(w + 512), *(const f32x4*)(w + 516), w1);
    getv(*(const f32x4*)(w + 1024), *(const f32x4*)(w + 1028), w2); getv(*(const f32x4*)cb, *(const f32x4*)(cb + 4), bb);
#pragma unroll
    for (int e = 0; e < 8; ++e) { const float y = w0[e] * bfe(pv, e) + w1[e] * bfe(c, e) + w2[e] * bfe(nv, e) + bb[e]; o[e] = silu_(y) * mul; }
}
DI void load3(const bf16* p, bool hasp, bool hasn, u32x4& pv, u32x4& c, u32x4& nv) {
    c = ldg((const u32x4*)p); pv = (u32x4){0u, 0u, 0u, 0u}; nv = pv;
    if (hasp) pv = ldg((const u32x4*)(p - 256));
    if (hasn) nv = ldg((const u32x4*)(p + 256));
}

struct MaPre { float lf, li; u32x4 kp, kc, kn, vraw; };
DI MaPre mlstm_a_load(unsigned char* ws, int tsk) {
    const int bh = tsk / NCH, cidx = tsk - bh * NCH, b = bh >> 2, h = bh & 3, tid = otid();
    const size_t m0 = (size_t)b * TK + cidx * 64; MaPre p; p.lf = 0.f; p.li = 0.f;
    if (tid < 128) { const int dir = tid >> 6, s = tid & 63; const float* sm = (const float*)(ws + WS_SMALL) + (m0 + s) * 48; p.lf = ldg(sm + (2 * dir + 1) * 4 + h); p.li = ldg(sm + (2 * dir) * 4 + h); }
    const int s = tid >> 3, d0 = (tid & 7) * 8;
    const bool hasp = (s > 0) || (cidx != 0 && cidx != 4), hasn = (s < 63) || (cidx != 3 && cidx != NCH - 1);
    load3((const bf16*)(ws + WS_KB) + (m0 + s) * 256 + h * 64 + d0, hasp, hasn, p.kp, p.kc, p.kn);
    p.vraw = ldg((const u32x4*)((const bf16*)(ws + WS_VBT) + ((size_t)bh * 64 + s) * TK + cidx * 64 + d0));
    return p;
}
DI void mlstm_a_run(unsigned char* lds, unsigned char* ws, int tsk, const MaPre& p, const float* conv_w, const float* conv_b) {
    const int bh = tsk / NCH, cidx = tsk - bh * NCH, h = bh & 3;
    const int tid = otid(), lane = tid & 63, wave = tid >> 6; const ScanPtrs sp = scan_ptrs(ws);
    bf16* KT = (bf16*)lds; bf16* VW = (bf16*)(lds + 9216); float* WE = (float*)(lds + 27648);
    if (wave < 2) { const int dir = wave; const float tot = wave_sum(p.lf), pre = wscan_add(p.lf, lane, false);
        const float g = (dir == 0 ? tot - pre : pre - p.lf) + p.li; const float G = wave_max(g);
        WE[dir * 64 + lane] = expf(g - G);
        if (lane == 0) { stg(sp.SB + (bh * 2 + dir) * NCH + cidx, tot); stg(sp.SG + (bh * 2 + dir) * NCH + cidx, G); } }
    { const int s = tid >> 3, d0 = (tid & 7) * 8; float kv[8];
      conv8r(p.kp, p.kc, p.kn, conv_w + 256 + h * 64 + d0, conv_b + 256 + h * 64 + d0, 0.125f, kv);
#pragma unroll
      for (int e = 0; e < 8; ++e) KT[(d0 + e) * LD64 + s] = f2b(kv[e]); }
    lbar();
    { const int v = tid >> 3, s0 = (tid & 7) * 8;
#pragma unroll
      for (int dir = 0; dir < 2; ++dir) { float o[8];
#pragma unroll
          for (int e = 0; e < 8; ++e) o[e] = bfe(p.vraw, e) * WE[dir * 64 + s0 + e];
          st8(VW + dir * (64 * LD64) + v * LD64 + s0, o); } }
    { const int o = tid >> 2, part = tid & 3, dir = o >> 6, d = o & 63; float a = 0.f;
#pragma unroll
      for (int q = 0; q < 16; ++q) { const int s = part * 16 + q; a += WE[dir * 64 + s] * b2f(KT[d * LD64 + s]); }
      a += __shfl_xor(a, 1); a += __shfl_xor(a, 2);
      if (part == 0) stg(sp.NST + ((size_t)(bh * 2 + dir) * NCH + cidx) * 64 + d, a); }
    lbar();
    { const int dir = wave >> 2, tr = (wave >> 1) & 1, tc = wave & 1, l32 = lane & 31, hi = lane >> 5;
      f32x16 acc;
#pragma unroll
      for (int i = 0; i < 16; ++i) acc[i] = 0.f;
#pragma unroll
      for (int ks = 0; ks < 4; ++ks) acc = MFMA32(ldfrag(VW + dir * (64 * LD64), LD64, 32 * tr, 16 * ks, lane), ldfrag(KT, LD64, 32 * tc, 16 * ks, lane), acc);
      float* dst = sp.CST + ((size_t)(bh * 2 + dir) * NCH + cidx) * 4096;
#pragma unroll
      for (int i = 0; i < 16; ++i) stg(dst + (32 * tr + crow(i, hi)) * 64 + 32 * tc + l32, acc[i]); }
    lbar();
}

struct GlPre { f32x4 lr[4]; u32x4 kraw, qraw, vraw; };
DI GlPre gla_load(unsigned char* ws, int tsk, bool need_q) {
    const int bh = tsk / NCH, cidx = tsk - bh * NCH, b = bh >> 2, h = bh & 3, tid = otid(), lane = tid & 63, wave = tid >> 6, z = wave >> 2, dg = wave & 3;
    const size_t m0 = (size_t)b * TK + cidx * 64; GlPre p;
    const float* sm = (const float*)(ws + WS_SMALL) + (m0 + lane) * 48 + 16 + z * 16;
#pragma unroll
    for (int q = 0; q < 4; ++q) p.lr[q] = ldg((const f32x4*)(sm + 4 * q));
    p.kraw = ldg((const u32x4*)((const bf16*)(ws + WS_KC) + (m0 + lane) * 128 + h * 32 + dg * 8));
    p.qraw = (u32x4){0u, 0u, 0u, 0u}; if (need_q) p.qraw = ldg((const u32x4*)((const bf16*)(ws + WS_QC) + (m0 + lane) * 128 + h * 32 + dg * 8));
    p.vraw = ldg((const u32x4*)((const bf16*)(ws + WS_VCT) + ((size_t)bh * 64 + (tid >> 3)) * TK + cidx * 64 + (tid & 7) * 8));
    return p;
}
DI void gla_bc(const GlPre& p, int h, int z, int dg, int lane, const float* wg, const float* bg, float* bc) {
    const float* wgp = wg + (z * 16) * 128 + h * 32 + dg * 8;
#pragma unroll
    for (int e = 0; e < 8; ++e) bc[e] = bg[z * 128 + h * 32 + dg * 8 + e];
#pragma unroll
    for (int r = 0; r < 16; ++r) { const float lr = p.lr[r >> 2][r & 3];
#pragma unroll
        for (int e = 0; e < 8; ++e) bc[e] += lr * wgp[r * 128 + e]; }
#pragma unroll
    for (int e = 0; e < 8; ++e) bc[e] = wscan_add((fminf(bc[e], 0.f) - __logf(1.f + __expf(-fabsf(bc[e])))) * (1.f / 16.f), lane, z == 1);
}
DI void gla_a_run(unsigned char* lds, unsigned char* ws, int tsk, const GlPre& p, const float* wg, const float* bg) {
    const int bh = tsk / NCH, cidx = tsk - bh * NCH, h = bh & 3;
    const int tid = otid(), lane = tid & 63, wave = __builtin_amdgcn_readfirstlane(tid >> 6), z = wave >> 2, dg = wave & 3; const ScanPtrs sp = scan_ptrs(ws);
    bf16* KH = (bf16*)lds; bf16* VT = (bf16*)(lds + 9216);
    float bc[8]; gla_bc(p, h, z, dg, lane, wg, bg, bc);
#pragma unroll
    for (int e = 0; e < 8; ++e) { const float bend = __shfl(bc[e], z == 0 ? 63 : 0);
        KH[z * (32 * LD64) + (dg * 8 + e) * LD64 + lane] = f2b(bfe(p.kraw, e) * expf(bend - bc[e]));
        if (lane == 0) stg(sp.GD + ((size_t)(bh * 2 + z) * NCH + cidx) * 32 + dg * 8 + e, expf(bend)); }
    *(u32x4*)(VT + (tid >> 3) * LD64 + (tid & 7) * 8) = p.vraw;
    lbar();
    if (wave < 4) { const int zz = wave >> 1, vc = wave & 1, l32 = lane & 31, hi = lane >> 5;
      f32x16 acc;
#pragma unroll
      for (int i = 0; i < 16; ++i) acc[i] = 0.f;
#pragma unroll
      for (int ks = 0; ks < 4; ++ks) acc = MFMA32(ldfrag(KH + zz * (32 * LD64), LD64, 0, 16 * ks, lane), ldfrag(VT, LD64, 32 * vc, 16 * ks, lane), acc);
      float* dst = sp.SST + ((size_t)(bh * 2 + zz) * NCH + cidx) * 2048;
#pragma unroll
      for (int i = 0; i < 16; ++i) stg(dst + crow(i, hi) * 64 + 32 * vc + l32, acc[i]); }
    lbar();
}
DI void scan_b(unsigned char* lds, unsigned char* ws, int t) {
    const int tid = otid(); const ScanPtrs sp = scan_ptrs(ws);
    float* DEC = (float*)lds; float* SCL = DEC + 256; float* XA = SCL + 256; float* XB = XA + 256; float* GS = XB + 256; float* BS = GS + 256; float* GDs = (float*)lds;
    if (t < 144) {
        const int scan = t < 128 ? (t >> 3) : (t - 128), dir = scan & 1;
        float bv = 0.f, gv = 0.f;
        if (tid < 132) { const int cidx = ord_cidx(dir, tid); bv = ldg(sp.SB + scan * NCH + cidx); gv = ldg(sp.SG + scan * NCH + cidx); }
        if (tid < 256) { XA[tid] = bv; BS[tid] = bv; GS[tid] = gv; }
        lbar();
        for (int off = 1; off < 256; off <<= 1) { float v = 0.f; if (tid < 256 && tid >= off) v = XA[tid - off]; lbar(); if (tid < 256) XA[tid] += v; lbar(); }
        if (tid < 256) XB[tid] = tid < 132 ? GS[tid] - XA[tid] : -INFINITY;
        lbar();
        for (int off = 1; off < 256; off <<= 1) { float v = -INFINITY; if (tid < 256 && tid >= off) v = XB[tid - off]; lbar(); if (tid < 256) XB[tid] = fmaxf(XB[tid], v); lbar(); }
        if (tid < 132) {
            const float m0 = tid == 0 ? 0.f : XA[tid - 1] + fmaxf(0.f, XB[tid - 1]);
            const float m1 = XA[tid] + fmaxf(0.f, XB[tid]);
            DEC[tid] = expf(BS[tid] + m0 - m1); SCL[tid] = expf(GS[tid] - m1);
            if (t >= 128) stg(sp.SM + scan * NCH + ord_cidx(dir, tid), m0);
        }
        lbar();
        if (t < 128 || tid < 64) {
            const int stride = t < 128 ? 4096 : 64;
            float* buf = (t < 128 ? sp.CST + (size_t)scan * NCH * 4096 + (t & 7) * 512 : sp.NST + (size_t)scan * NCH * 64) + tid;
            float run = 0.f;
            for (int s0 = 0; s0 < 132; s0 += 33) { float dl[33];
#pragma unroll
                for (int u = 0; u < 33; ++u) dl[u] = ldg(buf + (size_t)ord_cidx(dir, s0 + u) * stride);
#pragma unroll
                for (int u = 0; u < 33; ++u) { stg(buf + (size_t)ord_cidx(dir, s0 + u) * stride, run); run = DEC[s0 + u] * run + SCL[s0 + u] * dl[u]; } }
        }
        lbar();
    } else {
        const int scan = (t - 144) >> 2, dir = scan & 1, elem = ((t - 144) & 3) * 512 + tid, d = elem >> 6;
        for (int idx = tid; idx < 132 * 32; idx += 512) GDs[idx] = ldg(sp.GD + ((size_t)scan * NCH + ord_cidx(dir, idx >> 5)) * 32 + (idx & 31));
        lbar();
        float* buf = sp.SST + (size_t)scan * NCH * 2048 + elem; float run = 0.f;
        for (int s0 = 0; s0 < 132; s0 += 33) { float dl[33];
#pragma unroll
            for (int u = 0; u < 33; ++u) dl[u] = ldg(buf + (size_t)ord_cidx(dir, s0 + u) * 2048);
#pragma unroll
            for (int u = 0; u < 33; ++u) { stg(buf + (size_t)ord_cidx(dir, s0 + u) * 2048, run); run = GDs[(s0 + u) * 32 + d] * run + dl[u]; } }
        lbar();
    }
}

DI void chunk_finish(const float* H, unsigned char* ws, size_t m0, int colbase, int h, const float* outn, bool use_o, const u32x4& gg, const u32x4& og) {
    const int tid = otid(), t = tid >> 3, v8 = (tid & 7) * 8;
    float hs[8]; float ss = 0.f;
#pragma unroll
    for (int e = 0; e < 8; ++e) { hs[e] = H[t * HLD + v8 + e] + H[64 * HLD + t * HLD + v8 + e]; ss += hs[e] * hs[e]; }
    ss += __shfl_xor(ss, 1); ss += __shfl_xor(ss, 2); ss += __shfl_xor(ss, 4);
    const float rinv = rsqrtf(ss * (1.f / 64.f) + EPS);
    const size_t mrow = m0 + t;
    float o[8];
#pragma unroll
    for (int e = 0; e < 8; ++e) { float x = hs[e] * rinv * outn[v8 + e] * bfe(gg, e); if (use_o) x *= bfe(og, e); o[e] = x; }
    st8g((bf16*)(ws + WS_HXY) + mrow * 1024 + colbase + h * 64 + v8, o);
}

struct McPre { float lf, li, nl, mp; u32x4 qp, qc, qn, kp, kc, kn, vraw, gg, og; f32x4 c[2][2]; };
DI McPre mlstm_c_load(unsigned char* ws, int tsk) {
    const int bh = tsk / NCH, cidx = tsk - bh * NCH, b = bh >> 2, h = bh & 3, tid = otid();
    const size_t m0 = (size_t)b * TK + cidx * 64; const ScanPtrs sp = scan_ptrs(ws); McPre p; p.lf = 0.f; p.li = 0.f; p.nl = 0.f; p.mp = 0.f;
    if (tid < 128) { const int dir = tid >> 6, s = tid & 63; const float* sm = (const float*)(ws + WS_SMALL) + (m0 + s) * 48; p.lf = ldg(sm + (2 * dir + 1) * 4 + h); p.li = ldg(sm + (2 * dir) * 4 + h);
        p.nl = ldg(sp.NST + ((size_t)(bh * 2 + dir) * NCH + cidx) * 64 + s); p.mp = ldg(sp.SM + (bh * 2 + dir) * NCH + cidx); }
    const int s = tid >> 3, d0 = (tid & 7) * 8;
    const bool hasp = (s > 0) || (cidx != 0 && cidx != 4), hasn = (s < 63) || (cidx != 3 && cidx != NCH - 1);
    load3((const bf16*)(ws + WS_QB) + (m0 + s) * 256 + h * 64 + d0, hasp, hasn, p.qp, p.qc, p.qn);
    load3((const bf16*)(ws + WS_KB) + (m0 + s) * 256 + h * 64 + d0, hasp, hasn, p.kp, p.kc, p.kn);
    p.vraw = ldg((const u32x4*)((const bf16*)(ws + WS_VBT) + ((size_t)bh * 64 + s) * TK + cidx * 64 + d0));
#pragma unroll
    for (int dir = 0; dir < 2; ++dir) { const float* src = sp.CST + ((size_t)(bh * 2 + dir) * NCH + cidx) * 4096 + s * 64 + d0; p.c[dir][0] = ldg((const f32x4*)src); p.c[dir][1] = ldg((const f32x4*)(src + 4)); }
    p.gg = ldg((const u32x4*)((const bf16*)(ws + WS_GATE) + (m0 + s) * 1024 + 256 + h * 64 + d0));
    p.og = ldg((const u32x4*)((const bf16*)(ws + WS_OB) + (m0 + s) * 256 + h * 64 + d0));
    return p;
}
DI void mlstm_c_run(unsigned char* lds, unsigned char* ws, int tsk, const McPre& p, const float* conv_w, const float* conv_b, const float* outn) {
    const int bh = tsk / NCH, cidx = tsk - bh * NCH, b = bh >> 2, h = bh & 3;
    const int tid = otid(), lane = tid & 63, wave = tid >> 6, l32 = lane & 31, hi = lane >> 5;
    const size_t m0 = (size_t)b * TK + cidx * 64;
    bf16* QS = (bf16*)lds; bf16* KSm = (bf16*)(lds + 9216); bf16* VT = (bf16*)(lds + 18432); bf16* CB = (bf16*)(lds + 27648); bf16* PL = (bf16*)(lds + 46080);
    float* H = (float*)(lds + 64512); float* AA = (float*)(lds + 99328); float* MU = AA + 128; float* GI = MU + 128; float* EN = GI + 128;
    float* NQ = EN + 128; float* RS = NQ + 128; float* NL = RS + 256;
    if (wave < 2) { const int dir = wave; const bool rev = dir == 1;
        const float bcum = wscan_add(p.lf, lane, rev), a = p.li - bcum, cm = wscan_max(a, lane, rev), mu = fmaxf(p.mp, cm);
        AA[dir * 64 + lane] = a; MU[dir * 64 + lane] = mu; GI[dir * 64 + lane] = expf(p.mp - mu); EN[dir * 64 + lane] = expf(-bcum - mu); NL[dir * 64 + lane] = p.nl; }
    { const int s = tid >> 3, d0 = (tid & 7) * 8; float qv[8], kv[8];
      conv8r(p.qp, p.qc, p.qn, conv_w + h * 64 + d0, conv_b + h * 64 + d0, 1.f, qv);
      conv8r(p.kp, p.kc, p.kn, conv_w + 256 + h * 64 + d0, conv_b + 256 + h * 64 + d0, 0.125f, kv);
      st8(QS + s * LD64 + d0, qv); st8(KSm + s * LD64 + d0, kv);
      *(u32x4*)(VT + s * LD64 + d0) = p.vraw;
#pragma unroll
      for (int dir = 0; dir < 2; ++dir) { float cv[8]; getv(p.c[dir][0], p.c[dir][1], cv); st8(CB + dir * (64 * LD64) + s * LD64 + d0, cv); } }
    lbar();
    { const int o = tid >> 2, part = tid & 3, dir = o >> 6, t = o & 63; float a = 0.f;
#pragma unroll
      for (int q = 0; q < 16; ++q) { const int d = part * 16 + q; a += NL[dir * 64 + d] * b2f(QS[t * LD64 + d]); }
      a += __shfl_xor(a, 1); a += __shfl_xor(a, 2);
      if (part == 0) NQ[dir * 64 + t] = a; }
    { const int dir = wave >> 2, tr = (wave >> 1) & 1, tc = wave & 1;
      f32x16 S;
#pragma unroll
      for (int i = 0; i < 16; ++i) S[i] = 0.f;
#pragma unroll
      for (int ks = 0; ks < 4; ++ks) S = MFMA32(ldfrag(KSm, LD64, 32 * tr, 16 * ks, lane), ldfrag(QS, LD64, 32 * tc, 16 * ks, lane), S);
      const int t = 32 * tc + l32; const float mu = MU[dir * 64 + t]; float rs = 0.f;
#pragma unroll
      for (int g = 0; g < 4; ++g) { float pw[4];
#pragma unroll
          for (int e = 0; e < 4; ++e) { const int s = 32 * tr + 8 * g + 4 * hi + e; const bool ok = dir == 0 ? (s <= t) : (s >= t);
              pw[e] = ok ? S[4 * g + e] * __expf(AA[dir * 64 + s] - mu) : 0.f; rs += pw[e]; }
          *(u32x2*)(PL + dir * (64 * LD64) + t * LD64 + 32 * tr + 8 * g + 4 * hi) = (u32x2){pk(pw[0], pw[1]), pk(pw[2], pw[3])}; }
      rs += __shfl_xor(rs, 32);
      if (hi == 0) RS[(dir * 2 + tr) * 64 + t] = rs; }
    lbar();
    { const int dir = wave >> 2, vr = (wave >> 1) & 1, tc = wave & 1;
      f32x16 aP, aC;
#pragma unroll
      for (int i = 0; i < 16; ++i) { aP[i] = 0.f; aC[i] = 0.f; }
#pragma unroll
      for (int ks = 0; ks < 4; ++ks) { aP = MFMA32(ldfrag(VT, LD64, 32 * vr, 16 * ks, lane), ldfrag(PL + dir * (64 * LD64), LD64, 32 * tc, 16 * ks, lane), aP);
          aC = MFMA32(ldfrag(CB + dir * (64 * LD64), LD64, 32 * vr, 16 * ks, lane), ldfrag(QS, LD64, 32 * tc, 16 * ks, lane), aC); }
      const int t = 32 * tc + l32; const float gi = GI[dir * 64 + t];
      const float nq = RS[(dir * 2) * 64 + t] + RS[(dir * 2 + 1) * 64 + t] + gi * NQ[dir * 64 + t];
      const float inv = 1.f / fmaxf(fabsf(nq), EN[dir * 64 + t]);
#pragma unroll
      for (int i = 0; i < 16; ++i) H[dir * (64 * HLD) + t * HLD + 32 * vr + crow(i, hi)] = (aP[i] + gi * aC[i]) * inv; }
    lbar();
    chunk_finish(H, ws, m0, 256, h, outn, true, p.gg, p.og);
    lbar();
}

struct GcPre { GlPre g; u32x4 gg; float st[2][4]; };
DI GcPre gla_c_load(unsigned char* ws, int tsk) {
    const int bh = tsk / NCH, cidx = tsk - bh * NCH, b = bh >> 2, h = bh & 3, tid = otid(); const ScanPtrs sp = scan_ptrs(ws);
    const size_t m0 = (size_t)b * TK + cidx * 64; GcPre p; p.g = gla_load(ws, tsk, true);
    p.gg = ldg((const u32x4*)((const bf16*)(ws + WS_GATE) + (m0 + (tid >> 3)) * 1024 + 512 + h * 64 + (tid & 7) * 8));
#pragma unroll
    for (int z = 0; z < 2; ++z) { const float* src = sp.SST + ((size_t)(bh * 2 + z) * NCH + cidx) * 2048;
#pragma unroll
        for (int it = 0; it < 4; ++it) p.st[z][it] = ldg(src + tid + 512 * it); }
    return p;
}
DI void gla_c_run(unsigned char* lds, unsigned char* ws, int tsk, const GcPre& p, const float* wg, const float* bg, const float* outn) {
    const int bh = tsk / NCH, cidx = tsk - bh * NCH, b = bh >> 2, h = bh & 3;
    const int tid = otid(), lane = tid & 63, wave = tid >> 6, l32 = lane & 31, hi = lane >> 5;
    const size_t m0 = (size_t)b * TK + cidx * 64;
    bf16* QT = (bf16*)lds; bf16* KT2 = (bf16*)(lds + 10240); bf16* QH = (bf16*)(lds + 20480); bf16* VT = (bf16*)(lds + 30720);
    bf16* ST = (bf16*)(lds + 39936); bf16* PL = (bf16*)(lds + 50176); float* H = (float*)(lds + 68608);
    { const int wu = __builtin_amdgcn_readfirstlane(wave), z = wu >> 2, dg = wu & 3; float bc[8]; gla_bc(p.g, h, z, dg, lane, wg, bg, bc);
      float q1[8], k1[8], q2[8];
#pragma unroll
      for (int e = 0; e < 8; ++e) { const float rf = __shfl(bc[e], 32); const float qv = bfe(p.g.qraw, e);
          q1[e] = qv * __expf(bc[e] - rf); k1[e] = bfe(p.g.kraw, e) * __expf(rf - bc[e]); q2[e] = qv * __expf(bc[e]); }
      st8(QT + z * (64 * LD32) + lane * LD32 + dg * 8, q1); st8(KT2 + z * (64 * LD32) + lane * LD32 + dg * 8, k1); st8(QH + z * (64 * LD32) + lane * LD32 + dg * 8, q2); }
    *(u32x4*)(VT + (tid >> 3) * LD64 + (tid & 7) * 8) = p.g.vraw;
#pragma unroll
    for (int z = 0; z < 2; ++z)
#pragma unroll
        for (int it = 0; it < 4; ++it) { const int idx = tid + 512 * it, d = idx >> 6, v = idx & 63; ST[z * (64 * LD32) + v * LD32 + d] = f2b(p.st[z][it]); }
    lbar();
    { const int z = wave >> 2, tr = (wave >> 1) & 1, tc = wave & 1;
      f32x16 S;
#pragma unroll
      for (int i = 0; i < 16; ++i) S[i] = 0.f;
#pragma unroll
      for (int ks = 0; ks < 2; ++ks) S = MFMA32(ldfrag(KT2 + z * (64 * LD32), LD32, 32 * tr, 16 * ks, lane), ldfrag(QT + z * (64 * LD32), LD32, 32 * tc, 16 * ks, lane), S);
      const int t = 32 * tc + l32;
#pragma unroll
      for (int g = 0; g < 4; ++g) { float pw[4];
#pragma unroll
          for (int e = 0; e < 4; ++e) { const int s = 32 * tr + 8 * g + 4 * hi + e; const bool ok = z == 0 ? (s <= t) : (s >= t); pw[e] = ok ? S[4 * g + e] : 0.f; }
          *(u32x2*)(PL + z * (64 * LD64) + t * LD64 + 32 * tr + 8 * g + 4 * hi) = (u32x2){pk(pw[0], pw[1]), pk(pw[2], pw[3])}; } }
    lbar();
    { const int z = wave >> 2, vr = (wave >> 1) & 1, tc = wave & 1;
      f32x16 a;
#pragma unroll
      for (int i = 0; i < 16; ++i) a[i] = 0.f;
#pragma unroll
      for (int ks = 0; ks < 4; ++ks) a = MFMA32(ldfrag(VT, LD64, 32 * vr, 16 * ks, lane), ldfrag(PL + z * (64 * LD64), LD64, 32 * tc, 16 * ks, lane), a);
#pragma unroll
      for (int ks = 0; ks < 2; ++ks) a = MFMA32(ldfrag(ST + z * (64 * LD32), LD32, 32 * vr, 16 * ks, lane), ldfrag(QH + z * (64 * LD32), LD32, 32 * tc, 16 * ks, lane), a);
      const int t = 32 * tc + l32;
#pragma unroll
      for (int i = 0; i < 16; ++i) H[z * (64 * HLD) + t * HLD + 32 * vr + crow(i, hi)] = a[i]; }
    lbar();
    chunk_finish(H, ws, m0, 512, h, outn, false, p.gg, p.gg);
    lbar();
}


constexpr int W48_LD = 1032, W48_BYTES = 48 * W48_LD * 2;
DI void mini_proj(unsigned char* lds, unsigned char* ws, int first_tile, int tile_step, int ntiles, const bf16* Wt48, const float* gate_b) {
    const int tid = otid(), lane = tid & 63, wave = tid >> 6, l32 = lane & 31, hi = lane >> 5;
    bf16* WL = (bf16*)lds; bf16* AS = (bf16*)(lds + W48_BYTES);
    if (first_tile >= ntiles) return;
    for (int i = tid; i < 48 * 128; i += 512) { const int n = i >> 7, c = (i & 127) * 8; *(u32x4*)(WL + n * W48_LD + c) = ldg((const u32x4*)(Wt48 + (size_t)n * 1024 + c)); }
    const int brow1 = (32 + l32) < 48 ? 32 + l32 : 47;
    for (int pm = first_tile; pm < ntiles; pm += tile_step) {
        const bf16* A = (const bf16*)(ws + WS_HXY) + (size_t)pm * 256 * 1024;
        u32x4 ar[4][4];
#pragma unroll
        for (int j = 0; j < 4; ++j)
#pragma unroll
            for (int q = 0; q < 4; ++q) { const int idx = tid + 512 * q; ar[j][q] = ldg((const u32x4*)(A + (size_t)(idx >> 3) * 1024 + 64 * j + (idx & 7) * 8)); }
        f32x16 acc0, acc1;
#pragma unroll
        for (int i = 0; i < 16; ++i) { acc0[i] = 0.f; acc1[i] = 0.f; }
        lbar();
        for (int c4 = 0; c4 < 16; c4 += 4) {
#pragma unroll
            for (int j = 0; j < 4; ++j) { const int c = c4 + j;
#pragma unroll
                for (int q = 0; q < 4; ++q) { const int idx = tid + 512 * q; *(u32x4*)(AS + (idx >> 3) * LD64 + (idx & 7) * 8) = ar[j][q]; }
                if (c + 4 < 16) {
#pragma unroll
                    for (int q = 0; q < 4; ++q) { const int idx = tid + 512 * q; ar[j][q] = ldg((const u32x4*)(A + (size_t)(idx >> 3) * 1024 + 64 * (c + 4) + (idx & 7) * 8)); } }
                lbar();
#pragma unroll
                for (int ks = 0; ks < 4; ++ks) { const bf16x8 a = ldfrag(AS, LD64, 32 * wave, 16 * ks, lane);
                    const bf16x8 b0 = *(const bf16x8*)(WL + l32 * W48_LD + 64 * c + 16 * ks + 8 * hi), b1 = *(const bf16x8*)(WL + brow1 * W48_LD + 64 * c + 16 * ks + 8 * hi);
                    acc0 = MFMA32(a, b0, acc0); acc1 = MFMA32(a, b1, acc1); }
                lbar();
            }
        }
        float* dst = (float*)(ws + WS_SMALL);
        const size_t r0 = (size_t)pm * 256 + wave * 32;
        const float gb = l32 < 16 ? ldg(gate_b + l32) : 0.f; const bool ls = l32 < 16 && ((l32 >> 2) & 1);
#pragma unroll
        for (int i = 0; i < 16; ++i) { float x = acc0[i] + gb; if (ls) x = logsigmoid_(x); stg(dst + (r0 + crow(i, hi)) * 48 + l32, x); }
        if (l32 < 16) {
#pragma unroll
            for (int i = 0; i < 16; ++i) stg(dst + (r0 + crow(i, hi)) * 48 + 32 + l32, acc1[i]); }
    }
    lbar();
}

#ifndef DUP_MASK
#define DUP_MASK 0
#endif
#define XB_TMO      128
#define XB_XCNT(j)  (256  + 64 * (j))
#define XB_XSUB(j)  (1280 + 64 * (j))
#define XB_XGEN(j)  (2304 + 64 * (j))
#define XB_TOP      3328
#define XB_TOPGEN   3392
#define XCD_BAR_WORDS 3456
#define XB_SPIN_CAP (1u << 18)

__device__ __forceinline__ unsigned xb_ld(unsigned* p)              { return __hip_atomic_load(p, __ATOMIC_RELAXED, __HIP_MEMORY_SCOPE_AGENT); }
__device__ __forceinline__ unsigned xb_add(unsigned* p, unsigned v) { return __hip_atomic_fetch_add(p, v, __ATOMIC_RELAXED, __HIP_MEMORY_SCOPE_AGENT); }
__device__ __forceinline__ unsigned xb_xcc_id() { return (unsigned)__builtin_amdgcn_s_getreg((3 << 11) | 20) & 0xFu; }
#define XB_SPIN(cond, bar) do { unsigned _sp = 0; while (cond) { __builtin_amdgcn_s_sleep(1); \
    if ((++_sp & 255u) == 0u) { if (xb_ld(&(bar)[XB_TMO])) break; if (_sp > XB_SPIN_CAP) { atomicAdd(&(bar)[XB_TMO], 1u); break; } } } } while (0)

struct XcdBarrier {
    unsigned* bar; unsigned x;
    volatile unsigned* st;
};

__device__ __forceinline__ XcdBarrier xcd_barrier_post(unsigned* bar, volatile unsigned* st) {
    XcdBarrier b; b.bar = bar; b.x = xb_xcc_id(); b.st = st;
    if (threadIdx.x == 0) (void)xb_add(&bar[XB_XCNT(b.x)], 1u);
    return b;
}
__device__ __forceinline__ void xcd_barrier_complete(unsigned* bar, unsigned x, unsigned& nloc, unsigned& nx) {
    const unsigned G = gridDim.x * gridDim.y * gridDim.z;
    unsigned sum, cnt, mine, sp = 0u;
    for (;;) {
        sum = 0u; cnt = 0u; mine = 0u;
#pragma unroll
        for (unsigned j = 0; j < 16; ++j) { const unsigned c = xb_ld(&bar[XB_XCNT(j)]); sum += c; cnt += (c > 0u) ? 1u : 0u; mine = (j == x) ? c : mine; }
        if (sum == G) break;
        __builtin_amdgcn_s_sleep(1);
        if ((++sp & 255u) == 0u) { if (xb_ld(&bar[XB_TMO])) break; if (sp > XB_SPIN_CAP) { atomicAdd(&bar[XB_TMO], 1u); break; } }
    }
    nloc = mine > 0u ? mine : 1u; nx = cnt > 0u ? cnt : 1u;
}

__device__ __forceinline__ void xcd_barrier(const XcdBarrier& b) {
    asm volatile("s_waitcnt vmcnt(0)" ::: "memory");
    __syncthreads();
    if (threadIdx.x == 0) {
        unsigned* bar = b.bar;
        __builtin_amdgcn_s_waitcnt(0);
        unsigned nloc = b.st[0], nx = b.st[1];
        if (nloc == 0u) { xcd_barrier_complete(bar, b.x, nloc, nx); b.st[0] = nloc; b.st[1] = nx; }
        const unsigned old = xb_add(&bar[XB_XSUB(b.x)], 1u);
        const unsigned gen = old / nloc;
        if (old + 1u == (gen + 1u) * nloc) {
            __builtin_amdgcn_fence(__ATOMIC_RELEASE, "agent");
            asm volatile("s_waitcnt vmcnt(0)" ::: "memory");
            const unsigned og = xb_add(&bar[XB_TOP], 1u);
            const unsigned tg = og / nx;
            if (og + 1u == (tg + 1u) * nx) xb_add(&bar[XB_TOPGEN], 1u);
            else XB_SPIN(xb_ld(&bar[XB_TOPGEN]) == tg, bar);
            __builtin_amdgcn_fence(__ATOMIC_ACQUIRE, "agent");
            xb_add(&bar[XB_XGEN(b.x)], 1u);
            asm volatile("s_waitcnt vmcnt(0)" ::: "memory");
        } else {
            XB_SPIN(xb_ld(&bar[XB_XGEN(b.x)]) == gen, bar);
            __builtin_amdgcn_fence(__ATOMIC_ACQUIRE, "agent");
            asm volatile("s_waitcnt vmcnt(0)" ::: "memory");
        }
    }
    __syncthreads();
}

DI void gbar(unsigned* cnt, unsigned target) {
    asm volatile("s_waitcnt vmcnt(0) lgkmcnt(0)" ::: "memory");
    __syncthreads();
    if (threadIdx.x == 0) {
        __builtin_amdgcn_fence(__ATOMIC_RELEASE, "agent");
        __hip_atomic_fetch_add(cnt, 1u, __ATOMIC_RELAXED, __HIP_MEMORY_SCOPE_AGENT);
        while (__hip_atomic_load(cnt, __ATOMIC_RELAXED, __HIP_MEMORY_SCOPE_AGENT) < target) __builtin_amdgcn_s_sleep(1);
        __builtin_amdgcn_fence(__ATOMIC_ACQUIRE, "agent");
    }
    __syncthreads();
}
#define GSYNC() do { XcdBarrier xb_; xb_.bar = (unsigned*)(ws + WS_XBAR); xb_.x = xb_xcc_id(); xb_.st = (volatile unsigned*)(lds + LDS_BYTES - 64); xcd_barrier(xb_); if ((DUP_MASK) & 256) xcd_barrier(xb_); } while (0)
#define DUPN(bit) (((DUP_MASK) & (bit)) ? 2 : 1)
__global__ void __launch_bounds__(512, 2) fwd_kernel(Args a) {
    extern __shared__ __attribute__((aligned(16))) unsigned char lds[];
    cg::grid_group grid = cg::this_grid();
#ifdef PAD_NOPS
    asm volatile(".rept " PAD_NOPS "\n s_nop 0\n .endr" ::: );
#endif
    unsigned char* ws = a.ws;
    int tid = threadIdx.x, lane = tid & 63, wave = __builtin_amdgcn_readfirstlane(tid >> 6);
    const int G = gridDim.x, bid = blockIdx.x;
    float* MODV = (float*)(ws + WS_MODV); float* MISC = (float*)(ws + WS_MISC);
    if (bid == 0 && tid < 24) ((const float**)(ws + WS_ARGS))[tid] = tid < 23 ? a.in[tid] : (const float*)a.out;
    volatile unsigned* xst = (volatile unsigned*)(lds + LDS_BYTES - 64);
    if (tid < 2) xst[tid] = 0u;
    __syncthreads();
    (void)xcd_barrier_post((unsigned*)(ws + WS_XBAR), xst);


    for (int rep = 0; rep < DUPN(128); ++rep) {
        for (int task = bid; task < 96; task += G) {
            const int l = task / 48, n0 = (task % 48) * 64, n = n0 + lane;
            const float* wm = a.in[4] + (size_t)l * 1024 * 3072; const float* c = a.in[1]; const float* cc = a.in[3];
            float* SV = (float*)lds;
            for (int i = tid; i < 3072; i += 512) { const float x = i < 2048 ? c[i] : cc[i - 2048]; SV[i] = silu_(x); }
            __syncthreads();
            float a0 = 0.f, a1 = 0.f, a2 = 0.f;
            for (int k0 = 0; k0 < 128; k0 += 32) { float w[32];
#pragma unroll
                for (int kk = 0; kk < 32; ++kk) w[kk] = wm[(size_t)(wave * 128 + k0 + kk) * 3072 + n];
#pragma unroll
                for (int kk = 0; kk < 32; ++kk) { const int k = wave * 128 + k0 + kk; a0 += SV[k] * w[kk]; a1 += SV[1024 + k] * w[kk]; a2 += SV[2048 + k] * w[kk]; } }
            float* red = (float*)(lds + 131072);
            red[(wave * 3 + 0) * 64 + lane] = a0; red[(wave * 3 + 1) * 64 + lane] = a1; red[(wave * 3 + 2) * 64 + lane] = a2;
            __syncthreads();
            if (tid < 192) { const int v = tid >> 6; float s = a.in[5][l * 3072 + n0 + lane];
                for (int w = 0; w < 8; ++w) s += red[(w * 3 + v) * 64 + lane];
                MODV[(l * 3 + v) * 3072 + n0 + lane] = s; }
            __syncthreads();
        }
        if (bid == G - 1) {
            float* tabA = (float*)(ws + WS_TABA); float* tabD = (float*)(ws + WS_TABD);
            for (int idx = tid; idx < 128 * 8; idx += 512) { const int pos = idx >> 3, i = idx & 7;
                const float inv = exp2f(-(float)i * (13.287712379549449f / 8.f)); const float ang = (float)pos * inv;
                double rev = (double)ang * 0.15915494309189535; rev -= rint(rev);
                tabA[pos * 16 + i] = __builtin_amdgcn_cosf((float)rev); tabA[pos * 16 + 8 + i] = __builtin_amdgcn_sinf((float)rev); }
            for (int idx = tid; idx < 128 * 16; idx += 512) { const int pos = idx >> 4, i = idx & 15;
                const float inv = exp2f(-(float)i * (13.287712379549449f / 16.f)); const float ang = (float)pos * inv;
                double rev = (double)ang * 0.15915494309189535; rev -= rint(rev);
                tabD[pos * 32 + i] = __builtin_amdgcn_cosf((float)rev); tabD[pos * 32 + 16 + i] = __builtin_amdgcn_sinf((float)rev); }
            if (tid < 2) { const int l = tid; const float* lp = a.in[11] + l * 128; float s1 = 0.f, s2 = 0.f;
                for (int d = 0; d < 32; ++d) { s1 += lp[d] * lp[32 + d]; s2 += lp[64 + d] * lp[96 + d]; }
                const float lam_init = 0.8f - 0.6f * expf(-0.3f * (float)l);
                float gq = 0.f, gk = 0.f, gqd = 0.f, gkd = 0.f, sk = 0.f;
                for (int d = 0; d < 32; ++d) { gq = fmaxf(gq, fabsf(a.in[9][l * 32 + d])); gk = fmaxf(gk, fabsf(a.in[10][l * 32 + d])); }
                for (int d = 0; d < 64; ++d) { gqd = fmaxf(gqd, fabsf(a.in[20][l * 64 + d])); gkd = fmaxf(gkd, fabsf(a.in[21][l * 64 + d])); }
                for (int d = 0; d < 4; ++d) sk = fmaxf(sk, a.in[22][l * 4 + d] * LOG2E);
                MISC[l * 8 + 0] = expf(s1) - expf(s2) + lam_init; MISC[l * 8 + 1] = lam_init;
                MISC[l * 8 + 2] = 5.656854249f * LOG2E * gq * gk * 1.01f; MISC[l * 8 + 3] = fmaxf(8.f * LOG2E * gqd * gkd * 1.01f, sk); }
        }
        float* scr = (float*)(lds + wave * 16384);
        const int gw = bid * 8 + wave, NGW = G * 8;
        for (int it = gw; it < 2048; it += NGW) {
            if (it < 4096) { const int l = it >> 11; transpose_item(a.in[7] + (size_t)l * 1024 * NSRC, NSRC, true, (bf16*)(ws + WS_WIN) + (size_t)l * NP * 1024, 1024, it & 2047, NP / 32, scr, lane); }
            else { const int r = it - 4096, l = r >> 9; transpose_item(a.in[8] + (size_t)l * 1024 * 1024, 1024, false, (bf16*)(ws + WS_WOUT) + (size_t)l * 1024 * 1024, 1024, r & 511, 32, scr, lane); }
        }
    }
    if (a.ws == nullptr) grid.sync();
    GSYNC();

#pragma unroll 1
    for (int l = 0; l < 2; ++l) {
        asm volatile("" : "+s"(ws));
        const float* const* IN = (const float* const*)(ws + WS_ARGS); float* OUT = (float*)IN[23];
        const float* xsrc = l == 0 ? IN[0] : OUT; const float* csrc = l == 0 ? IN[2] : (const float*)(ws + WS_CTX);
        tid = otid(); lane = tid & 63; wave = __builtin_amdgcn_readfirstlane(tid >> 6);
        {
            const int gw = bid * 8 + wave, NGW = G * 8; const float* ng = IN[6] + l * 1024;
            for (int rep = 0; rep < DUPN(1); ++rep)
            for (int m0 = gw; m0 < M; m0 += 2 * NGW) {
                const float* srcs[2]; int vs[2]; bool ok[2]; f32x4 x[2][4];
#pragma unroll
                for (int r = 0; r < 2; ++r) { const int m = m0 + r * NGW; ok[r] = m < M; const int mm = ok[r] ? m : m0;
                    const int b = mm >= TK ? 1 : 0, j = mm - b * TK;
                    if (j < LC) { srcs[r] = csrc + (size_t)(b * LC + j) * D; vs[r] = 2; } else { srcs[r] = xsrc + (size_t)(b * T + j - LC) * D; vs[r] = b; }
#pragma unroll
                    for (int q = 0; q < 4; ++q) x[r][q] = ldg((const f32x4*)srcs[r] + lane + 64 * q); }
#pragma unroll
                for (int r = 0; r < 2; ++r) { if (!ok[r]) continue; const int m = m0 + r * NGW;
                    const float* md = MODV + (l * 3 + vs[r]) * 3072; float ss = 0.f;
#pragma unroll
                    for (int q = 0; q < 4; ++q) ss += (x[r][q].x * x[r][q].x + x[r][q].y * x[r][q].y) + (x[r][q].z * x[r][q].z + x[r][q].w * x[r][q].w);
                    const float rinv = rsqrtf(wave_sum(ss) * (1.f / 1024.f) + EPS);
                    bf16* dst = (bf16*)(ws + WS_HXY) + (size_t)m * D;
#pragma unroll
                    for (int q = 0; q < 4; ++q) { const int col = 4 * (lane + 64 * q);
                        const f32x4 g = ldg((const f32x4*)(ng + col)), sh = ldg((const f32x4*)(md + col)), sc = ldg((const f32x4*)(md + 1024 + col));
                        const f32x4 y = (x[r][q] * rinv) * g * (sc + 1.f) + sh;
                        stg((u32x2*)(dst + col), (u32x2){pk(y.x, y.y), pk(y.z, y.w)}); } }
            }
        }
        GSYNC();
        {
#ifdef USE_MINI
            constexpr int NBIG = 3840, NUNITS = (M / 256) * (NBIG / 256);
            { const int first = NUNITS % G;
              if (bid >= first) mini_proj(lds, ws, bid - first, G - first, M / 256, (const bf16*)(ws + WS_WIN) + ((size_t)l * NP + NBIG) * 1024, IN[15] + l * 16); }
#else
            constexpr int NBIG = NP;
#endif
            pg8::Gemm g{(const pg8::bf16_t*)(ws + WS_HXY), (const pg8::bf16_t*)(ws + WS_WIN) + (size_t)l * NP * 1024, M, NBIG, D};
            pg8::StaticOrder S; S.init(M, NBIG, G, bid);
            EpiIn E{ws, l};
            for (int rep = 0; rep < DUPN(2); ++rep) pg8::gemm_phase<EpiIn, pg8::StaticOrder, true, true>((PG8_LAS unsigned char*)lds, g, S, E);
        }
        GSYNC();
        {
            const float* misc = MISC + l * 8;
#ifdef PAD_CA
            asm volatile("s_nop 0");
#endif
            fill_wcache(lds, IN, l);
            for (int rep = 0; rep < DUPN(4); ++rep) {
                { const float* cw = (const float*)(lds + WC_OFF) + WC_CW; const float* cb = (const float*)(lds + WC_OFF) + WC_CB;
                  int t = bid; MaPre cur = mlstm_a_load(ws, t < 8 * NCH ? t : 0);
                  while (t < 8 * NCH) { const int tn = t + G; MaPre nxt = mlstm_a_load(ws, tn < 8 * NCH ? tn : t); mlstm_a_run(lds, ws, t, cur, cw, cb); cur = nxt; t = tn; } }
                { const float* wg = (const float*)(lds + WC_OFF) + WC_WG; const float* bg = (const float*)(lds + WC_OFF) + WC_BG;
                  int t = bid; GlPre cur = gla_load(ws, t < 8 * NCH ? t : 0, false);
                  while (t < 8 * NCH) { const int tn = t + G; GlPre nxt = gla_load(ws, tn < 8 * NCH ? tn : t, false); gla_a_run(lds, ws, t, cur, wg, bg); cur = nxt; t = tn; } }
            }
#ifdef PAD_CA
            asm volatile("s_nop 0");
#endif
            const int nU = l == 0 ? 264 : 256;
            for (int rep = 0; rep < DUPN(8); ++rep)
            for (int u = bid; u < nU; u += G) attnD_unit(lds, ws, u, IN[22] + l * 4, misc);
            for (int rep = 0; rep < DUPN(16); ++rep)
            for (int u = bid; u < nU; u += G) attnA_unit(lds, ws, u, IN[12] + l * 64, misc);
        }
        GSYNC();
        for (int t = bid; t < 208; t += G) scan_b(lds, ws, t);
        if (l == 0) {
            float* scr = (float*)(lds + wave * 16384);
            for (int it = 2048 + bid * 8 + wave; it < 2 * 2048 + 2 * 512; it += G * 8) {
                if (it < 4096) { transpose_item(IN[7] + (size_t)1024 * NSRC, NSRC, true, (bf16*)(ws + WS_WIN) + (size_t)NP * 1024, 1024, it & 2047, NP / 32, scr, lane); }
                else { const int r = it - 4096, ll = r >> 9; transpose_item(IN[8] + (size_t)ll * 1024 * 1024, 1024, false, (bf16*)(ws + WS_WOUT) + (size_t)ll * 1024 * 1024, 1024, r & 511, 32, scr, lane); }
            }
            __syncthreads();
        }
        GSYNC();
#ifdef PAD_CC
        asm volatile("s_nop 0");
#endif
        fill_wcache(lds, IN, l);
        for (int rep = 0; rep < DUPN(32); ++rep) {
            const int ncl = l == 0 ? NCH : NCH - 4, ntask = 8 * ncl;
#define C_TASK(u) (((u) / ncl) * NCH + ((u) % ncl) + (NCH - ncl))
            { const float* cw = (const float*)(lds + WC_OFF) + WC_CW; const float* cb = (const float*)(lds + WC_OFF) + WC_CB; const float* on = (const float*)(lds + WC_OFF) + WC_BON;
              int u = bid; McPre cur = mlstm_c_load(ws, C_TASK(u < ntask ? u : 0));
              while (u < ntask) { const int un = u + G; McPre nxt = mlstm_c_load(ws, C_TASK(un < ntask ? un : u)); mlstm_c_run(lds, ws, C_TASK(u), cur, cw, cb, on); cur = nxt; u = un; } }
            { const float* wg = (const float*)(lds + WC_OFF) + WC_WG; const float* bg = (const float*)(lds + WC_OFF) + WC_BG; const float* on = (const float*)(lds + WC_OFF) + WC_CON;
              int u = bid; GcPre cur = gla_c_load(ws, C_TASK(u < ntask ? u : 0));
              while (u < ntask) { const int un = u + G; GcPre nxt = gla_c_load(ws, C_TASK(un < ntask ? un : u)); gla_c_run(lds, ws, C_TASK(u), cur, wg, bg, on); cur = nxt; u = un; } }
        }
#ifdef PAD_CC
        asm volatile("s_nop 0");
#endif
        GSYNC();
        {
            pg8::Gemm g{(const pg8::bf16_t*)(ws + WS_HXY), (const pg8::bf16_t*)(ws + WS_WOUT) + (size_t)l * 1024 * 1024, M, D, D};
            EpiOut E{xsrc, csrc, OUT, (float*)(ws + WS_CTX), MODV + l * 3 * 3072};
            if (l == 0) { pg8::StaticOrder S; S.init(M, D, G, bid); for (int rep = 0; rep < DUPN(64); ++rep) pg8::gemm_phase<EpiOut, pg8::StaticOrder, true, true>((PG8_LAS unsigned char*)lds, g, S, E); }
            else { LatOrder S; S.so.init(NB * T, D, G, bid); pg8::gemm_phase<EpiOut, LatOrder, true, true>((PG8_LAS unsigned char*)lds, g, S, E); }
        }
        if (l == 0) GSYNC();
    }
}

extern "C" void kernel_launch(void* const* d_in, const int* in_sizes, int n_in, void* d_out, int out_size, void* d_ws, size_t ws_size, hipStream_t stream) {
    static int grid = 0;
    if (grid == 0) {
        int dev = 0, cus = 0, per_cu = 0;
        if (n_in != 23 || ws_size < 256 * MiB) { fprintf(stderr, "kernel_launch: unexpected inputs (n_in %d, ws %zu)\n", n_in, ws_size); grid = -1; return; }
        hipGetDevice(&dev); hipDeviceGetAttribute(&cus, hipDeviceAttributeMultiprocessorCount, dev);
        if (hipFuncSetAttribute((const void*)fwd_kernel, hipFuncAttributeMaxDynamicSharedMemorySize, LDS_BYTES) != hipSuccess) { fprintf(stderr, "kernel_launch: hipFuncSetAttribute failed\n"); grid = -1; return; }
        if (hipOccupancyMaxActiveBlocksPerMultiprocessor(&per_cu, (const void*)fwd_kernel, 512, LDS_BYTES) != hipSuccess || per_cu < 1) { fprintf(stderr, "kernel_launch: occupancy query says %d\n", per_cu); per_cu = 1; }
        (void)hipGetLastError();
        grid = cus > 0 ? cus : 256;
    }
    if (grid < 0) return;
    Args a{};
    for (int i = 0; i < 23; ++i) a.in[i] = (const float*)d_in[i];
    a.out = (float*)d_out; a.ws = (unsigned char*)d_ws;
    if (hipMemsetAsync((char*)d_ws + WS_XBAR, 0, 16384, stream) != hipSuccess) { fprintf(stderr, "kernel_launch: memset of the barrier word failed\n"); return; }
    void* args[] = {&a};
    hipError_t e = hipLaunchCooperativeKernel((const void*)fwd_kernel, dim3(grid), dim3(512), args, LDS_BYTES, stream);
    if (e != hipSuccess) fprintf(stderr, "kernel_launch: cooperative launch failed: %s (grid %d)\n", hipGetErrorString(e), grid);
}
```

```cpp
#include <hip/hip_runtime.h>
#include <hip/hip_cooperative_groups.h>
#include <cstdio>
#include <cstdint>
namespace cg = cooperative_groups;
#define DUP_MASK 0
#define PAD_NOPS "6"
#define USE_MINI
namespace pg8 {
#define PG8_LAS __attribute__((address_space(3)))
typedef unsigned short bf16_t;
typedef short bf16x8 __attribute__((ext_vector_type(8)));
typedef float f32x4 __attribute__((ext_vector_type(4)));
typedef unsigned u32x4 __attribute__((ext_vector_type(4)));
constexpr int BM = 256, BK = 64, HALF = 128, HTB = HALF * BK * 2  , STAGE_BYTES = 8 * HTB, NXCD = 8, WGM = 8;

__host__ __device__ __forceinline__ int lds_byte(int r, int c) { const int st = (r >> 4) * 2 + (c >> 5), rr = r & 15, cc = c & 31, ob = rr * 64 + cc * 2; return st * 1024 + (ob ^ (((ob >> 9) & 1) << 5)); }
__host__ __device__ __forceinline__ void stage_rc(int b, int& R, int& C) { const int st = b / 1024, sb = b % 1024, swz = sb ^ (((sb >> 9) & 1) << 5); R = (st >> 1) * 16 + swz / 64; C = (st & 1) * 32 + (swz % 64) / 2; }
__host__ __device__ __forceinline__ int perm32(int rho) { const int n = rho >> 4, i = rho & 15; return 8 * (i >> 2) + 4 * n + (i & 3); }

struct Unit { int pm, pn; };
struct Gemm { const bf16_t* A; const bf16_t* Bt; int M, N, K; };

struct StaticOrder {
    int nM, nN, nwg, G, c;
    __host__ __device__ void init(int M, int N, int G_, int c_) { nM = M / BM; nN = N / BM; nwg = nM * nN; G = G_; c = c_; }
    __host__ __device__ bool next(int i, Unit& u) const {
        const long L = (long)i * G + c; if (L >= nwg) return false;
        int wgid = (int)L; { const int q = nwg / NXCD, r = nwg % NXCD, xcd = wgid % NXCD, off = wgid / NXCD; wgid = (xcd < r ? xcd * (q + 1) : r * (q + 1) + (xcd - r) * q) + off; }
        const int nig = WGM * nN, gid = wgid / nig, fm = gid * WGM, gsz = (nM - fm) < WGM ? (nM - fm) : WGM;
        u.pm = fm + ((wgid % nig) % gsz); u.pn = (wgid % nig) / gsz; return true;
    }
    __device__ __forceinline__ void a_ready(const Unit&) const {}
    __device__ __forceinline__ void done(const Unit&) const {}
};

__device__ __forceinline__ unsigned cvt_pk_bf16(float lo, float hi) { unsigned r; asm volatile("v_cvt_pk_bf16_f32 %0, %1, %2" : "=v"(r) : "v"(lo), "v"(hi)); return r; }
typedef float f32x2 __attribute__((ext_vector_type(2)));
template <class Epi, class Sched, bool ALIGN_EPI = false, bool SP2 = false>
__device__ __forceinline__ void gemm_phase(PG8_LAS unsigned char* lds, const Gemm g, const Sched& S, const Epi& E) {
    int tid_ = threadIdx.x; asm volatile("" : "+v"(tid_)); const int tid = tid_, wid = __builtin_amdgcn_readfirstlane(tid >> 6), lane = tid & 63, wr = wid >> 2, wc = wid & 3, fr = lane & 15, fq = lane >> 4;
    const int K = g.K, nt = K / BK;
    unsigned voffA[2], voffB[2];
#pragma unroll
    for (int i = 0; i < 2; ++i) { int R, C; stage_rc(tid * 16 + i * 8192, R, C); const int Rb = Epi::PERM ? ((R & ~31) + perm32(R & 31)) : R;
        voffA[i] = (unsigned)(R * K + C) * 2u; voffB[i] = (unsigned)(Rb * K + C) * 2u; }
    const size_t kstep = (size_t)(BK * 2);
    const size_t hstep = (size_t)HALF * K * 2;
    const size_t tstep = 2 * hstep;
    const unsigned ldsw = (unsigned)wid * 1024u;
    const int aoff = lds_byte(wr * 64 + fr, fq * 8), boff = lds_byte(wc * 32 + fr, fq * 8);
#define PG8_SA(b, h) (((b) * 2 + (h)) * HTB)
#define PG8_SB(b, h) ((4 + (b) * 2 + (h)) * HTB)
#define PG8_STAGE(bufoff, gbase, voff) do { _Pragma("unroll") for (int _i = 0; _i < 2; ++_i) \
        __builtin_amdgcn_global_load_lds((const unsigned*)((const char*)(gbase) + (voff)[_i]), (PG8_LAS unsigned*)(lds + (bufoff) + ldsw + _i * 8192), 16, 0, 0); } while (0)
#define PG8_LDA(dst, b, h) do { _Pragma("unroll") for (int m = 0; m < 4; ++m) _Pragma("unroll") for (int k = 0; k < 2; ++k) dst[m][k] = *(const PG8_LAS bf16x8*)(lds + PG8_SA(b, h) + aoff + m * 2048 + k * 1024); } while (0)
#define PG8_LDB(dst, b, h) do { _Pragma("unroll") for (int n = 0; n < 2; ++n) _Pragma("unroll") for (int k = 0; k < 2; ++k) dst[n][k] = *(const PG8_LAS bf16x8*)(lds + PG8_SB(b, h) + boff + n * 2048 + k * 1024); } while (0)
#define PG8_MMA(ai, bj, At, Bt) do { __builtin_amdgcn_s_setprio(1); _Pragma("unroll") for (int m = 0; m < 4; ++m) _Pragma("unroll") for (int n = 0; n < 2; ++n) _Pragma("unroll") for (int k = 0; k < 2; ++k) \
        acc[ai][bj][m][n] = __builtin_amdgcn_mfma_f32_16x16x32_bf16(Bt[n][k], At[m][k], acc[ai][bj][m][n], 0, 0, 0); __builtin_amdgcn_s_setprio(0); } while (0)
#define PG8_WAIT_V(n) asm volatile("s_waitcnt vmcnt(" #n ")" ::: "memory")
#define PG8_WAIT_L(n) asm volatile("s_waitcnt lgkmcnt(" #n ")" ::: "memory")
#define PG8_BAR __builtin_amdgcn_s_barrier()
#define PG8_SCHED __builtin_amdgcn_sched_barrier(0)
    Unit cur, nxt; int ui = 0;
    if (!S.next(0, cur)) return;
    f32x4 acc[2][2][4][2];
#pragma unroll
    for (int a = 0; a < 2; ++a)
#pragma unroll
        for (int b = 0; b < 2; ++b)
#pragma unroll
            for (int m = 0; m < 4; ++m)
#pragma unroll
                for (int n = 0; n < 2; ++n) acc[a][b][m][n] = (f32x4){0.f, 0.f, 0.f, 0.f};
    bf16x8 At[4][2], B0[2][2], B1[2][2];
    const char* cA = (const char*)g.A + (size_t)cur.pm * tstep; const char* cB = (const char*)g.Bt + (size_t)cur.pn * tstep;
    S.a_ready(cur);
    if constexpr (SP2) {
        PG8_STAGE(PG8_SB(0, 0), cB, voffB); PG8_STAGE(PG8_SB(0, 1), cB + hstep, voffB); PG8_STAGE(PG8_SA(0, 0), cA, voffA); PG8_STAGE(PG8_SA(0, 1), cA + hstep, voffA);
        if (wr == 1) PG8_BAR;
        PG8_WAIT_V(2); PG8_BAR;
        PG8_STAGE(PG8_SB(1, 0), cB + kstep, voffB); PG8_STAGE(PG8_SA(1, 0), cA + kstep, voffA); PG8_STAGE(PG8_SB(1, 1), cB + hstep + kstep, voffB);
        PG8_WAIT_V(6); PG8_BAR;
    } else {
        PG8_STAGE(PG8_SB(0, 0), cB, voffB); PG8_STAGE(PG8_SA(0, 0), cA, voffA); PG8_STAGE(PG8_SB(0, 1), cB + hstep, voffB); PG8_STAGE(PG8_SA(0, 1), cA + hstep, voffA);
        if (wr == 1) PG8_BAR;
        PG8_WAIT_V(4); PG8_BAR;
        PG8_STAGE(PG8_SB(1, 0), cB + kstep, voffB); PG8_STAGE(PG8_SA(1, 0), cA + kstep, voffA); PG8_STAGE(PG8_SB(1, 1), cB + hstep + kstep, voffB);
        PG8_WAIT_V(6); PG8_BAR;
    }
#ifdef PAD_G
    if constexpr (Epi::PADK) asm volatile("s_nop 0");
#endif
    for (;;) {
        const bool has_next = S.next(ui + 1, nxt);
        const char* nA = has_next ? (const char*)g.A + (size_t)nxt.pm * tstep : cA; const char* nB = has_next ? (const char*)g.Bt + (size_t)nxt.pn * tstep : cB;
        for (int t = 0; t < nt; t += 2) {
            const bool last = (t == nt - 2);
            const char* a1 = cA + (size_t)(t + 1) * kstep;
            const char* a2 = last ? nA : cA + (size_t)(t + 2) * kstep; const char* b2 = last ? nB : cB + (size_t)(t + 2) * kstep;
            const char* a3 = a2 + kstep; const char* b3 = b2 + kstep;
            if (last && has_next) S.a_ready(nxt);
            if constexpr (SP2) {
            PG8_LDB(B0, 0, 0); PG8_LDB(B1, 0, 1); PG8_SCHED; PG8_LDA(At, 0, 0); PG8_STAGE(PG8_SA(1, 1), a1 + hstep, voffA);
            PG8_WAIT_V(8); PG8_WAIT_L(0); PG8_BAR; PG8_MMA(0, 0, At, B0); PG8_MMA(0, 1, At, B1); PG8_BAR; PG8_SCHED;
            PG8_LDA(At, 0, 1); PG8_STAGE(PG8_SB(0, 0), b2, voffB); PG8_STAGE(PG8_SB(0, 1), b2 + hstep, voffB); PG8_STAGE(PG8_SA(0, 0), a2, voffA);
            PG8_WAIT_V(8); PG8_WAIT_L(0); PG8_BAR; PG8_MMA(1, 0, At, B0); PG8_MMA(1, 1, At, B1); PG8_BAR; PG8_SCHED;
            PG8_LDB(B0, 1, 0); PG8_LDB(B1, 1, 1); PG8_SCHED; PG8_LDA(At, 1, 0); PG8_STAGE(PG8_SA(0, 1), a2 + hstep, voffA);
            PG8_WAIT_V(8); PG8_WAIT_L(0); PG8_BAR; PG8_MMA(0, 0, At, B0); PG8_MMA(0, 1, At, B1); PG8_BAR; PG8_SCHED;
            PG8_LDA(At, 1, 1); PG8_STAGE(PG8_SB(1, 0), b3, voffB); PG8_STAGE(PG8_SB(1, 1), b3 + hstep, voffB); PG8_STAGE(PG8_SA(1, 0), a3, voffA);
            PG8_WAIT_V(8); PG8_WAIT_L(0); PG8_BAR; PG8_MMA(1, 0, At, B0); PG8_MMA(1, 1, At, B1); PG8_BAR; PG8_SCHED;
            } else {
            PG8_LDB(B0, 0, 0); PG8_SCHED; PG8_LDA(At, 0, 0); PG8_STAGE(PG8_SA(1, 1), a1 + hstep, voffA);
            PG8_WAIT_L(8); PG8_BAR; PG8_WAIT_L(0); PG8_MMA(0, 0, At, B0); PG8_BAR; PG8_SCHED;
            PG8_LDB(B1, 0, 1); PG8_STAGE(PG8_SB(0, 0), b2, voffB);
            PG8_BAR; PG8_WAIT_L(0); PG8_MMA(0, 1, At, B1); PG8_BAR;
            PG8_LDA(At, 0, 1); PG8_STAGE(PG8_SA(0, 0), a2, voffA);
            PG8_BAR; PG8_WAIT_L(0); PG8_MMA(1, 0, At, B0); PG8_BAR; PG8_SCHED;
            PG8_STAGE(PG8_SB(0, 1), b2 + hstep, voffB);
            PG8_WAIT_V(6); PG8_BAR; PG8_MMA(1, 1, At, B1); PG8_BAR;
            PG8_LDB(B0, 1, 0); PG8_SCHED; PG8_LDA(At, 1, 0); PG8_STAGE(PG8_SA(0, 1), a2 + hstep, voffA);
            PG8_WAIT_L(8); PG8_BAR; PG8_WAIT_L(0); PG8_MMA(0, 0, At, B0); PG8_BAR; PG8_SCHED;
            PG8_LDB(B1, 1, 1); PG8_STAGE(PG8_SB(1, 0), b3, voffB);
            PG8_BAR; PG8_WAIT_L(0); PG8_MMA(0, 1, At, B1); PG8_BAR;
            PG8_LDA(At, 1, 1); PG8_STAGE(PG8_SA(1, 0), a3, voffA);
            PG8_BAR; PG8_WAIT_L(0); PG8_MMA(1, 0, At, B0); PG8_BAR; PG8_SCHED;
            PG8_STAGE(PG8_SB(1, 1), b3 + hstep, voffB);
            PG8_WAIT_V(6); PG8_BAR; PG8_MMA(1, 1, At, B1); PG8_BAR;
            }
        }
        if constexpr (ALIGN_EPI) { if (wr == 0) PG8_BAR; }
        if constexpr (!Epi::AFTER_DRAIN) { E(acc, cur, wr, wc, fr, fq); S.done(cur); }
        if (!has_next) break;
#pragma unroll
        for (int a = 0; a < 2; ++a)
#pragma unroll
            for (int b = 0; b < 2; ++b)
#pragma unroll
                for (int m = 0; m < 4; ++m)
#pragma unroll
                    for (int n = 0; n < 2; ++n) acc[a][b][m][n] = (f32x4){0.f, 0.f, 0.f, 0.f};
        cur = nxt; cA = nA; cB = nB; ++ui;
        if constexpr (ALIGN_EPI) { if (wr == 1) PG8_BAR; }
    }
#ifdef PAD_G
    if constexpr (Epi::PADK) asm volatile("s_nop 0");
#endif
    PG8_WAIT_V(0);
    if constexpr (!ALIGN_EPI) { if (wr == 0) PG8_BAR; }
    PG8_BAR;
    if constexpr (Epi::AFTER_DRAIN) { E.fused(acc, cur, wr, wc, fr, fq, lds, wid, lane); S.done(cur); }
#undef PG8_SA
#undef PG8_SB
#undef PG8_STAGE
#undef PG8_LDA
#undef PG8_LDB
#undef PG8_MMA
#undef PG8_WAIT_V
#undef PG8_WAIT_L
#undef PG8_BAR
#undef PG8_SCHED
}
}

#define DI __device__ __forceinline__
typedef unsigned short bf16;
typedef short bf16x8 __attribute__((ext_vector_type(8)));
typedef float f32x4 __attribute__((ext_vector_type(4)));
typedef float f32x16 __attribute__((ext_vector_type(16)));
typedef unsigned u32x4 __attribute__((ext_vector_type(4)));
typedef unsigned u32x2 __attribute__((ext_vector_type(2)));
typedef __bf16 bf16x2_t __attribute__((ext_vector_type(2)));
typedef float f32x2_t __attribute__((ext_vector_type(2)));
#define MFMA32(a, b, c) __builtin_amdgcn_mfma_f32_32x32x16_bf16((a), (b), (c), 0, 0, 0)

constexpr int NB = 2, T = 8192, LC = 256, TK = 8448, M = NB * TK, D = 1024, NSRC = 3888, NP = 4096, NCH = 132;
constexpr float EPS = 1e-6f, LOG2E = 1.4426950408889634f;
constexpr int LDS_BYTES = 147456;

constexpr size_t MiB = 1u << 20;
constexpr size_t S8 = (size_t)M * 256 * 2, S4 = S8 / 2;
constexpr size_t WS_ARGS = 512 * 1024, WS_XBAR = 64 * 1024;
constexpr size_t WS_MODV = 1 * MiB, WS_TABA = WS_MODV + 131072, WS_TABD = WS_TABA + 8192, WS_MISC = WS_TABD + 16384;
constexpr size_t WS_WIN = 2 * MiB, WS_WOUT = 18 * MiB, WS_CTX = 22 * MiB, WS_HXY = 24 * MiB;
constexpr size_t WS_QA = 57 * MiB, WS_KA = WS_QA + S8, WS_VAT = WS_KA + S8, WS_QB = WS_VAT + S8, WS_KB = WS_QB + S8, WS_VBT = WS_KB + S8, WS_OB = WS_VBT + S8;
constexpr size_t WS_QC = WS_OB + S8, WS_KC = WS_QC + S4, WS_VCT = WS_KC + S4, WS_QD = WS_VCT + S8, WS_KD = WS_QD + S8, WS_VDT = WS_KD + S4, WS_GATE = WS_VDT + S4;
constexpr size_t WS_SMALL = WS_GATE + 4 * S8;
constexpr size_t WS_CST = 184 * MiB, WS_NST = 217 * MiB, WS_SSC = WS_NST + 768 * 1024, WS_SST = 218 * MiB, WS_GD = WS_SST + (size_t)16 * NCH * 2048 * 4;
static_assert(WS_SMALL + (size_t)M * 48 * 4 <= WS_CST, "ws map");
static_assert(WS_CST + (size_t)16 * NCH * 4096 * 4 <= WS_NST, "ws map");
static_assert(WS_GD + (size_t)16 * NCH * 32 * 4 <= 256 * MiB, "ws map");

DI unsigned pk(float lo, float hi) { f32x2_t v = {lo, hi}; bf16x2_t b = __builtin_convertvector(v, bf16x2_t); return __builtin_bit_cast(unsigned, b); }
DI bf16 f2b(float x) { return (bf16)(pk(x, 0.f) & 0xffffu); }
DI float b2f(bf16 x) { return __uint_as_float((unsigned)x << 16); }
DI float bfe(const u32x4& v, int e) { const unsigned w = v[e >> 1]; return __uint_as_float((e & 1) ? (w & 0xffff0000u) : (w << 16)); }
DI float bfe2(const u32x2& v, int e) { const unsigned w = v[e >> 1]; return __uint_as_float((e & 1) ? (w & 0xffff0000u) : (w << 16)); }
DI void st8(bf16* p, const float* v) { u32x4 w; w.x = pk(v[0], v[1]); w.y = pk(v[2], v[3]); w.z = pk(v[4], v[5]); w.w = pk(v[6], v[7]); *(u32x4*)p = w; }
DI void st8g(bf16* p, const float* v) { u32x4 w; w.x = pk(v[0], v[1]); w.y = pk(v[2], v[3]); w.z = pk(v[4], v[5]); w.w = pk(v[6], v[7]); *(__attribute__((address_space(1))) u32x4*)p = w; }
DI void st8t(bf16* p, const float* v) {
#pragma unroll
    for (int e = 0; e < 8; ++e) *(__attribute__((address_space(1))) bf16*)(p + (size_t)e * TK) = f2b(v[e]); }
DI float sigmoid_(float x) { return 1.f / (1.f + __expf(-x)); }
DI float silu_(float x) { return x * sigmoid_(x); }
DI float logsigmoid_(float x) { return fminf(x, 0.f) - log1pf(expf(-fabsf(x))); }
DI int crow(int r, int hi) { return (r & 3) + 8 * (r >> 2) + 4 * hi; }
DI float wave_sum(float v) {
#pragma unroll
    for (int o = 1; o < 64; o <<= 1) v += __shfl_xor(v, o);
    return v; }
DI void getv(const f32x4& a, const f32x4& b, float* v) { v[0] = a[0]; v[1] = a[1]; v[2] = a[2]; v[3] = a[3]; v[4] = b[0]; v[5] = b[1]; v[6] = b[2]; v[7] = b[3]; }
DI bf16x8 ldfrag(const bf16* X, int ld, int r0, int k0, int lane) { return *(const bf16x8*)(X + (r0 + (lane & 31)) * ld + k0 + 8 * (lane >> 5)); }

DI int otid() { int t = threadIdx.x; asm volatile("" : "+v"(t)); return t; }
template <class T> DI T ldg(const T* p) { return *(const __attribute__((address_space(1))) T*)p; }
template <class T> DI void stg(T* p, const T& v) { *(__attribute__((address_space(1))) T*)p = v; }
DI void lbar() { asm volatile("s_waitcnt lgkmcnt(0)" ::: "memory"); __builtin_amdgcn_s_barrier(); asm volatile("" ::: "memory"); }
struct Args { const float* in[23]; float* out; unsigned char* ws; };

DI int srccol(int n) {
    const int tile = n >> 8, p = n & 255;
    if (tile < 6) return n;
    if (tile == 6) return 1552 + p;
    if (tile == 7) return 1808 + p;
    if (tile == 8) return 2064 + p;
    if (tile == 9 || tile == 10) {
        const int hh = (p >> 5) & 3, d = ((p >> 7) << 5) + (p & 31);
        if (tile == 9) return 2352 + hh * 64 + d;
        return hh < 2 ? 2608 + hh * 64 + d : 2736 + (hh - 2) * 64 + d;
    }
    if (tile < 15) return 2864 + (n - 11 * 256);
    if (p < 16) return 1536 + p;
    if (p < 48) return 2320 + (p - 16);
    return -1;
}

DI void transpose_item(const float* W, int Nsrc, bool perm, bf16* WT, int K, int item, int nblk, float* scr, int lane) {
    const int kb = item / nblk, nb = item - kb * nblk, k0 = 64 * kb, n0 = 32 * nb;
    const int n = n0 + (lane & 31); const int sc = perm ? srccol(n) : n;
#pragma unroll 8
    for (int i = 0; i < 32; ++i) { const int kk = 2 * i + (lane >> 5); scr[kk * 33 + (lane & 31)] = sc >= 0 ? W[(size_t)(k0 + kk) * Nsrc + sc] : 0.f; }
    asm volatile("s_waitcnt lgkmcnt(0)" ::: "memory");
    const int c = lane & 7;
#pragma unroll
    for (int j = 0; j < 4; ++j) { const int nn = (lane >> 3) + 8 * j; const float* s = scr + (8 * c) * 33 + nn;
        u32x4 o; o.x = pk(s[0 * 33], s[1 * 33]); o.y = pk(s[2 * 33], s[3 * 33]); o.z = pk(s[4 * 33], s[5 * 33]); o.w = pk(s[6 * 33], s[7 * 33]);
        *(u32x4*)(WT + (size_t)(n0 + nn) * K + k0 + 8 * c) = o; }
    asm volatile("s_waitcnt lgkmcnt(0)" ::: "memory");
}

DI void a_head(float* v, const float* gn, bool rope, const float* tab, int fq, float scale) {
    float ss = 0.f;
#pragma unroll
    for (int e = 0; e < 8; ++e) ss += v[e] * v[e];
    ss += __shfl_xor(ss, 16); ss += __shfl_xor(ss, 32);
    const float rinv = rsqrtf(ss * (1.f / 32.f) + EPS);
#pragma unroll
    for (int e = 0; e < 8; ++e) v[e] *= rinv * gn[e];
    if (rope) {
        const f32x4 ca = ldg((const f32x4*)tab), cb = ldg((const f32x4*)(tab + 4)), sa = ldg((const f32x4*)(tab + 8)), sb = ldg((const f32x4*)(tab + 12));
        float c[8], sn[8]; getv(ca, cb, c); getv(sa, sb, sn);
#pragma unroll
        for (int e = 0; e < 8; ++e) { const float p = __shfl_xor(v[e], 16); v[e] = (fq & 1) ? (p * sn[e] + v[e] * c[e]) : (v[e] * c[e] - p * sn[e]); }
    }
#pragma unroll
    for (int e = 0; e < 8; ++e) v[e] *= scale;
}
DI void d_head(float* v0, float* v1, const float* g0, const float* g1, bool rope, const float* tabr, const float* tabc, int fq, float scale) {
    float ss = 0.f;
#pragma unroll
    for (int e = 0; e < 8; ++e) ss += v0[e] * v0[e] + v1[e] * v1[e];
    ss += __shfl_xor(ss, 16); ss += __shfl_xor(ss, 32);
    const float rinv = rsqrtf(ss * (1.f / 64.f) + EPS);
#pragma unroll
    for (int e = 0; e < 8; ++e) { v0[e] *= rinv * g0[e]; v1[e] *= rinv * g1[e]; }
    if (rope) {
        const int fi = 8 * (fq & 1);
        { const f32x4 ca = ldg((const f32x4*)(tabr + fi)), cb = ldg((const f32x4*)(tabr + fi + 4)), sa = ldg((const f32x4*)(tabr + 16 + fi)), sb = ldg((const f32x4*)(tabr + 16 + fi + 4));
          float c[8], sn[8]; getv(ca, cb, c); getv(sa, sb, sn);
#pragma unroll
          for (int e = 0; e < 8; ++e) { const float p0 = __shfl_xor(v0[e], 32); v0[e] = (fq >= 2) ? (p0 * sn[e] + v0[e] * c[e]) : (v0[e] * c[e] - p0 * sn[e]); } }
        asm volatile("" ::: "memory");
        { const f32x4 ca = ldg((const f32x4*)(tabc + fi)), cb = ldg((const f32x4*)(tabc + fi + 4)), sa = ldg((const f32x4*)(tabc + 16 + fi)), sb = ldg((const f32x4*)(tabc + 16 + fi + 4));
          float c[8], sn[8]; getv(ca, cb, c); getv(sa, sb, sn);
#pragma unroll
          for (int e = 0; e < 8; ++e) { const float p1 = __shfl_xor(v1[e], 32); v1[e] = (fq >= 2) ? (p1 * sn[e] + v1[e] * c[e]) : (v1[e] * c[e] - p1 * sn[e]); } }
    }
#pragma unroll
    for (int e = 0; e < 8; ++e) { v0[e] *= scale; v1[e] *= scale; }
}

struct EpiIn {
    static constexpr bool PERM = true, AFTER_DRAIN = false;
#ifdef PAD_GIN
    static constexpr bool PADK = true;
#else
    static constexpr bool PADK = false;
#endif
    unsigned char* ws; int l;
    DI void operator()(const pg8::f32x4 (&acc)[2][2][4][2], const pg8::Unit& u, int wr, int wc, int fr_, int fq_) const {
        int fr = fr_, fq = fq_; asm volatile("" : "+v"(fr), "+v"(fq));
        const int b = u.pm >= 33 ? 1 : 0, pmi = u.pm - 33 * b; const bool is_ctx = (pmi == 0);
        const int j00 = pmi * 256 + wr * 64 + fr, pn = u.pn;
        const float* tabA = (const float*)(ws + WS_TABA); const float* tabD = (const float*)(ws + WS_TABD);
        const float* const* IN = (const float* const*)(ws + WS_ARGS);
#define ROWS_BEGIN _Pragma("unroll") for (int ai = 0; ai < 2; ++ai) _Pragma("unroll") for (int m = 0; m < 4; ++m) { \
        float v0[8], v1[8]; getv(acc[ai][0][m][0], acc[ai][0][m][1], v0); getv(acc[ai][1][m][0], acc[ai][1][m][1], v1); \
        const int j = j00 + ai * 128 + m * 16; const size_t mrow = (size_t)b * TK + j; const int t = is_ctx ? 0 : j - LC; (void)mrow; (void)t;
#define ROWS_END asm volatile("" ::: "memory"); }
        if (pn == 0 || pn == 1) {
            const float* gsrc = IN[pn == 0 ? 9 : 10] + l * 32 + 8 * fq;
            const float scale = pn == 0 ? 0.17677669529663687f * LOG2E : 1.f;
            bf16* dstb = (bf16*)(ws + (pn == 0 ? WS_QA : WS_KA));
            ROWS_BEGIN
                const float* tab = tabA + ((fq < 2) ? (t >> 6) : (t & 63)) * 16;
                float gn[8]; getv(ldg((const f32x4*)gsrc), ldg((const f32x4*)(gsrc + 4)), gn);
                a_head(v0, gn, !is_ctx, tab, fq, scale); a_head(v1, gn, !is_ctx, tab, fq, scale);
                { const int gi = wc, h = gi >> 1, c = gi & 1; st8g(dstb + (((b * 4 + h) * TK + j) * 64 + c * 32 + 8 * fq), v0); }
                { const int gi = 4 + wc, h = gi >> 1, c = gi & 1; st8g(dstb + (((b * 4 + h) * TK + j) * 64 + c * 32 + 8 * fq), v1); }
            ROWS_END
        } else if (pn == 2 || pn == 5 || pn == 8) {
            bf16* dstb = (bf16*)(ws + (pn == 2 ? WS_VAT : (pn == 5 ? WS_VBT : WS_VCT)));
            const int dv0 = (wc & 1) * 32 + 8 * fq;
            ROWS_BEGIN
                st8t(dstb + ((size_t)(b * 4 + (wc >> 1)) * 64 + dv0) * TK + j, v0);
                st8t(dstb + ((size_t)(b * 4 + 2 + (wc >> 1)) * 64 + dv0) * TK + j, v1);
            ROWS_END
        } else if (pn == 3 || pn == 4 || pn == 6) {
            bf16* dstb = (bf16*)(ws + (pn == 3 ? WS_QB : (pn == 4 ? WS_KB : WS_OB)));
            const int c0 = wc * 32 + 8 * fq;
            ROWS_BEGIN
                if (pn == 6) {
#pragma unroll
                    for (int e = 0; e < 8; ++e) { v0[e] = sigmoid_(v0[e]); v1[e] = sigmoid_(v1[e]); } }
                st8g(dstb + mrow * 256 + c0, v0); st8g(dstb + mrow * 256 + 128 + c0, v1);
            ROWS_END
        } else if (pn == 7) {
            bf16* dq = (bf16*)(ws + WS_QC); bf16* dk = (bf16*)(ws + WS_KC); const int c0 = wc * 32 + 8 * fq;
            ROWS_BEGIN
#pragma unroll
                for (int e = 0; e < 8; ++e) v0[e] *= 0.17677669529663687f;
                st8g(dq + mrow * 128 + c0, v0); st8g(dk + mrow * 128 + c0, v1);
            ROWS_END
        } else if (pn == 9) {
            bf16* dstb = (bf16*)(ws + WS_QD); const float* d_qn = IN[20] + l * 64;
            ROWS_BEGIN
                float g0[8], g1[8]; getv(ldg((const f32x4*)(d_qn + 8 * fq)), ldg((const f32x4*)(d_qn + 8 * fq + 4)), g0); getv(ldg((const f32x4*)(d_qn + 32 + 8 * fq)), ldg((const f32x4*)(d_qn + 36 + 8 * fq)), g1);
                d_head(v0, v1, g0, g1, !is_ctx, tabD + (t >> 6) * 32, tabD + (t & 63) * 32, fq, 0.125f * LOG2E);
                bf16* p = dstb + ((((b * 2 + (wc >> 1)) * 2 + (wc & 1)) * TK + j) * 64 + 8 * fq);
                st8g(p, v0); st8g(p + 32, v1);
            ROWS_END
        } else if (pn == 10) {
            if (wc < 2) {
                bf16* dstb = (bf16*)(ws + WS_KD); const float* d_kn = IN[21] + l * 64;
                ROWS_BEGIN
                    float g0[8], g1[8]; getv(ldg((const f32x4*)(d_kn + 8 * fq)), ldg((const f32x4*)(d_kn + 8 * fq + 4)), g0); getv(ldg((const f32x4*)(d_kn + 32 + 8 * fq)), ldg((const f32x4*)(d_kn + 36 + 8 * fq)), g1);
                    d_head(v0, v1, g0, g1, !is_ctx, tabD + (t >> 6) * 32, tabD + (t & 63) * 32, fq, 1.f);
                    bf16* p = dstb + (((b * 2 + wc) * TK + j) * 64 + 8 * fq);
                    st8g(p, v0); st8g(p + 32, v1);
                ROWS_END
            } else {
                bf16* dstb = (bf16*)(ws + WS_VDT);
                ROWS_BEGIN
                    bf16* p = dstb + ((size_t)(b * 2 + (wc - 2)) * 64 + 8 * fq) * TK + j;
                    st8t(p, v0); st8t(p + (size_t)32 * TK, v1);
                ROWS_END
            }
        } else if (pn < 15) {
            bf16* dstb = (bf16*)(ws + WS_GATE); const int c0 = (pn - 11) * 256 + wc * 32 + 8 * fq;
            ROWS_BEGIN
#pragma unroll
                for (int e = 0; e < 8; ++e) { v0[e] = silu_(v0[e]); v1[e] = silu_(v1[e]); }
                st8g(dstb + mrow * 1024 + c0, v0); st8g(dstb + mrow * 1024 + 128 + c0, v1);
            ROWS_END
        } else {
            float* dstb = (float*)(ws + WS_SMALL); const int p0 = wc * 32 + 8 * fq; const float* gate_b = IN[15] + l * 16;
            if (p0 < 48) {
                ROWS_BEGIN
                    if (p0 < 16) {
#pragma unroll
                        for (int e = 0; e < 8; ++e) { const int p = p0 + e, type = p >> 2; float x = v0[e] + ldg(gate_b + p); if (type & 1) x = logsigmoid_(x); v0[e] = x; } }
                    float* o = dstb + mrow * 48 + p0;
                    stg((f32x4*)o, (f32x4){v0[0], v0[1], v0[2], v0[3]}); stg((f32x4*)(o + 4), (f32x4){v0[4], v0[5], v0[6], v0[7]});
                ROWS_END
            }
        }
    }
};

struct EpiOut {
    static constexpr bool PERM = true, AFTER_DRAIN = false;
#ifdef PAD_GOUT
    static constexpr bool PADK = true;
#else
    static constexpr bool PADK = false;
#endif
    const float* xsrc; const float* csrc; float* xdst; float* cdst; const float* modv;
    DI void operator()(const pg8::f32x4 (&acc)[2][2][4][2], const pg8::Unit& u, int wr, int wc, int fr_, int fq_) const {
        int fr = fr_, fq = fq_; asm volatile("" : "+v"(fr), "+v"(fq));
        const int b = u.pm >= 33 ? 1 : 0, pmi = u.pm - 33 * b; const bool is_ctx = (pmi == 0);
        const int j00 = pmi * 256 + wr * 64 + fr, col0 = u.pn * 256 + wc * 32 + 8 * fq;
        const float* gt = modv + (is_ctx ? 2 : b) * 3072 + 2048 + col0;
        f32x4 g[2][2];
#pragma unroll
        for (int bj = 0; bj < 2; ++bj) { g[bj][0] = ldg((const f32x4*)(gt + bj * 128)); g[bj][1] = ldg((const f32x4*)(gt + bj * 128 + 4)); }
#pragma unroll
        for (int ai = 0; ai < 2; ++ai)
#pragma unroll
            for (int m = 0; m < 4; ++m) {
                const int j = j00 + ai * 128 + m * 16;
                const size_t off = (is_ctx ? (size_t)(b * LC + j) : (size_t)(b * T + j - LC)) * D + col0;
                const float* s = (is_ctx ? csrc : xsrc) + off; float* d = (is_ctx ? cdst : xdst) + off;
#pragma unroll
                for (int bj = 0; bj < 2; ++bj) {
                    const f32x4 r0 = ldg((const f32x4*)(s + bj * 128)), r1 = ldg((const f32x4*)(s + bj * 128 + 4));
                    stg((f32x4*)(d + bj * 128), (f32x4)(r0 + g[bj][0] * acc[ai][bj][m][0]));
                    stg((f32x4*)(d + bj * 128 + 4), (f32x4)(r1 + g[bj][1] * acc[ai][bj][m][1]));
                }
            }
    }
};
struct LatOrder {
    pg8::StaticOrder so;
    DI bool next(int i, pg8::Unit& u) const { if (!so.next(i, u)) return false; u.pm += 1 + (u.pm >= 32 ? 1 : 0); return true; }
    DI void a_ready(const pg8::Unit&) const {}
    DI void done(const pg8::Unit&) const {}
};

constexpr int KS_LD = 72, VS_LD = 68, KS_BYTES = 64 * KS_LD * 2, VS_BYTES = 64 * VS_LD * 2;
template <int MODE>
DI void attn_core(unsigned char* lds, const bf16* qrow, const bf16* Kb, const bf16* Vt, int n1, int js, int nt, int qpos, float negM,
                  f32x16 (&O)[MODE == 0 ? 2 : 1][2], float (&lsum)[MODE == 0 ? 2 : 1]) {
    constexpr int NC = MODE == 0 ? 2 : 1, KS = MODE == 0 ? 2 : 4;
    const int tid = otid(), lane = tid & 63, l32 = lane & 31, hi = lane >> 5;
    bf16* Ksm = (bf16*)lds; bf16* Vsm = (bf16*)(lds + 2 * KS_BYTES);
    bf16x8 qf[NC][KS];
#pragma unroll
    for (int c = 0; c < NC; ++c)
#pragma unroll
        for (int ks = 0; ks < KS; ++ks) qf[c][ks] = ldg((const bf16x8*)(qrow + c * (KS * 16) + 16 * ks + 8 * hi));
#pragma unroll
    for (int c = 0; c < NC; ++c) { lsum[c] = 0.f;
#pragma unroll
        for (int d = 0; d < 2; ++d)
#pragma unroll
            for (int i = 0; i < 16; ++i) O[c][d][i] = 0.f; }
    const int lr = tid >> 3, lc = (tid & 7) * 8;
    f32x16 L1;
#pragma unroll
    for (int i = 0; i < 16; ++i) L1[i] = 0.f;
    f32x16 L0;
#pragma unroll
    for (int i = 0; i < 16; ++i) L0[i] = 0.f;
    const bf16x8 ones = (bf16x8){0x3F80, 0x3F80, 0x3F80, 0x3F80, 0x3F80, 0x3F80, 0x3F80, 0x3F80};
    f32x16 CNEG;
#pragma unroll
    for (int i = 0; i < 16; ++i) CNEG[i] = negM;
    asm volatile("" : "+v"(CNEG));
    u32x4 kreg, vreg;
    { const int j0 = (0 < n1) ? 0 : js;
      kreg = ldg((const u32x4*)(Kb + (size_t)(j0 + lr) * 64 + lc)); vreg = ldg((const u32x4*)(Vt + (size_t)lr * TK + j0 + lc));
      *(u32x4*)(Ksm + lr * KS_LD + lc) = kreg; *(u32x2*)(Vsm + lr * VS_LD + lc) = (u32x2){vreg.x, vreg.y}; *(u32x2*)(Vsm + lr * VS_LD + lc + 4) = (u32x2){vreg.z, vreg.w}; }
    lbar();
#ifdef PAD_A
    asm volatile("s_nop 0");
#endif
    for (int it = 0; it < nt; ++it) {
        const int buf = it & 1; const int j0 = (it < n1) ? 64 * it : js + 64 * (it - n1);
        const bool more = (it + 1 < nt);
        if (more) { const int jn = (it + 1 < n1) ? 64 * (it + 1) : js + 64 * (it + 1 - n1);
            kreg = ldg((const u32x4*)(Kb + (size_t)(jn + lr) * 64 + lc)); vreg = ldg((const u32x4*)(Vt + (size_t)lr * TK + jn + lc)); }
        const bf16* Kc = Ksm + buf * (64 * KS_LD); const bf16* Vc = Vsm + buf * (64 * VS_LD);
        const bool masked = (MODE == 1) && (it >= n1);
#pragma unroll
        for (int kb = 0; kb < 2; ++kb) {
#ifdef PAD_KB
            if (kb == 1) asm volatile("s_nop 0");
#endif
            bf16x8 pf[NC][2];
#pragma unroll
            for (int c = 0; c < NC; ++c) {
                f32x16 S;
#pragma unroll
                for (int ks = 0; ks < KS; ++ks) { const bf16x8 a = *(const bf16x8*)(Kc + (32 * kb + l32) * KS_LD + c * (KS * 16) + 16 * ks + 8 * hi); S = MFMA32(a, qf[c][ks], ks == 0 ? CNEG : S); }
                float p[16];
#pragma unroll
                for (int i = 0; i < 16; ++i) p[i] = __builtin_amdgcn_exp2f(S[i]);
                if (MODE == 1) { if (masked) { const int kp0 = j0 - LC + 32 * kb + 4 * hi - qpos;
#pragma unroll
                    for (int i = 0; i < 16; ++i) { const int dlt = kp0 + (i & 3) + 8 * (i >> 2); p[i] = (dlt >= -128 && dlt <= 128) ? p[i] : 0.f; } } }
                if (c != 0) { float ps = 0.f;
#pragma unroll
                    for (int i = 8; i < 16; ++i) ps += p[i];
                    lsum[c] += ps; }
#pragma unroll
                for (int s = 0; s < 2; ++s) { u32x4 w; w.x = pk(p[8 * s], p[8 * s + 1]); w.y = pk(p[8 * s + 2], p[8 * s + 3]); w.z = pk(p[8 * s + 4], p[8 * s + 5]); w.w = pk(p[8 * s + 6], p[8 * s + 7]); pf[c][s] = __builtin_bit_cast(bf16x8, w); }
            }
#pragma unroll
            for (int dvb = 0; dvb < 2; ++dvb)
#pragma unroll
                for (int s = 0; s < 2; ++s) {
                    const bf16* vp = Vc + (32 * dvb + l32) * VS_LD + 32 * kb + 16 * s + 4 * hi;
                    const u32x2 lo = *(const u32x2*)vp, hh = *(const u32x2*)(vp + 8);
                    const bf16x8 va = __builtin_bit_cast(bf16x8, (u32x4){lo.x, lo.y, hh.x, hh.y});
#pragma unroll
                    for (int c = 0; c < NC; ++c) O[c][dvb] = MFMA32(va, pf[c][s], O[c][dvb]);
                    if (dvb == 0) L0 = MFMA32(ones, pf[0][s], L0);
                    if (dvb == 1 && s == 0 && NC == 2) L1 = MFMA32(ones, pf[NC - 1][0], L1);
                }
        }
        if (more) { bf16* Kn = Ksm + (buf ^ 1) * (64 * KS_LD); bf16* Vn = Vsm + (buf ^ 1) * (64 * VS_LD);
            *(u32x4*)(Kn + lr * KS_LD + lc) = kreg; *(u32x2*)(Vn + lr * VS_LD + lc) = (u32x2){vreg.x, vreg.y}; *(u32x2*)(Vn + lr * VS_LD + lc + 4) = (u32x2){vreg.z, vreg.w}; }
        lbar();
    }
#ifdef PAD_A
    asm volatile("s_nop 0");
#endif
    lsum[0] = 0.5f * L0[0];
    if (NC == 2) lsum[NC - 1] += 0.5f * L1[0];
}

DI void attnA_unit(unsigned char* lds, unsigned char* ws, int u, const float* subln, const float* misc) {
    const int tid = otid(), lane = tid & 63, wave = tid >> 6, l32 = lane & 31, hi = lane >> 5;
    int bh, jq0, nt;
    if (u < 256) { bh = u & 7; jq0 = LC + 256 * (u >> 3); nt = TK / 64; } else { bh = u - 256; jq0 = 0; nt = LC / 64; }
    const int b = bh >> 2, h = bh & 3, jq = jq0 + 32 * wave + l32;
    const bf16* qrow = (const bf16*)(ws + WS_QA) + ((size_t)bh * TK + jq) * 64;
    const bf16* Kb = (const bf16*)(ws + WS_KA) + (size_t)bh * TK * 64;
    const bf16* Vt = (const bf16*)(ws + WS_VAT) + (size_t)bh * 64 * TK;
    f32x16 O[2][2]; float lsum[2];
    attn_core<0>(lds, qrow, Kb, Vt, nt, 0, nt, 0, -misc[2], O, lsum);
    const float lam = misc[0], lam_init = misc[1];
    const float l0 = lsum[0] + __shfl_xor(lsum[0], 32), l1 = lsum[1] + __shfl_xor(lsum[1], 32);
    const float i0 = 1.f / l0, i1 = lam / l1;
    float ss = 0.f;
#pragma unroll
    for (int d = 0; d < 2; ++d)
#pragma unroll
        for (int i = 0; i < 16; ++i) { const float a = O[0][d][i] * i0 - O[1][d][i] * i1; O[0][d][i] = a; ss += a * a; }
    ss += __shfl_xor(ss, 32);
    const float rinv = rsqrtf(ss * (1.f / 64.f) + EPS) * (1.f - lam_init);
    const size_t mrow = (size_t)b * TK + jq;
    const bf16* gate = (const bf16*)(ws + WS_GATE) + mrow * 1024 + h * 64;
    bf16* y = (bf16*)(ws + WS_HXY) + mrow * 1024 + h * 64;
#pragma unroll
    for (int d = 0; d < 2; ++d)
#pragma unroll
        for (int g = 0; g < 4; ++g) {
            const int dv = 32 * d + 8 * g + 4 * hi;
            const u32x2 gg = ldg((const u32x2*)(gate + dv)); const f32x4 sb = ldg((const f32x4*)(subln + dv));
            u32x2 o; o.x = pk(O[0][d][4 * g] * rinv * sb[0] * bfe2(gg, 0), O[0][d][4 * g + 1] * rinv * sb[1] * bfe2(gg, 1));
            o.y = pk(O[0][d][4 * g + 2] * rinv * sb[2] * bfe2(gg, 2), O[0][d][4 * g + 3] * rinv * sb[3] * bfe2(gg, 3));
            stg((u32x2*)(y + dv), o);
        }
}

DI void attnD_unit(unsigned char* lds, unsigned char* ws, int u, const float* sink, const float* misc) {
    const int tid = otid(), lane = tid & 63, wave = tid >> 6, l32 = lane & 31, hi = lane >> 5;
    int b, kv, jq0, n1 = LC / 64, js = 0, nt = LC / 64, qpos = 0;
    if (u < 256) { const int x = u & 7; b = x >> 2; kv = (x >> 1) & 1; const int qblk = (x & 1) * 32 + (u >> 3), q0 = qblk * 128;
        jq0 = LC + q0; const int p0 = q0 - 128 < 0 ? 0 : q0 - 128, p1 = q0 + 256 > T ? T : q0 + 256; js = LC + p0; nt = n1 + (p1 - p0) / 64; qpos = q0 + 32 * (wave & 3) + l32; }
    else { const int x = u - 256; b = x >> 2; kv = (x >> 1) & 1; jq0 = 128 * (x & 1); }
    const int g = wave >> 2, jq = jq0 + 32 * (wave & 3) + l32;
    const bf16* qrow = (const bf16*)(ws + WS_QD) + ((size_t)((b * 2 + kv) * 2 + g) * TK + jq) * 64;
    const bf16* Kb = (const bf16*)(ws + WS_KD) + (size_t)(b * 2 + kv) * TK * 64;
    const bf16* Vt = (const bf16*)(ws + WS_VDT) + (size_t)(b * 2 + kv) * 64 * TK;
    f32x16 O[1][2]; float lsum[1];
    attn_core<1>(lds, qrow, Kb, Vt, n1, js, nt, qpos, -misc[3], O, lsum);
    const float l = lsum[0] + __shfl_xor(lsum[0], 32) + __builtin_amdgcn_exp2f(sink[kv * 2 + g] * LOG2E - misc[3]);
    const float inv = 1.f / l;
    const size_t mrow = (size_t)b * TK + jq; const int hc = 768 + (kv * 2 + g) * 64;
    const bf16* gate = (const bf16*)(ws + WS_GATE) + mrow * 1024 + hc;
    bf16* y = (bf16*)(ws + WS_HXY) + mrow * 1024 + hc;
#pragma unroll
    for (int d = 0; d < 2; ++d)
#pragma unroll
        for (int gq = 0; gq < 4; ++gq) {
            const int dv = 32 * d + 8 * gq + 4 * hi;
            const u32x2 gg = ldg((const u32x2*)(gate + dv));
            u32x2 o; o.x = pk(O[0][d][4 * gq] * inv * bfe2(gg, 0), O[0][d][4 * gq + 1] * inv * bfe2(gg, 1));
            o.y = pk(O[0][d][4 * gq + 2] * inv * bfe2(gg, 2), O[0][d][4 * gq + 3] * inv * bfe2(gg, 3));
            stg((u32x2*)(y + dv), o);
        }
}

DI int ord_cidx(int dir, int step) { return dir == 0 ? step : (step < 4 ? 3 - step : 135 - step); }
constexpr int LD64 = 72, LD32 = 40, HLD = 68;
constexpr int WC_OFF = 110592, WC_CW = 0, WC_CB = 1536, WC_BON = 2048, WC_CON = 2112, WC_WG = 2176, WC_BG = 6272, WC_N = 6528;
DI void fill_wcache(unsigned char* lds, const float* const* IN, int l) {
    float* WC = (float*)(lds + WC_OFF); const int tid = otid();
    const float* cw = IN[13] + l * 1536; const float* cb = IN[14] + l * 512; const float* bo = IN[16] + l * 64; const float* co = IN[19] + l * 64; const float* wg = IN[17] + l * 4096; const float* bg = IN[18] + l * 256;
    const f32x4 w0 = ldg((const f32x4*)wg + tid), w1 = ldg((const f32x4*)wg + 512 + tid);
    f32x4 c0 = (f32x4){0.f, 0.f, 0.f, 0.f}, c1 = c0;
    if (tid < 384) c0 = ldg((const f32x4*)cw + tid);
    const float* src = cb; int dsto = 0;
    if (tid < 128) { src = cb + 4 * tid; dsto = WC_CB + 4 * tid; }
    else if (tid < 144) { src = bo + 4 * (tid - 128); dsto = WC_BON + 4 * (tid - 128); }
    else if (tid < 160) { src = co + 4 * (tid - 144); dsto = WC_CON + 4 * (tid - 144); }
    else if (tid < 224) { src = bg + 4 * (tid - 160); dsto = WC_BG + 4 * (tid - 160); }
    if (tid < 224) c1 = ldg((const f32x4*)src);
    *(f32x4*)(WC + WC_WG + 4 * tid) = w0; *(f32x4*)(WC + WC_WG + 2048 + 4 * tid) = w1;
    if (tid < 384) *(f32x4*)(WC + WC_CW + 4 * tid) = c0;
    if (tid < 224) *(f32x4*)(WC + dsto) = c1;
    lbar();
}

struct ScanPtrs { float *CST, *NST, *SB, *SG, *SM, *SST, *GD; };
DI ScanPtrs scan_ptrs(unsigned char* ws) { ScanPtrs p; p.CST = (float*)(ws + WS_CST); p.NST = (float*)(ws + WS_NST); p.SB = (float*)(ws + WS_SSC); p.SG = p.SB + 16 * NCH; p.SM = p.SG + 16 * NCH;
    p.SST = (float*)(ws + WS_SST); p.GD = (float*)(ws + WS_GD); return p; }


DI float wscan_add(float v, int lane, bool rev) {
#pragma unroll
    for (int off = 1; off < 64; off <<= 1) { const float t = rev ? __shfl_down(v, off) : __shfl_up(v, off); const bool ok = rev ? (lane + off < 64) : (lane >= off); v += ok ? t : 0.f; }
    return v; }
DI float wscan_max(float v, int lane, bool rev) {
#pragma unroll
    for (int off = 1; off < 64; off <<= 1) { const float t = rev ? __shfl_down(v, off) : __shfl_up(v, off); const bool ok = rev ? (lane + off < 64) : (lane >= off); v = ok ? fmaxf(v, t) : v; }
    return v; }
DI float wave_max(float v) {
#pragma unroll
    for (int o = 1; o < 64; o <<= 1) v = fmaxf(v, __shfl_xor(v, o));
    return v; }

DI void conv8r(const u32x4& pv, const u32x4& c, const u32x4& nv, const float* w  , const float* cb, float mul, float* o) {
    float w0[8], w1[8], w2[8], bb[8];
    getv(*(const f32x4*)w, *(const f32x4*)(w + 4), w0); getv(*(const f32x4*)(w + 512), *(const f32x4*)(w + 516), w1);
    getv(*(const f32x4*)(w + 1024), *(const f32x4*)(w + 1028), w2); getv(*(const f32x4*)cb, *(const f32x4*)(cb + 4), bb);
#pragma unroll
    for (int e = 0; e < 8; ++e) { const float y = w0[e] * bfe(pv, e) + w1[e] * bfe(c, e) + w2[e] * bfe(nv, e) + bb[e]; o[e] = silu_(y) * mul; }
}
DI void load3(const bf16* p, bool hasp, bool hasn, u32x4& pv, u32x4& c, u32x4& nv) {
    c = ldg((const u32x4*)p); pv = (u32x4){0u, 0u, 0u, 0u}; nv = pv;
    if (hasp) pv = ldg((const u32x4*)(p - 256));
    if (hasn) nv = ldg((const u32x4*)(p + 256));
}

struct MaPre { float lf, li; u32x4 kp, kc, kn, vraw; };
DI MaPre mlstm_a_load(unsigned char* ws, int tsk) {
    const int bh = tsk / NCH, cidx = tsk - bh * NCH, b = bh >> 2, h = bh & 3, tid = otid();
    const size_t m0 = (size_t)b * TK + cidx * 64; MaPre p; p.lf = 0.f; p.li = 0.f;
    if (tid < 128) { const int dir = tid >> 6, s = tid & 63; const float* sm = (const float*)(ws + WS_SMALL) + (m0 + s) * 48; p.lf = ldg(sm + (2 * dir + 1) * 4 + h); p.li = ldg(sm + (2 * dir) * 4 + h); }
    const int s = tid >> 3, d0 = (tid & 7) * 8;
    const bool hasp = (s > 0) || (cidx != 0 && cidx != 4), hasn = (s < 63) || (cidx != 3 && cidx != NCH - 1);
    load3((const bf16*)(ws + WS_KB) + (m0 + s) * 256 + h * 64 + d0, hasp, hasn, p.kp, p.kc, p.kn);
    p.vraw = ldg((const u32x4*)((const bf16*)(ws + WS_VBT) + ((size_t)bh * 64 + s) * TK + cidx * 64 + d0));
    return p;
}
DI void mlstm_a_run(unsigned char* lds, unsigned char* ws, int tsk, const MaPre& p, const float* conv_w, const float* conv_b) {
    const int bh = tsk / NCH, cidx = tsk - bh * NCH, h = bh & 3;
    const int tid = otid(), lane = tid & 63, wave = tid >> 6; const ScanPtrs sp = scan_ptrs(ws);
    bf16* KT = (bf16*)lds; bf16* VW = (bf16*)(lds + 9216); float* WE = (float*)(lds + 27648);
    if (wave < 2) { const int dir = wave; const float tot = wave_sum(p.lf), pre = wscan_add(p.lf, lane, false);
        const float g = (dir == 0 ? tot - pre : pre - p.lf) + p.li; const float G = wave_max(g);
        WE[dir * 64 + lane] = expf(g - G);
        if (lane == 0) { stg(sp.SB + (bh * 2 + dir) * NCH + cidx, tot); stg(sp.SG + (bh * 2 + dir) * NCH + cidx, G); } }
    { const int s = tid >> 3, d0 = (tid & 7) * 8; float kv[8];
      conv8r(p.kp, p.kc, p.kn, conv_w + 256 + h * 64 + d0, conv_b + 256 + h * 64 + d0, 0.125f, kv);
#pragma unroll
      for (int e = 0; e < 8; ++e) KT[(d0 + e) * LD64 + s] = f2b(kv[e]); }
    lbar();
    { const int v = tid >> 3, s0 = (tid & 7) * 8;
#pragma unroll
      for (int dir = 0; dir < 2; ++dir) { float o[8];
#pragma unroll
          for (int e = 0; e < 8; ++e) o[e] = bfe(p.vraw, e) * WE[dir * 64 + s0 + e];
          st8(VW + dir * (64 * LD64) + v * LD64 + s0, o); } }
    { const int o = tid >> 2, part = tid & 3, dir = o >> 6, d = o & 63; float a = 0.f;
#pragma unroll
      for (int q = 0; q < 16; ++q) { const int s = part * 16 + q; a += WE[dir * 64 + s] * b2f(KT[d * LD64 + s]); }
      a += __shfl_xor(a, 1); a += __shfl_xor(a, 2);
      if (part == 0) stg(sp.NST + ((size_t)(bh * 2 + dir) * NCH + cidx) * 64 + d, a); }
    lbar();
    { const int dir = wave >> 2, tr = (wave >> 1) & 1, tc = wave & 1, l32 = lane & 31, hi = lane >> 5;
      f32x16 acc;
#pragma unroll
      for (int i = 0; i < 16; ++i) acc[i] = 0.f;
#pragma unroll
      for (int ks = 0; ks < 4; ++ks) acc = MFMA32(ldfrag(VW + dir * (64 * LD64), LD64, 32 * tr, 16 * ks, lane), ldfrag(KT, LD64, 32 * tc, 16 * ks, lane), acc);
      float* dst = sp.CST + ((size_t)(bh * 2 + dir) * NCH + cidx) * 4096;
#pragma unroll
      for (int i = 0; i < 16; ++i) stg(dst + (32 * tr + crow(i, hi)) * 64 + 32 * tc + l32, acc[i]); }
    lbar();
}

struct GlPre { f32x4 lr[4]; u32x4 kraw, qraw, vraw; };
DI GlPre gla_load(unsigned char* ws, int tsk, bool need_q) {
    const int bh = tsk / NCH, cidx = tsk - bh * NCH, b = bh >> 2, h = bh & 3, tid = otid(), lane = tid & 63, wave = tid >> 6, z = wave >> 2, dg = wave & 3;
    const size_t m0 = (size_t)b * TK + cidx * 64; GlPre p;
    const float* sm = (const float*)(ws + WS_SMALL) + (m0 + lane) * 48 + 16 + z * 16;
#pragma unroll
    for (int q = 0; q < 4; ++q) p.lr[q] = ldg((const f32x4*)(sm + 4 * q));
    p.kraw = ldg((const u32x4*)((const bf16*)(ws + WS_KC) + (m0 + lane) * 128 + h * 32 + dg * 8));
    p.qraw = (u32x4){0u, 0u, 0u, 0u}; if (need_q) p.qraw = ldg((const u32x4*)((const bf16*)(ws + WS_QC) + (m0 + lane) * 128 + h * 32 + dg * 8));
    p.vraw = ldg((const u32x4*)((const bf16*)(ws + WS_VCT) + ((size_t)bh * 64 + (tid >> 3)) * TK + cidx * 64 + (tid & 7) * 8));
    return p;
}
DI void gla_bc(const GlPre& p, int h, int z, int dg, int lane, const float* wg, const float* bg, float* bc) {
    const float* wgp = wg + (z * 16) * 128 + h * 32 + dg * 8;
#pragma unroll
    for (int e = 0; e < 8; ++e) bc[e] = bg[z * 128 + h * 32 + dg * 8 + e];
#pragma unroll
    for (int r = 0; r < 16; ++r) { const float lr = p.lr[r >> 2][r & 3];
#pragma unroll
        for (int e = 0; e < 8; ++e) bc[e] += lr * wgp[r * 128 + e]; }
#pragma unroll
    for (int e = 0; e < 8; ++e) bc[e] = wscan_add((fminf(bc[e], 0.f) - __logf(1.f + __expf(-fabsf(bc[e])))) * (1.f / 16.f), lane, z == 1);
}
DI void gla_a_run(unsigned char* lds, unsigned char* ws, int tsk, const GlPre& p, const float* wg, const float* bg) {
    const int bh = tsk / NCH, cidx = tsk - bh * NCH, h = bh & 3;
    const int tid = otid(), lane = tid & 63, wave = __builtin_amdgcn_readfirstlane(tid >> 6), z = wave >> 2, dg = wave & 3; const ScanPtrs sp = scan_ptrs(ws);
    bf16* KH = (bf16*)lds; bf16* VT = (bf16*)(lds + 9216);
    float bc[8]; gla_bc(p, h, z, dg, lane, wg, bg, bc);
#pragma unroll
    for (int e = 0; e < 8; ++e) { const float bend = __shfl(bc[e], z == 0 ? 63 : 0);
        KH[z * (32 * LD64) + (dg * 8 + e) * LD64 + lane] = f2b(bfe(p.kraw, e) * expf(bend - bc[e]));
        if (lane == 0) stg(sp.GD + ((size_t)(bh * 2 + z) * NCH + cidx) * 32 + dg * 8 + e, expf(bend)); }
    *(u32x4*)(VT + (tid >> 3) * LD64 + (tid & 7) * 8) = p.vraw;
    lbar();
    if (wave < 4) { const int zz = wave >> 1, vc = wave & 1, l32 = lane & 31, hi = lane >> 5;
      f32x16 acc;
#pragma unroll
      for (int i = 0; i < 16; ++i) acc[i] = 0.f;
#pragma unroll
      for (int ks = 0; ks < 4; ++ks) acc = MFMA32(ldfrag(KH + zz * (32 * LD64), LD64, 0, 16 * ks, lane), ldfrag(VT, LD64, 32 * vc, 16 * ks, lane), acc);
      float* dst = sp.SST + ((size_t)(bh * 2 + zz) * NCH + cidx) * 2048;
#pragma unroll
      for (int i = 0; i < 16; ++i) stg(dst + crow(i, hi) * 64 + 32 * vc + l32, acc[i]); }
    lbar();
}
DI void scan_b(unsigned char* lds, unsigned char* ws, int t) {
    const int tid = otid(); const ScanPtrs sp = scan_ptrs(ws);
    float* DEC = (float*)lds; float* SCL = DEC + 256; float* XA = SCL + 256; float* XB = XA + 256; float* GS = XB + 256; float* BS = GS + 256; float* GDs = (float*)lds;
    if (t < 144) {
        const int scan = t < 128 ? (t >> 3) : (t - 128), dir = scan & 1;
        float bv = 0.f, gv = 0.f;
        if (tid < 132) { const int cidx = ord_cidx(dir, tid); bv = ldg(sp.SB + scan * NCH + cidx); gv = ldg(sp.SG + scan * NCH + cidx); }
        if (tid < 256) { XA[tid] = bv; BS[tid] = bv; GS[tid] = gv; }
        lbar();
        for (int off = 1; off < 256; off <<= 1) { float v = 0.f; if (tid < 256 && tid >= off) v = XA[tid - off]; lbar(); if (tid < 256) XA[tid] += v; lbar(); }
        if (tid < 256) XB[tid] = tid < 132 ? GS[tid] - XA[tid] : -INFINITY;
        lbar();
        for (int off = 1; off < 256; off <<= 1) { float v = -INFINITY; if (tid < 256 && tid >= off) v = XB[tid - off]; lbar(); if (tid < 256) XB[tid] = fmaxf(XB[tid], v); lbar(); }
        if (tid < 132) {
            const float m0 = tid == 0 ? 0.f : XA[tid - 1] + fmaxf(0.f, XB[tid - 1]);
            const float m1 = XA[tid] + fmaxf(0.f, XB[tid]);
            DEC[tid] = expf(BS[tid] + m0 - m1); SCL[tid] = expf(GS[tid] - m1);
            if (t >= 128) stg(sp.SM + scan * NCH + ord_cidx(dir, tid), m0);
        }
        lbar();
        if (t < 128 || tid < 64) {
            const int stride = t < 128 ? 4096 : 64;
            float* buf = (t < 128 ? sp.CST + (size_t)scan * NCH * 4096 + (t & 7) * 512 : sp.NST + (size_t)scan * NCH * 64) + tid;
            float run = 0.f;
            for (int s0 = 0; s0 < 132; s0 += 33) { float dl[33];
#pragma unroll
                for (int u = 0; u < 33; ++u) dl[u] = ldg(buf + (size_t)ord_cidx(dir, s0 + u) * stride);
#pragma unroll
                for (int u = 0; u < 33; ++u) { stg(buf + (size_t)ord_cidx(dir, s0 + u) * stride, run); run = DEC[s0 + u] * run + SCL[s0 + u] * dl[u]; } }
        }
        lbar();
    } else {
        const int scan = (t - 144) >> 2, dir = scan & 1, elem = ((t - 144) & 3) * 512 + tid, d = elem >> 6;
        for (int idx = tid; idx < 132 * 32; idx += 512) GDs[idx] = ldg(sp.GD + ((size_t)scan * NCH + ord_cidx(dir, idx >> 5)) * 32 + (idx & 31));
        lbar();
        float* buf = sp.SST + (size_t)scan * NCH * 2048 + elem; float run = 0.f;
        for (int s0 = 0; s0 < 132; s0 += 33) { float dl[33];
#pragma unroll
            for (int u = 0; u < 33; ++u) dl[u] = ldg(buf + (size_t)ord_cidx(dir, s0 + u) * 2048);
#pragma unroll
            for (int u = 0; u < 33; ++u) { stg(buf + (size_t)ord_cidx(dir, s0 + u) * 2048, run); run = GDs[(s0 + u) * 32 + d] * run + dl[u]; } }
        lbar();
    }
}

DI void chunk_finish(const float* H, unsigned char* ws, size_t m0, int colbase, int h, const float* outn, bool use_o, const u32x4& gg, const u32x4& og) {
    const int tid = otid(), t = tid >> 3, v8 = (tid & 7) * 8;
    float hs[8]; float ss = 0.f;
#pragma unroll
    for (int e = 0; e < 8; ++e) { hs[e] = H[t * HLD + v8 + e] + H[64 * HLD + t * HLD + v8 + e]; ss += hs[e] * hs[e]; }
    ss += __shfl_xor(ss, 1); ss += __shfl_xor(ss, 2); ss += __shfl_xor(ss, 4);
    const float rinv = rsqrtf(ss * (1.f / 64.f) + EPS);
    const size_t mrow = m0 + t;
    float o[8];
#pragma unroll
    for (int e = 0; e < 8; ++e) { float x = hs[e] * rinv * outn[v8 + e] * bfe(gg, e); if (use_o) x *= bfe(og, e); o[e] = x; }
    st8g((bf16*)(ws + WS_HXY) + mrow * 1024 + colbase + h * 64 + v8, o);
}

struct McPre { float lf, li, nl, mp; u32x4 qp, qc, qn, kp, kc, kn, vraw, gg, og; f32x4 c[2][2]; };
DI McPre mlstm_c_load(unsigned char* ws, int tsk) {
    const int bh = tsk / NCH, cidx = tsk - bh * NCH, b = bh >> 2, h = bh & 3, tid = otid();
    const size_t m0 = (size_t)b * TK + cidx * 64; const ScanPtrs sp = scan_ptrs(ws); McPre p; p.lf = 0.f; p.li = 0.f; p.nl = 0.f; p.mp = 0.f;
    if (tid < 128) { const int dir = tid >> 6, s = tid & 63; const float* sm = (const float*)(ws + WS_SMALL) + (m0 + s) * 48; p.lf = ldg(sm + (2 * dir + 1) * 4 + h); p.li = ldg(sm + (2 * dir) * 4 + h);
        p.nl = ldg(sp.NST + ((size_t)(bh * 2 + dir) * NCH + cidx) * 64 + s); p.mp = ldg(sp.SM + (bh * 2 + dir) * NCH + cidx); }
    const int s = tid >> 3, d0 = (tid & 7) * 8;
    const bool hasp = (s > 0) || (cidx != 0 && cidx != 4), hasn = (s < 63) || (cidx != 3 && cidx != NCH - 1);
    load3((const bf16*)(ws + WS_QB) + (m0 + s) * 256 + h * 64 + d0, hasp, hasn, p.qp, p.qc, p.qn);
    load3((const bf16*)(ws + WS_KB) + (m0 + s) * 256 + h * 64 + d0, hasp, hasn, p.kp, p.kc, p.kn);
    p.vraw = ldg((const u32x4*)((const bf16*)(ws + WS_VBT) + ((size_t)bh * 64 + s) * TK + cidx * 64 + d0));
#pragma unroll
    for (int dir = 0; dir < 2; ++dir) { const float* src = sp.CST + ((size_t)(bh * 2 + dir) * NCH + cidx) * 4096 + s * 64 + d0; p.c[dir][0] = ldg((const f32x4*)src); p.c[dir][1] = ldg((const f32x4*)(src + 4)); }
    p.gg = ldg((const u32x4*)((const bf16*)(ws + WS_GATE) + (m0 + s) * 1024 + 256 + h * 64 + d0));
    p.og = ldg((const u32x4*)((const bf16*)(ws + WS_OB) + (m0 + s) * 256 + h * 64 + d0));
    return p;
}
DI void mlstm_c_run(unsigned char* lds, unsigned char* ws, int tsk, const McPre& p, const float* conv_w, const float* conv_b, const float* outn) {
    const int bh = tsk / NCH, cidx = tsk - bh * NCH, b = bh >> 2, h = bh & 3;
    const int tid = otid(), lane = tid & 63, wave = tid >> 6, l32 = lane & 31, hi = lane >> 5;
    const size_t m0 = (size_t)b * TK + cidx * 64;
    bf16* QS = (bf16*)lds; bf16* KSm = (bf16*)(lds + 9216); bf16* VT = (bf16*)(lds + 18432); bf16* CB = (bf16*)(lds + 27648); bf16* PL = (bf16*)(lds + 46080);
    float* H = (float*)(lds + 64512); float* AA = (float*)(lds + 99328); float* MU = AA + 128; float* GI = MU + 128; float* EN = GI + 128;
    float* NQ = EN + 128; float* RS = NQ + 128; float* NL = RS + 256;
    if (wave < 2) { const int dir = wave; const bool rev = dir == 1;
        const float bcum = wscan_add(p.lf, lane, rev), a = p.li - bcum, cm = wscan_max(a, lane, rev), mu = fmaxf(p.mp, cm);
        AA[dir * 64 + lane] = a; MU[dir * 64 + lane] = mu; GI[dir * 64 + lane] = expf(p.mp - mu); EN[dir * 64 + lane] = expf(-bcum - mu); NL[dir * 64 + lane] = p.nl; }
    { const int s = tid >> 3, d0 = (tid & 7) * 8; float qv[8], kv[8];
      conv8r(p.qp, p.qc, p.qn, conv_w + h * 64 + d0, conv_b + h * 64 + d0, 1.f, qv);
      conv8r(p.kp, p.kc, p.kn, conv_w + 256 + h * 64 + d0, conv_b + 256 + h * 64 + d0, 0.125f, kv);
      st8(QS + s * LD64 + d0, qv); st8(KSm + s * LD64 + d0, kv);
      *(u32x4*)(VT + s * LD64 + d0) = p.vraw;
#pragma unroll
      for (int dir = 0; dir < 2; ++dir) { float cv[8]; getv(p.c[dir][0], p.c[dir][1], cv); st8(CB + dir * (64 * LD64) + s * LD64 + d0, cv); } }
    lbar();
    { const int o = tid >> 2, part = tid & 3, dir = o >> 6, t = o & 63; float a = 0.f;
#pragma unroll
      for (int q = 0; q < 16; ++q) { const int d = part * 16 + q; a += NL[dir * 64 + d] * b2f(QS[t * LD64 + d]); }
      a += __shfl_xor(a, 1); a += __shfl_xor(a, 2);
      if (part == 0) NQ[dir * 64 + t] = a; }
    { const int dir = wave >> 2, tr = (wave >> 1) & 1, tc = wave & 1;
      f32x16 S;
#pragma unroll
      for (int i = 0; i < 16; ++i) S[i] = 0.f;
#pragma unroll
      for (int ks = 0; ks < 4; ++ks) S = MFMA32(ldfrag(KSm, LD64, 32 * tr, 16 * ks, lane), ldfrag(QS, LD64, 32 * tc, 16 * ks, lane), S);
      const int t = 32 * tc + l32; const float mu = MU[dir * 64 + t]; float rs = 0.f;
#pragma unroll
      for (int g = 0; g < 4; ++g) { float pw[4];
#pragma unroll
          for (int e = 0; e < 4; ++e) { const int s = 32 * tr + 8 * g + 4 * hi + e; const bool ok = dir == 0 ? (s <= t) : (s >= t);
              pw[e] = ok ? S[4 * g + e] * __expf(AA[dir * 64 + s] - mu) : 0.f; rs += pw[e]; }
          *(u32x2*)(PL + dir * (64 * LD64) + t * LD64 + 32 * tr + 8 * g + 4 * hi) = (u32x2){pk(pw[0], pw[1]), pk(pw[2], pw[3])}; }
      rs += __shfl_xor(rs, 32);
      if (hi == 0) RS[(dir * 2 + tr) * 64 + t] = rs; }
    lbar();
    { const int dir = wave >> 2, vr = (wave >> 1) & 1, tc = wave & 1;
      f32x16 aP, aC;
#pragma unroll
      for (int i = 0; i < 16; ++i) { aP[i] = 0.f; aC[i] = 0.f; }
#pragma unroll
      for (int ks = 0; ks < 4; ++ks) { aP = MFMA32(ldfrag(VT, LD64, 32 * vr, 16 * ks, lane), ldfrag(PL + dir * (64 * LD64), LD64, 32 * tc, 16 * ks, lane), aP);
          aC = MFMA32(ldfrag(CB + dir * (64 * LD64), LD64, 32 * vr, 16 * ks, lane), ldfrag(QS, LD64, 32 * tc, 16 * ks, lane), aC); }
      const int t = 32 * tc + l32; const float gi = GI[dir * 64 + t];
      const float nq = RS[(dir * 2) * 64 + t] + RS[(dir * 2 + 1) * 64 + t] + gi * NQ[dir * 64 + t];
      const float inv = 1.f / fmaxf(fabsf(nq), EN[dir * 64 + t]);
#pragma unroll
      for (int i = 0; i < 16; ++i) H[dir * (64 * HLD) + t * HLD + 32 * vr + crow(i, hi)] = (aP[i] + gi * aC[i]) * inv; }
    lbar();
    chunk_finish(H, ws, m0, 256, h, outn, true, p.gg, p.og);
    lbar();
}

struct GcPre { GlPre g; u32x4 gg; float st[2][4]; };
DI GcPre gla_c_load(unsigned char* ws, int tsk) {
    const int bh = tsk / NCH, cidx = tsk - bh * NCH, b = bh >> 2, h = bh & 3, tid = otid(); const ScanPtrs sp = scan_ptrs(ws);
    const size_t m0 = (size_t)b * TK + cidx * 64; GcPre p; p.g = gla_load(ws, tsk, true);
    p.gg = ldg((const u32x4*)((const bf16*)(ws + WS_GATE) + (m0 + (tid >> 3)) * 1024 + 512 + h * 64 + (tid & 7) * 8));
#pragma unroll
    for (int z = 0; z < 2; ++z) { const float* src = sp.SST + ((size_t)(bh * 2 + z) * NCH + cidx) * 2048;
#pragma unroll
        for (int it = 0; it < 4; ++it) p.st[z][it] = ldg(src + tid + 512 * it); }
    return p;
}
DI void gla_c_run(unsigned char* lds, unsigned char* ws, int tsk, const GcPre& p, const float* wg, const float* bg, const float* outn) {
    const int bh = tsk / NCH, cidx = tsk - bh * NCH, b = bh >> 2, h = bh & 3;
    const int tid = otid(), lane = tid & 63, wave = tid >> 6, l32 = lane & 31, hi = lane >> 5;
    const size_t m0 = (size_t)b * TK + cidx * 64;
    bf16* QT = (bf16*)lds; bf16* KT2 = (bf16*)(lds + 10240); bf16* QH = (bf16*)(lds + 20480); bf16* VT = (bf16*)(lds + 30720);
    bf16* ST = (bf16*)(lds + 39936); bf16* PL = (bf16*)(lds + 50176); float* H = (float*)(lds + 68608);
    { const int wu = __builtin_amdgcn_readfirstlane(wave), z = wu >> 2, dg = wu & 3; float bc[8]; gla_bc(p.g, h, z, dg, lane, wg, bg, bc);
      float q1[8], k1[8], q2[8];
#pragma unroll
      for (int e = 0; e < 8; ++e) { const float rf = __shfl(bc[e], 32); const float qv = bfe(p.g.qraw, e);
          q1[e] = qv * __expf(bc[e] - rf); k1[e] = bfe(p.g.kraw, e) * __expf(rf - bc[e]); q2[e] = qv * __expf(bc[e]); }
      st8(QT + z * (64 * LD32) + lane * LD32 + dg * 8, q1); st8(KT2 + z * (64 * LD32) + lane * LD32 + dg * 8, k1); st8(QH + z * (64 * LD32) + lane * LD32 + dg * 8, q2); }
    *(u32x4*)(VT + (tid >> 3) * LD64 + (tid & 7) * 8) = p.g.vraw;
#pragma unroll
    for (int z = 0; z < 2; ++z)
#pragma unroll
        for (int it = 0; it < 4; ++it) { const int idx = tid + 512 * it, d = idx >> 6, v = idx & 63; ST[z * (64 * LD32) + v * LD32 + d] = f2b(p.st[z][it]); }
    lbar();
    { const int z = wave >> 2, tr = (wave >> 1) & 1, tc = wave & 1;
      f32x16 S;
#pragma unroll
      for (int i = 0; i < 16; ++i) S[i] = 0.f;
#pragma unroll
      for (int ks = 0; ks < 2; ++ks) S = MFMA32(ldfrag(KT2 + z * (64 * LD32), LD32, 32 * tr, 16 * ks, lane), ldfrag(QT + z * (64 * LD32), LD32, 32 * tc, 16 * ks, lane), S);
      const int t = 32 * tc + l32;
#pragma unroll
      for (int g = 0; g < 4; ++g) { float pw[4];
#pragma unroll
          for (int e = 0; e < 4; ++e) { const int s = 32 * tr + 8 * g + 4 * hi + e; const bool ok = z == 0 ? (s <= t) : (s >= t); pw[e] = ok ? S[4 * g + e] : 0.f; }
          *(u32x2*)(PL + z * (64 * LD64) + t * LD64 + 32 * tr + 8 * g + 4 * hi) = (u32x2){pk(pw[0], pw[1]), pk(pw[2], pw[3])}; } }
    lbar();
    { const int z = wave >> 2, vr = (wave >> 1) & 1, tc = wave & 1;
      f32x16 a;
#pragma unroll
      for (int i = 0; i < 16; ++i) a[i] = 0.f;
#pragma unroll
      for (int ks = 0; ks < 4; ++ks) a = MFMA32(ldfrag(VT, LD64, 32 * vr, 16 * ks, lane), ldfrag(PL + z * (64 * LD64), LD64, 32 * tc, 16 * ks, lane), a);
#pragma unroll
      for (int ks = 0; ks < 2; ++ks) a = MFMA32(ldfrag(ST + z * (64 * LD32), LD32, 32 * vr, 16 * ks, lane), ldfrag(QH + z * (64 * LD32), LD32, 32 * tc, 16 * ks, lane), a);
      const int t = 32 * tc + l32;
#pragma unroll
      for (int i = 0; i < 16; ++i) H[z * (64 * HLD) + t * HLD + 32 * vr + crow(i, hi)] = a[i]; }
    lbar();
    chunk_finish(H, ws, m0, 512, h, outn, false, p.gg, p.gg);
    lbar();
}


constexpr int W48_LD = 1032, W48_BYTES = 48 * W48_LD * 2;
DI void mini_proj(unsigned char* lds, unsigned char* ws, int first_tile, int tile_step, int ntiles, const bf16* Wt48, const float* gate_b) {
    const int tid = otid(), lane = tid & 63, wave = tid >> 6, l32 = lane & 31, hi = lane >> 5;
    bf16* WL = (bf16*)lds; bf16* AS = (bf16*)(lds + W48_BYTES);
    if (first_tile >= ntiles) return;
    for (int i = tid; i < 48 * 128; i += 512) { const int n = i >> 7, c = (i & 127) * 8; *(u32x4*)(WL + n * W48_LD + c) = ldg((const u32x4*)(Wt48 + (size_t)n * 1024 + c)); }
    const int brow1 = (32 + l32) < 48 ? 32 + l32 : 47;
    for (int pm = first_tile; pm < ntiles; pm += tile_step) {
        const bf16* A = (const bf16*)(ws + WS_HXY) + (size_t)pm * 256 * 1024;
        u32x4 ar[4][4];
#pragma unroll
        for (int j = 0; j < 4; ++j)
#pragma unroll
            for (int q = 0; q < 4; ++q) { const int idx = tid + 512 * q; ar[j][q] = ldg((const u32x4*)(A + (size_t)(idx >> 3) * 1024 + 64 * j + (idx & 7) * 8)); }
        f32x16 acc0, acc1;
#pragma unroll
        for (int i = 0; i < 16; ++i) { acc0[i] = 0.f; acc1[i] = 0.f; }
        lbar();
        for (int c4 = 0; c4 < 16; c4 += 4) {
#pragma unroll
            for (int j = 0; j < 4; ++j) { const int c = c4 + j;
#pragma unroll
                for (int q = 0; q < 4; ++q) { const int idx = tid + 512 * q; *(u32x4*)(AS + (idx >> 3) * LD64 + (idx & 7) * 8) = ar[j][q]; }
                if (c + 4 < 16) {
#pragma unroll
                    for (int q = 0; q < 4; ++q) { const int idx = tid + 512 * q; ar[j][q] = ldg((const u32x4*)(A + (size_t)(idx >> 3) * 1024 + 64 * (c + 4) + (idx & 7) * 8)); } }
                lbar();
#pragma unroll
                for (int ks = 0; ks < 4; ++ks) { const bf16x8 a = ldfrag(AS, LD64, 32 * wave, 16 * ks, lane);
                    const bf16x8 b0 = *(const bf16x8*)(WL + l32 * W48_LD + 64 * c + 16 * ks + 8 * hi), b1 = *(const bf16x8*)(WL + brow1 * W48_LD + 64 * c + 16 * ks + 8 * hi);
                    acc0 = MFMA32(a, b0, acc0); acc1 = MFMA32(a, b1, acc1); }
                lbar();
            }
        }
        float* dst = (float*)(ws + WS_SMALL);
        const size_t r0 = (size_t)pm * 256 + wave * 32;
        const float gb = l32 < 16 ? ldg(gate_b + l32) : 0.f; const bool ls = l32 < 16 && ((l32 >> 2) & 1);
#pragma unroll
        for (int i = 0; i < 16; ++i) { float x = acc0[i] + gb; if (ls) x = logsigmoid_(x); stg(dst + (r0 + crow(i, hi)) * 48 + l32, x); }
        if (l32 < 16) {
#pragma unroll
            for (int i = 0; i < 16; ++i) stg(dst + (r0 + crow(i, hi)) * 48 + 32 + l32, acc1[i]); }
    }
    lbar();
}

#ifndef DUP_MASK
#define DUP_MASK 0
#endif
#define XB_TMO      128
#define XB_XCNT(j)  (256  + 64 * (j))
#define XB_XSUB(j)  (1280 + 64 * (j))
#define XB_XGEN(j)  (2304 + 64 * (j))
#define XB_TOP      3328
#define XB_TOPGEN   3392
#define XCD_BAR_WORDS 3456
#define XB_SPIN_CAP (1u << 18)

__device__ __forceinline__ unsigned xb_ld(unsigned* p)              { return __hip_atomic_load(p, __ATOMIC_RELAXED, __HIP_MEMORY_SCOPE_AGENT); }
__device__ __forceinline__ unsigned xb_add(unsigned* p, unsigned v) { return __hip_atomic_fetch_add(p, v, __ATOMIC_RELAXED, __HIP_MEMORY_SCOPE_AGENT); }
__device__ __forceinline__ unsigned xb_xcc_id() { return (unsigned)__builtin_amdgcn_s_getreg((3 << 11) | 20) & 0xFu; }
#define XB_SPIN(cond, bar) do { unsigned _sp = 0; while (cond) { __builtin_amdgcn_s_sleep(1); \
    if ((++_sp & 255u) == 0u) { if (xb_ld(&(bar)[XB_TMO])) break; if (_sp > XB_SPIN_CAP) { atomicAdd(&(bar)[XB_TMO], 1u); break; } } } } while (0)

struct XcdBarrier {
    unsigned* bar; unsigned x;
    volatile unsigned* st;
};

__device__ __forceinline__ XcdBarrier xcd_barrier_post(unsigned* bar, volatile unsigned* st) {
    XcdBarrier b; b.bar = bar; b.x = xb_xcc_id(); b.st = st;
    if (threadIdx.x == 0) (void)xb_add(&bar[XB_XCNT(b.x)], 1u);
    return b;
}
__device__ __forceinline__ void xcd_barrier_complete(unsigned* bar, unsigned x, unsigned& nloc, unsigned& nx) {
    const unsigned G = gridDim.x * gridDim.y * gridDim.z;
    unsigned sum, cnt, mine, sp = 0u;
    for (;;) {
        sum = 0u; cnt = 0u; mine = 0u;
#pragma unroll
        for (unsigned j = 0; j < 16; ++j) { const unsigned c = xb_ld(&bar[XB_XCNT(j)]); sum += c; cnt += (c > 0u) ? 1u : 0u; mine = (j == x) ? c : mine; }
        if (sum == G) break;
        __builtin_amdgcn_s_sleep(1);
        if ((++sp & 255u) == 0u) { if (xb_ld(&bar[XB_TMO])) break; if (sp > XB_SPIN_CAP) { atomicAdd(&bar[XB_TMO], 1u); break; } }
    }
    nloc = mine > 0u ? mine : 1u; nx = cnt > 0u ? cnt : 1u;
}

__device__ __forceinline__ void xcd_barrier(const XcdBarrier& b) {
    asm volatile("s_waitcnt vmcnt(0)" ::: "memory");
    __syncthreads();
    if (threadIdx.x == 0) {
        unsigned* bar = b.bar;
        __builtin_amdgcn_s_waitcnt(0);
        unsigned nloc = b.st[0], nx = b.st[1];
        if (nloc == 0u) { xcd_barrier_complete(bar, b.x, nloc, nx); b.st[0] = nloc; b.st[1] = nx; }
        const unsigned old = xb_add(&bar[XB_XSUB(b.x)], 1u);
        const unsigned gen = old / nloc;
        if (old + 1u == (gen + 1u) * nloc) {
            __builtin_amdgcn_fence(__ATOMIC_RELEASE, "agent");
            asm volatile("s_waitcnt vmcnt(0)" ::: "memory");
            const unsigned og = xb_add(&bar[XB_TOP], 1u);
            const unsigned tg = og / nx;
            if (og + 1u == (tg + 1u) * nx) xb_add(&bar[XB_TOPGEN], 1u);
            else XB_SPIN(xb_ld(&bar[XB_TOPGEN]) == tg, bar);
            __builtin_amdgcn_fence(__ATOMIC_ACQUIRE, "agent");
            xb_add(&bar[XB_XGEN(b.x)], 1u);
            asm volatile("s_waitcnt vmcnt(0)" ::: "memory");
        } else {
            XB_SPIN(xb_ld(&bar[XB_XGEN(b.x)]) == gen, bar);
            __builtin_amdgcn_fence(__ATOMIC_ACQUIRE, "agent");
            asm volatile("s_waitcnt vmcnt(0)" ::: "memory");
        }
    }
    __syncthreads();
}

DI void gbar(unsigned* cnt, unsigned target) {
    asm volatile("s_waitcnt vmcnt(0) lgkmcnt(0)" ::: "memory");
    __syncthreads();
    if (threadIdx.x == 0) {
        __builtin_amdgcn_fence(__ATOMIC_RELEASE, "agent");
        __hip_atomic_fetch_add(cnt, 1u, __ATOMIC_RELAXED, __HIP_MEMORY_SCOPE_AGENT);
        while (__hip_atomic_load(cnt, __ATOMIC_RELAXED, __HIP_MEMORY_SCOPE_AGENT) < target) __builtin_amdgcn_s_sleep(1);
        __builtin_amdgcn_fence(__ATOMIC_ACQUIRE, "agent");
    }
    __syncthreads();
}
#define GSYNC() do { XcdBarrier xb_; xb_.bar = (unsigned*)(ws + WS_XBAR); xb_.x = xb_xcc_id(); xb_.st = (volatile unsigned*)(lds + LDS_BYTES - 64); xcd_barrier(xb_); if ((DUP_MASK) & 256) xcd_barrier(xb_); } while (0)
#define DUPN(bit) (((DUP_MASK) & (bit)) ? 2 : 1)
__global__ void __launch_bounds__(512, 2) fwd_kernel(Args a) {
    extern __shared__ __attribute__((aligned(16))) unsigned char lds[];
    cg::grid_group grid = cg::this_grid();
#ifdef PAD_NOPS
    asm volatile(".rept " PAD_NOPS "\n s_nop 0\n .endr" ::: );
#endif
    unsigned char* ws = a.ws;
    int tid = threadIdx.x, lane = tid & 63, wave = __builtin_amdgcn_readfirstlane(tid >> 6);
    const int G = gridDim.x, bid = blockIdx.x;
    float* MODV = (float*)(ws + WS_MODV); float* MISC = (float*)(ws + WS_MISC);
    if (bid == 0 && tid < 24) ((const float**)(ws + WS_ARGS))[tid] = tid < 23 ? a.in[tid] : (const float*)a.out;
    volatile unsigned* xst = (volatile unsigned*)(lds + LDS_BYTES - 64);
    if (tid < 2) xst[tid] = 0u;
    __syncthreads();
    (void)xcd_barrier_post((unsigned*)(ws + WS_XBAR), xst);


    for (int rep = 0; rep < DUPN(128); ++rep) {
        for (int task = bid; task < 96; task += G) {
            const int l = task / 48, n0 = (task % 48) * 64, n = n0 + lane;
            const float* wm = a.in[4] + (size_t)l * 1024 * 3072; const float* c = a.in[1]; const float* cc = a.in[3];
            float* SV = (float*)lds;
            for (int i = tid; i < 3072; i += 512) { const float x = i < 2048 ? c[i] : cc[i - 2048]; SV[i] = silu_(x); }
            __syncthreads();
            float a0 = 0.f, a1 = 0.f, a2 = 0.f;
            for (int k0 = 0; k0 < 128; k0 += 32) { float w[32];
#pragma unroll
                for (int kk = 0; kk < 32; ++kk) w[kk] = wm[(size_t)(wave * 128 + k0 + kk) * 3072 + n];
#pragma unroll
                for (int kk = 0; kk < 32; ++kk) { const int k = wave * 128 + k0 + kk; a0 += SV[k] * w[kk]; a1 += SV[1024 + k] * w[kk]; a2 += SV[2048 + k] * w[kk]; } }
            float* red = (float*)(lds + 131072);
            red[(wave * 3 + 0) * 64 + lane] = a0; red[(wave * 3 + 1) * 64 + lane] = a1; red[(wave * 3 + 2) * 64 + lane] = a2;
            __syncthreads();
            if (tid < 192) { const int v = tid >> 6; float s = a.in[5][l * 3072 + n0 + lane];
                for (int w = 0; w < 8; ++w) s += red[(w * 3 + v) * 64 + lane];
                MODV[(l * 3 + v) * 3072 + n0 + lane] = s; }
            __syncthreads();
        }
        if (bid == G - 1) {
            float* tabA = (float*)(ws + WS_TABA); float* tabD = (float*)(ws + WS_TABD);
            for (int idx = tid; idx < 128 * 8; idx += 512) { const int pos = idx >> 3, i = idx & 7;
                const float inv = exp2f(-(float)i * (13.287712379549449f / 8.f)); const float ang = (float)pos * inv;
                double rev = (double)ang * 0.15915494309189535; rev -= rint(rev);
                tabA[pos * 16 + i] = __builtin_amdgcn_cosf((float)rev); tabA[pos * 16 + 8 + i] = __builtin_amdgcn_sinf((float)rev); }
            for (int idx = tid; idx < 128 * 16; idx += 512) { const int pos = idx >> 4, i = idx & 15;
                const float inv = exp2f(-(float)i * (13.287712379549449f / 16.f)); const float ang = (float)pos * inv;
                double rev = (double)ang * 0.15915494309189535; rev -= rint(rev);
                tabD[pos * 32 + i] = __builtin_amdgcn_cosf((float)rev); tabD[pos * 32 + 16 + i] = __builtin_amdgcn_sinf((float)rev); }
            if (tid < 2) { const int l = tid; const float* lp = a.in[11] + l * 128; float s1 = 0.f, s2 = 0.f;
                for (int d = 0; d < 32; ++d) { s1 += lp[d] * lp[32 + d]; s2 += lp[64 + d] * lp[96 + d]; }
                const float lam_init = 0.8f - 0.6f * expf(-0.3f * (float)l);
                float gq = 0.f, gk = 0.f, gqd = 0.f, gkd = 0.f, sk = 0.f;
                for (int d = 0; d < 32; ++d) { gq = fmaxf(gq, fabsf(a.in[9][l * 32 + d])); gk = fmaxf(gk, fabsf(a.in[10][l * 32 + d])); }
                for (int d = 0; d < 64; ++d) { gqd = fmaxf(gqd, fabsf(a.in[20][l * 64 + d])); gkd = fmaxf(gkd, fabsf(a.in[21][l * 64 + d])); }
                for (int d = 0; d < 4; ++d) sk = fmaxf(sk, a.in[22][l * 4 + d] * LOG2E);
                MISC[l * 8 + 0] = expf(s1) - expf(s2) + lam_init; MISC[l * 8 + 1] = lam_init;
                MISC[l * 8 + 2] = 5.656854249f * LOG2E * gq * gk * 1.01f; MISC[l * 8 + 3] = fmaxf(8.f * LOG2E * gqd * gkd * 1.01f, sk); }
        }
        float* scr = (float*)(lds + wave * 16384);
        const int gw = bid * 8 + wave, NGW = G * 8;
        for (int it = gw; it < 2048; it += NGW) {
            if (it < 4096) { const int l = it >> 11; transpose_item(a.in[7] + (size_t)l * 1024 * NSRC, NSRC, true, (bf16*)(ws + WS_WIN) + (size_t)l * NP * 1024, 1024, it & 2047, NP / 32, scr, lane); }
            else { const int r = it - 4096, l = r >> 9; transpose_item(a.in[8] + (size_t)l * 1024 * 1024, 1024, false, (bf16*)(ws + WS_WOUT) + (size_t)l * 1024 * 1024, 1024, r & 511, 32, scr, lane); }
        }
    }
    if (a.ws == nullptr) grid.sync();
    GSYNC();

#pragma unroll 1
    for (int l = 0; l < 2; ++l) {
        asm volatile("" : "+s"(ws));
        const float* const* IN = (const float* const*)(ws + WS_ARGS); float* OUT = (float*)IN[23];
        const float* xsrc = l == 0 ? IN[0] : OUT; const float* csrc = l == 0 ? IN[2] : (const float*)(ws + WS_CTX);
        tid = otid(); lane = tid & 63; wave = __builtin_amdgcn_readfirstlane(tid >> 6);
        {
            const int gw = bid * 8 + wave, NGW = G * 8; const float* ng = IN[6] + l * 1024;
            for (int rep = 0; rep < DUPN(1); ++rep)
            for (int m0 = gw; m0 < M; m0 += 2 * NGW) {
                const float* srcs[2]; int vs[2]; bool ok[2]; f32x4 x[2][4];
#pragma unroll
                for (int r = 0; r < 2; ++r) { const int m = m0 + r * NGW; ok[r] = m < M; const int mm = ok[r] ? m : m0;
                    const int b = mm >= TK ? 1 : 0, j = mm - b * TK;
                    if (j < LC) { srcs[r] = csrc + (size_t)(b * LC + j) * D; vs[r] = 2; } else { srcs[r] = xsrc + (size_t)(b * T + j - LC) * D; vs[r] = b; }
#pragma unroll
                    for (int q = 0; q < 4; ++q) x[r][q] = ldg((const f32x4*)srcs[r] + lane + 64 * q); }
#pragma unroll
                for (int r = 0; r < 2; ++r) { if (!ok[r]) continue; const int m = m0 + r * NGW;
                    const float* md = MODV + (l * 3 + vs[r]) * 3072; float ss = 0.f;
#pragma unroll
                    for (int q = 0; q < 4; ++q) ss += (x[r][q].x * x[r][q].x + x[r][q].y * x[r][q].y) + (x[r][q].z * x[r][q].z + x[r][q].w * x[r][q].w);
                    const float rinv = rsqrtf(wave_sum(ss) * (1.f / 1024.f) + EPS);
                    bf16* dst = (bf16*)(ws + WS_HXY) + (size_t)m * D;
#pragma unroll
                    for (int q = 0; q < 4; ++q) { const int col = 4 * (lane + 64 * q);
                        const f32x4 g = ldg((const f32x4*)(ng + col)), sh = ldg((const f32x4*)(md + col)), sc = ldg((const f32x4*)(md + 1024 + col));
                        const f32x4 y = (x[r][q] * rinv) * g * (sc + 1.f) + sh;
                        stg((u32x2*)(dst + col), (u32x2){pk(y.x, y.y), pk(y.z, y.w)}); } }
            }
        }
        GSYNC();
        {
#ifdef USE_MINI
            constexpr int NBIG = 3840, NUNITS = (M / 256) * (NBIG / 256);
            { const int first = NUNITS % G;
              if (bid >= first) mini_proj(lds, ws, bid - first, G - first, M / 256, (const bf16*)(ws + WS_WIN) + ((size_t)l * NP + NBIG) * 1024, IN[15] + l * 16); }
#else
            constexpr int NBIG = NP;
#endif
            pg8::Gemm g{(const pg8::bf16_t*)(ws + WS_HXY), (const pg8::bf16_t*)(ws + WS_WIN) + (size_t)l * NP * 1024, M, NBIG, D};
            pg8::StaticOrder S; S.init(M, NBIG, G, bid);
            EpiIn E{ws, l};
            for (int rep = 0; rep < DUPN(2); ++rep) pg8::gemm_phase<EpiIn, pg8::StaticOrder, true, true>((PG8_LAS unsigned char*)lds, g, S, E);
        }
        GSYNC();
        {
            const float* misc = MISC + l * 8;
#ifdef PAD_CA
            asm volatile("s_nop 0");
#endif
            fill_wcache(lds, IN, l);
            for (int rep = 0; rep < DUPN(4); ++rep) {
                { const float* cw = (const float*)(lds + WC_OFF) + WC_CW; const float* cb = (const float*)(lds + WC_OFF) + WC_CB;
                  int t = bid; MaPre cur = mlstm_a_load(ws, t < 8 * NCH ? t : 0);
                  while (t < 8 * NCH) { const int tn = t + G; MaPre nxt = mlstm_a_load(ws, tn < 8 * NCH ? tn : t); mlstm_a_run(lds, ws, t, cur, cw, cb); cur = nxt; t = tn; } }
                { const float* wg = (const float*)(lds + WC_OFF) + WC_WG; const float* bg = (const float*)(lds + WC_OFF) + WC_BG;
                  int t = bid; GlPre cur = gla_load(ws, t < 8 * NCH ? t : 0, false);
                  while (t < 8 * NCH) { const int tn = t + G; GlPre nxt = gla_load(ws, tn < 8 * NCH ? tn : t, false); gla_a_run(lds, ws, t, cur, wg, bg); cur = nxt; t = tn; } }
            }
#ifdef PAD_CA
            asm volatile("s_nop 0");
#endif
            const int nU = l == 0 ? 264 : 256;
            for (int rep = 0; rep < DUPN(8); ++rep)
            for (int u = bid; u < nU; u += G) attnD_unit(lds, ws, u, IN[22] + l * 4, misc);
            for (int rep = 0; rep < DUPN(16); ++rep)
            for (int u = bid; u < nU; u += G) attnA_unit(lds, ws, u, IN[12] + l * 64, misc);
        }
        GSYNC();
        for (int t = bid; t < 208; t += G) scan_b(lds, ws, t);
        if (l == 0) {
            float* scr = (float*)(lds + wave * 16384);
            for (int it = 2048 + bid * 8 + wave; it < 2 * 2048 + 2 * 512; it += G * 8) {
                if (it < 4096) { transpose_item(IN[7] + (size_t)1024 * NSRC, NSRC, true, (bf16*)(ws + WS_WIN) + (size_t)NP * 1024, 1024, it & 2047, NP / 32, scr, lane); }
                else { const int r = it - 4096, ll = r >> 9; transpose_item(IN[8] + (size_t)ll * 1024 * 1024, 1024, false, (bf16*)(ws + WS_WOUT) + (size_t)ll * 1024 * 1024, 1024, r & 511, 32, scr, lane); }
            }
            __syncthreads();
        }
        GSYNC();
#ifdef PAD_CC
        asm volatile("s_nop 0");
#endif
        fill_wcache(lds, IN, l);
        for (int rep = 0; rep < DUPN(32); ++rep) {
            const int ncl = l == 0 ? NCH : NCH - 4, ntask = 8 * ncl;
#define C_TASK(u) (((u) / ncl) * NCH + ((u) % ncl) + (NCH - ncl))
            { const float* cw = (const float*)(lds + WC_OFF) + WC_CW; const float* cb = (const float*)(lds + WC_OFF) + WC_CB; const float* on = (const float*)(lds + WC_OFF) + WC_BON;
              int u = bid; McPre cur = mlstm_c_load(ws, C_TASK(u < ntask ? u : 0));
              while (u < ntask) { const int un = u + G; McPre nxt = mlstm_c_load(ws, C_TASK(un < ntask ? un : u)); mlstm_c_run(lds, ws, C_TASK(u), cur, cw, cb, on); cur = nxt; u = un; } }
            { const float* wg = (const float*)(lds + WC_OFF) + WC_WG; const float* bg = (const float*)(lds + WC_OFF) + WC_BG; const float* on = (const float*)(lds + WC_OFF) + WC_CON;
              int u = bid; GcPre cur = gla_c_load(ws, C_TASK(u < ntask ? u : 0));
              while (u < ntask) { const int un = u + G; GcPre nxt = gla_c_load(ws, C_TASK(un < ntask ? un : u)); gla_c_run(lds, ws, C_TASK(u), cur, wg, bg, on); cur = nxt; u = un; } }
        }
#ifdef PAD_CC
        asm volatile("s_nop 0");
#endif
        GSYNC();
        {
            pg8::Gemm g{(const pg8::bf16_t*)(ws + WS_HXY), (const pg8::bf16_t*)(ws + WS_WOUT) + (size_t)l * 1024 * 1024, M, D, D};
            EpiOut E{xsrc, csrc, OUT, (float*)(ws + WS_CTX), MODV + l * 3 * 3072};
            if (l == 0) { pg8::StaticOrder S; S.init(M, D, G, bid); for (int rep = 0; rep < DUPN(64); ++rep) pg8::gemm_phase<EpiOut, pg8::StaticOrder, true, true>((PG8_LAS unsigned char*)lds, g, S, E); }
            else { LatOrder S; S.so.init(NB * T, D, G, bid); pg8::gemm_phase<EpiOut, LatOrder, true, true>((PG8_LAS unsigned char*)lds, g, S, E); }
        }
        if (l == 0) GSYNC();
    }
}

extern "C" void kernel_launch(void* const* d_in, const int* in_sizes, int n_in, void* d_out, int out_size, void* d_ws, size_t ws_size, hipStream_t stream) {
    static int grid = 0;
    if (grid == 0) {
        int dev = 0, cus = 0, per_cu = 0;
        if (n_in != 23 || ws_size < 256 * MiB) { fprintf(stderr, "kernel_launch: unexpected inputs (n_in %d, ws %zu)\n", n_in, ws_size); grid = -1; return; }
        hipGetDevice(&dev); hipDeviceGetAttribute(&cus, hipDeviceAttributeMultiprocessorCount, dev);
        if (hipFuncSetAttribute((const void*)fwd_kernel, hipFuncAttributeMaxDynamicSharedMemorySize, LDS_BYTES) != hipSuccess) { fprintf(stderr, "kernel_launch: hipFuncSetAttribute failed\n"); grid = -1; return; }
        if (hipOccupancyMaxActiveBlocksPerMultiprocessor(&per_cu, (const void*)fwd_kernel, 512, LDS_BYTES) != hipSuccess || per_cu < 1) { fprintf(stderr, "kernel_launch: occupancy query says %d\n", per_cu); per_cu = 1; }
        (void)hipGetLastError();
        grid = cus > 0 ? cus : 256;
    }
    if (grid < 0) return;
    Args a{};
    for (int i = 0; i < 23; ++i) a.in[i] = (const float*)d_in[i];
    a.out = (float*)d_out; a.ws = (unsigned char*)d_ws;
    if (hipMemsetAsync((char*)d_ws + WS_XBAR, 0, 16384, stream) != hipSuccess) { fprintf(stderr, "kernel_launch: memset of the barrier word failed\n"); return; }
    void* args[] = {&a};
    hipError_t e = hipLaunchCooperativeKernel((const void*)fwd_kernel, dim3(grid), dim3(512), args, LDS_BYTES, stream);
    if (e != hipSuccess) fprintf(stderr, "kernel_launch: cooperative launch failed: %s (grid %d)\n", hipGetErrorString(e), grid);
}
```

```cpp
#include <hip/hip_runtime.h>
#include <hip/hip_cooperative_groups.h>
#include <cstdio>
#include <cstdint>
namespace cg = cooperative_groups;
#define DUP_MASK 0
#define PAD_NOPS "6"
#define USE_MINI
namespace pg8 {
#define PG8_LAS __attribute__((address_space(3)))
typedef unsigned short bf16_t;
typedef short bf16x8 __attribute__((ext_vector_type(8)));
typedef float f32x4 __attribute__((ext_vector_type(4)));
typedef unsigned u32x4 __attribute__((ext_vector_type(4)));
constexpr int BM = 256, BK = 64, HALF = 128, HTB = HALF * BK * 2  , STAGE_BYTES = 8 * HTB, NXCD = 8, WGM = 8;

__host__ __device__ __forceinline__ int lds_byte(int r, int c) { const int st = (r >> 4) * 2 + (c >> 5), rr = r & 15, cc = c & 31, ob = rr * 64 + cc * 2; return st * 1024 + (ob ^ (((ob >> 9) & 1) << 5)); }
__host__ __device__ __forceinline__ void stage_rc(int b, int& R, int& C) { const int st = b / 1024, sb = b % 1024, swz = sb ^ (((sb >> 9) & 1) << 5); R = (st >> 1) * 16 + swz / 64; C = (st & 1) * 32 + (swz % 64) / 2; }
__host__ __device__ __forceinline__ int perm32(int rho) { const int n = rho >> 4, i = rho & 15; return 8 * (i >> 2) + 4 * n + (i & 3); }

struct Unit { int pm, pn; };
struct Gemm { const bf16_t* A; const bf16_t* Bt; int M, N, K; };

struct StaticOrder {
    int nM, nN, nwg, G, c;
    __host__ __device__ void init(int M, int N, int G_, int c_) { nM = M / BM; nN = N / BM; nwg = nM * nN; G = G_; c = c_; }
    __host__ __device__ bool next(int i, Unit& u) const {
        const long L = (long)i * G + c; if (L >= nwg) return false;
        int wgid = (int)L; { const int q = nwg / NXCD, r = nwg % NXCD, xcd = wgid % NXCD, off = wgid / NXCD; wgid = (xcd < r ? xcd * (q + 1) : r * (q + 1) + (xcd - r) * q) + off; }
        const int nig = WGM * nN, gid = wgid / nig, fm = gid * WGM, gsz = (nM - fm) < WGM ? (nM - fm) : WGM;
        u.pm = fm + ((wgid % nig) % gsz); u.pn = (wgid % nig) / gsz; return true;
    }
    __device__ __forceinline__ void a_ready(const Unit&) const {}
    __device__ __forceinline__ void done(const Unit&) const {}
};

__device__ __forceinline__ unsigned cvt_pk_bf16(float lo, float hi) { unsigned r; asm volatile("v_cvt_pk_bf16_f32 %0, %1, %2" : "=v"(r) : "v"(lo), "v"(hi)); return r; }
typedef float f32x2 __attribute__((ext_vector_type(2)));
template <class Epi, class Sched, bool ALIGN_EPI = false, bool SP2 = false>
__device__ __forceinline__ void gemm_phase(PG8_LAS unsigned char* lds, const Gemm g, const Sched& S, const Epi& E) {
    int tid_ = threadIdx.x; asm volatile("" : "+v"(tid_)); const int tid = tid_, wid = __builtin_amdgcn_readfirstlane(tid >> 6), lane = tid & 63, wr = wid >> 2, wc = wid & 3, fr = lane & 15, fq = lane >> 4;
    const int K = g.K, nt = K / BK;
    unsigned voffA[2], voffB[2];
#pragma unroll
    for (int i = 0; i < 2; ++i) { int R, C; stage_rc(tid * 16 + i * 8192, R, C); const int Rb = Epi::PERM ? ((R & ~31) + perm32(R & 31)) : R;
        voffA[i] = (unsigned)(R * K + C) * 2u; voffB[i] = (unsigned)(Rb * K + C) * 2u; }
    const size_t kstep = (size_t)(BK * 2);
    const size_t hstep = (size_t)HALF * K * 2;
    const size_t tstep = 2 * hstep;
    const unsigned ldsw = (unsigned)wid * 1024u;
    const int aoff = lds_byte(wr * 64 + fr, fq * 8), boff = lds_byte(wc * 32 + fr, fq * 8);
#define PG8_SA(b, h) (((b) * 2 + (h)) * HTB)
#define PG8_SB(b, h) ((4 + (b) * 2 + (h)) * HTB)
#define PG8_STAGE(bufoff, gbase, voff) do { _Pragma("unroll") for (int _i = 0; _i < 2; ++_i) \
        __builtin_amdgcn_global_load_lds((const unsigned*)((const char*)(gbase) + (voff)[_i]), (PG8_LAS unsigned*)(lds + (bufoff) + ldsw + _i * 8192), 16, 0, 0); } while (0)
#define PG8_LDA(dst, b, h) do { _Pragma("unroll") for (int m = 0; m < 4; ++m) _Pragma("unroll") for (int k = 0; k < 2; ++k) dst[m][k] = *(const PG8_LAS bf16x8*)(lds + PG8_SA(b, h) + aoff + m * 2048 + k * 1024); } while (0)
#define PG8_LDB(dst, b, h) do { _Pragma("unroll") for (int n = 0; n < 2; ++n) _Pragma("unroll") for (int k = 0; k < 2; ++k) dst[n][k] = *(const PG8_LAS bf16x8*)(lds + PG8_SB(b, h) + boff + n * 2048 + k * 1024); } while (0)
#define PG8_MMA(ai, bj, At, Bt) do { __builtin_amdgcn_s_setprio(1); _Pragma("unroll") for (int m = 0; m < 4; ++m) _Pragma("unroll") for (int n = 0; n < 2; ++n) _Pragma("unroll") for (int k = 0; k < 2; ++k) \
        acc[ai][bj][m][n] = __builtin_amdgcn_mfma_f32_16x16x32_bf16(Bt[n][k], At[m][k], acc[ai][bj][m][n], 0, 0, 0); __builtin_amdgcn_s_setprio(0); } while (0)
#define PG8_WAIT_V(n) asm volatile("s_waitcnt vmcnt(" #n ")" ::: "memory")
#define PG8_WAIT_L(n) asm volatile("s_waitcnt lgkmcnt(" #n ")" ::: "memory")
#define PG8_BAR __builtin_amdgcn_s_barrier()
#define PG8_SCHED __builtin_amdgcn_sched_barrier(0)
    Unit cur, nxt; int ui = 0;
    if (!S.next(0, cur)) return;
    f32x4 acc[2][2][4][2];
#pragma unroll
    for (int a = 0; a < 2; ++a)
#pragma unroll
        for (int b = 0; b < 2; ++b)
#pragma unroll
            for (int m = 0; m < 4; ++m)
#pragma unroll
                for (int n = 0; n < 2; ++n) acc[a][b][m][n] = (f32x4){0.f, 0.f, 0.f, 0.f};
    bf16x8 At[4][2], B0[2][2], B1[2][2];
    const char* cA = (const char*)g.A + (size_t)cur.pm * tstep; const char* cB = (const char*)g.Bt + (size_t)cur.pn * tstep;
    S.a_ready(cur);
    if constexpr (SP2) {
        PG8_STAGE(PG8_SB(0, 0), cB, voffB); PG8_STAGE(PG8_SB(0, 1), cB + hstep, voffB); PG8_STAGE(PG8_SA(0, 0), cA, voffA); PG8_STAGE(PG8_SA(0, 1), cA + hstep, voffA);
        if (wr == 1) PG8_BAR;
        PG8_WAIT_V(2); PG8_BAR;
        PG8_STAGE(PG8_SB(1, 0), cB + kstep, voffB); PG8_STAGE(PG8_SA(1, 0), cA + kstep, voffA); PG8_STAGE(PG8_SB(1, 1), cB + hstep + kstep, voffB);
        PG8_WAIT_V(6); PG8_BAR;
    } else {
        PG8_STAGE(PG8_SB(0, 0), cB, voffB); PG8_STAGE(PG8_SA(0, 0), cA, voffA); PG8_STAGE(PG8_SB(0, 1), cB + hstep, voffB); PG8_STAGE(PG8_SA(0, 1), cA + hstep, voffA);
        if (wr == 1) PG8_BAR;
        PG8_WAIT_V(4); PG8_BAR;
        PG8_STAGE(PG8_SB(1, 0), cB + kstep, voffB); PG8_STAGE(PG8_SA(1, 0), cA + kstep, voffA); PG8_STAGE(PG8_SB(1, 1), cB + hstep + kstep, voffB);
        PG8_WAIT_V(6); PG8_BAR;
    }
#ifdef PAD_G
    if constexpr (Epi::PADK) asm volatile("s_nop 0");
#endif
    for (;;) {
        const bool has_next = S.next(ui + 1, nxt);
        const char* nA = has_next ? (const char*)g.A + (size_t)nxt.pm * tstep : cA; const char* nB = has_next ? (const char*)g.Bt + (size_t)nxt.pn * tstep : cB;
        for (int t = 0; t < nt; t += 2) {
            const bool last = (t == nt - 2);
            const char* a1 = cA + (size_t)(t + 1) * kstep;
            const char* a2 = last ? nA : cA + (size_t)(t + 2) * kstep; const char* b2 = last ? nB : cB + (size_t)(t + 2) * kstep;
            const char* a3 = a2 + kstep; const char* b3 = b2 + kstep;
            if (last && has_next) S.a_ready(nxt);
            if constexpr (SP2) {
            PG8_LDB(B0, 0, 0); PG8_LDB(B1, 0, 1); PG8_SCHED; PG8_LDA(At, 0, 0); PG8_STAGE(PG8_SA(1, 1), a1 + hstep, voffA);
            PG8_WAIT_V(8); PG8_WAIT_L(0); PG8_BAR; PG8_MMA(0, 0, At, B0); PG8_MMA(0, 1, At, B1); PG8_BAR; PG8_SCHED;
            PG8_LDA(At, 0, 1); PG8_STAGE(PG8_SB(0, 0), b2, voffB); PG8_STAGE(PG8_SB(0, 1), b2 + hstep, voffB); PG8_STAGE(PG8_SA(0, 0), a2, voffA);
            PG8_WAIT_V(8); PG8_WAIT_L(0); PG8_BAR; PG8_MMA(1, 0, At, B0); PG8_MMA(1, 1, At, B1); PG8_BAR; PG8_SCHED;
            PG8_LDB(B0, 1, 0); PG8_LDB(B1, 1, 1); PG8_SCHED; PG8_LDA(At, 1, 0); PG8_STAGE(PG8_SA(0, 1), a2 + hstep, voffA);
            PG8_WAIT_V(8); PG8_WAIT_L(0); PG8_BAR; PG8_MMA(0, 0, At, B0); PG8_MMA(0, 1, At, B1); PG8_BAR; PG8_SCHED;
            PG8_LDA(At, 1, 1); PG8_STAGE(PG8_SB(1, 0), b3, voffB); PG8_STAGE(PG8_SB(1, 1), b3 + hstep, voffB); PG8_STAGE(PG8_SA(1, 0), a3, voffA);
            PG8_WAIT_V(8); PG8_WAIT_L(0); PG8_BAR; PG8_MMA(1, 0, At, B0); PG8_MMA(1, 1, At, B1); PG8_BAR; PG8_SCHED;
            } else {
            PG8_LDB(B0, 0, 0); PG8_SCHED; PG8_LDA(At, 0, 0); PG8_STAGE(PG8_SA(1, 1), a1 + hstep, voffA);
            PG8_WAIT_L(8); PG8_BAR; PG8_WAIT_L(0); PG8_MMA(0, 0, At, B0); PG8_BAR; PG8_SCHED;
            PG8_LDB(B1, 0, 1); PG8_STAGE(PG8_SB(0, 0), b2, voffB);
            PG8_BAR; PG8_WAIT_L(0); PG8_MMA(0, 1, At, B1); PG8_BAR;
            PG8_LDA(At, 0, 1); PG8_STAGE(PG8_SA(0, 0), a2, voffA);
            PG8_BAR; PG8_WAIT_L(0); PG8_MMA(1, 0, At, B0); PG8_BAR; PG8_SCHED;
            PG8_STAGE(PG8_SB(0, 1), b2 + hstep, voffB);
            PG8_WAIT_V(6); PG8_BAR; PG8_MMA(1, 1, At, B1); PG8_BAR;
            PG8_LDB(B0, 1, 0); PG8_SCHED; PG8_LDA(At, 1, 0); PG8_STAGE(PG8_SA(0, 1), a2 + hstep, voffA);
            PG8_WAIT_L(8); PG8_BAR; PG8_WAIT_L(0); PG8_MMA(0, 0, At, B0); PG8_BAR; PG8_SCHED;
            PG8_LDB(B1, 1, 1); PG8_STAGE(PG8_SB(1, 0), b3, voffB);
            PG8_BAR; PG8_WAIT_L(0); PG8_MMA(0, 1, At, B1); PG8_BAR;
            PG8_LDA(At, 1, 1); PG8_STAGE(PG8_SA(1, 0), a3, voffA);
            PG8_BAR; PG8_WAIT_L(0); PG8_MMA(1, 0, At, B0); PG8_BAR; PG8_SCHED;
            PG8_STAGE(PG8_SB(1, 1), b3 + hstep, voffB);
            PG8_WAIT_V(6); PG8_BAR; PG8_MMA(1, 1, At, B1); PG8_BAR;
            }
        }
        if constexpr (ALIGN_EPI) { if (wr == 0) PG8_BAR; }
        if constexpr (!Epi::AFTER_DRAIN) { E(acc, cur, wr, wc, fr, fq); S.done(cur); }
        if (!has_next) break;
#pragma unroll
        for (int a = 0; a < 2; ++a)
#pragma unroll
            for (int b = 0; b < 2; ++b)
#pragma unroll
                for (int m = 0; m < 4; ++m)
#pragma unroll
                    for (int n = 0; n < 2; ++n) acc[a][b][m][n] = (f32x4){0.f, 0.f, 0.f, 0.f};
        cur = nxt; cA = nA; cB = nB; ++ui;
        if constexpr (ALIGN_EPI) { if (wr == 1) PG8_BAR; }
    }
#ifdef PAD_G
    if constexpr (Epi::PADK) asm volatile("s_nop 0");
#endif
    PG8_WAIT_V(0);
    if constexpr (!ALIGN_EPI) { if (wr == 0) PG8_BAR; }
    PG8_BAR;
    if constexpr (Epi::AFTER_DRAIN) { E.fused(acc, cur, wr, wc, fr, fq, lds, wid, lane); S.done(cur); }
#undef PG8_SA
#undef PG8_SB
#undef PG8_STAGE
#undef PG8_LDA
#undef PG8_LDB
#undef PG8_MMA
#undef PG8_WAIT_V
#undef PG8_WAIT_L
#undef PG8_BAR
#undef PG8_SCHED
}
}

#define DI __device__ __forceinline__
typedef unsigned short bf16;
typedef short bf16x8 __attribute__((ext_vector_type(8)));
typedef float f32x4 __attribute__((ext_vector_type(4)));
typedef float f32x16 __attribute__((ext_vector_type(16)));
typedef unsigned u32x4 __attribute__((ext_vector_type(4)));
typedef unsigned u32x2 __attribute__((ext_vector_type(2)));
typedef __bf16 bf16x2_t __attribute__((ext_vector_type(2)));
typedef float f32x2_t __attribute__((ext_vector_type(2)));
#define MFMA32(a, b, c) __builtin_amdgcn_mfma_f32_32x32x16_bf16((a), (b), (c), 0, 0, 0)

constexpr int NB = 2, T = 8192, LC = 256, TK = 8448, M = NB * TK, D = 1024, NSRC = 3888, NP = 4096, NCH = 132;
constexpr float EPS = 1e-6f, LOG2E = 1.4426950408889634f;
constexpr int LDS_BYTES = 147456;

constexpr size_t MiB = 1u << 20;
constexpr size_t S8 = (size_t)M * 256 * 2, S4 = S8 / 2;
constexpr size_t WS_ARGS = 512 * 1024, WS_XBAR = 64 * 1024;
constexpr size_t WS_MODV = 1 * MiB, WS_TABA = WS_MODV + 131072, WS_TABD = WS_TABA + 8192, WS_MISC = WS_TABD + 16384;
constexpr size_t WS_WIN = 2 * MiB, WS_WOUT = 18 * MiB, WS_CTX = 22 * MiB, WS_HXY = 24 * MiB;
constexpr size_t WS_QA = 57 * MiB, WS_KA = WS_QA + S8, WS_VAT = WS_KA + S8, WS_QB = WS_VAT + S8, WS_KB = WS_QB + S8, WS_VBT = WS_KB + S8, WS_OB = WS_VBT + S8;
constexpr size_t WS_QC = WS_OB + S8, WS_KC = WS_QC + S4, WS_VCT = WS_KC + S4, WS_QD = WS_VCT + S8, WS_KD = WS_QD + S8, WS_VDT = WS_KD + S4, WS_GATE = WS_VDT + S4;
constexpr size_t WS_SMALL = WS_GATE + 4 * S8;
constexpr size_t WS_CST = 184 * MiB, WS_NST = 217 * MiB, WS_SSC = WS_NST + 768 * 1024, WS_SST = 218 * MiB, WS_GD = WS_SST + (size_t)16 * NCH * 2048 * 4;
static_assert(WS_SMALL + (size_t)M * 48 * 4 <= WS_CST, "ws map");
static_assert(WS_CST + (size_t)16 * NCH * 4096 * 4 <= WS_NST, "ws map");
static_assert(WS_GD + (size_t)16 * NCH * 32 * 4 <= 256 * MiB, "ws map");

DI unsigned pk(float lo, float hi) { f32x2_t v = {lo, hi}; bf16x2_t b = __builtin_convertvector(v, bf16x2_t); return __builtin_bit_cast(unsigned, b); }
DI bf16 f2b(float x) { return (bf16)(pk(x, 0.f) & 0xffffu); }
DI float b2f(bf16 x) { return __uint_as_float((unsigned)x << 16); }
DI float bfe(const u32x4& v, int e) { const unsigned w = v[e >> 1]; return __uint_as_float((e & 1) ? (w & 0xffff0000u) : (w << 16)); }
DI float bfe2(const u32x2& v, int e) { const unsigned w = v[e >> 1]; return __uint_as_float((e & 1) ? (w & 0xffff0000u) : (w << 16)); }
DI void st8(bf16* p, const float* v) { u32x4 w; w.x = pk(v[0], v[1]); w.y = pk(v[2], v[3]); w.z = pk(v[4], v[5]); w.w = pk(v[6], v[7]); *(u32x4*)p = w; }
DI void st8g(bf16* p, const float* v) { u32x4 w; w.x = pk(v[0], v[1]); w.y = pk(v[2], v[3]); w.z = pk(v[4], v[5]); w.w = pk(v[6], v[7]); *(__attribute__((address_space(1))) u32x4*)p = w; }
DI void st8t(bf16* p, const float* v) {
#pragma unroll
    for (int e = 0; e < 8; ++e) *(__attribute__((address_space(1))) bf16*)(p + (size_t)e * TK) = f2b(v[e]); }
DI float sigmoid_(float x) { return 1.f / (1.f + __expf(-x)); }
DI float silu_(float x) { return x * sigmoid_(x); }
DI float logsigmoid_(float x) { return fminf(x, 0.f) - log1pf(expf(-fabsf(x))); }
DI int crow(int r, int hi) { return (r & 3) + 8 * (r >> 2) + 4 * hi; }
DI float wave_sum(float v) {
#pragma unroll
    for (int o = 1; o < 64; o <<= 1) v += __shfl_xor(v, o);
    return v; }
DI void getv(const f32x4& a, const f32x4& b, float* v) { v[0] = a[0]; v[1] = a[1]; v[2] = a[2]; v[3] = a[3]; v[4] = b[0]; v[5] = b[1]; v[6] = b[2]; v[7] = b[3]; }
DI bf16x8 ldfrag(const bf16* X, int ld, int r0, int k0, int lane) { return *(const bf16x8*)(X + (r0 + (lane & 31)) * ld + k0 + 8 * (lane >> 5)); }

DI int otid() { int t = threadIdx.x; asm volatile("" : "+v"(t)); return t; }
template <class T> DI T ldg(const T* p) { return *(const __attribute__((address_space(1))) T*)p; }
template <class T> DI void stg(T* p, const T& v) { *(__attribute__((address_space(1))) T*)p = v; }
DI void lbar() { asm volatile("s_waitcnt lgkmcnt(0)" ::: "memory"); __builtin_amdgcn_s_barrier(); asm volatile("" ::: "memory"); }
struct Args { const float* in[23]; float* out; unsigned char* ws; };

DI int srccol(int n) {
    const int tile = n >> 8, p = n & 255;
    if (tile < 6) return n;
    if (tile == 6) return 1552 + p;
    if (tile == 7) return 1808 + p;
    if (tile == 8) return 2064 + p;
    if (tile == 9 || tile == 10) {
        const int hh = (p >> 5) & 3, d = ((p >> 7) << 5) + (p & 31);
        if (tile == 9) return 2352 + hh * 64 + d;
        return hh < 2 ? 2608 + hh * 64 + d : 2736 + (hh - 2) * 64 + d;
    }
    if (tile < 15) return 2864 + (n - 11 * 256);
    if (p < 16) return 1536 + p;
    if (p < 48) return 2320 + (p - 16);
    return -1;
}

DI void transpose_item(const float* W, int Nsrc, bool perm, bf16* WT, int K, int item, int nblk, float* scr, int lane) {
    const int kb = item / nblk, nb = item - kb * nblk, k0 = 64 * kb, n0 = 32 * nb;
    const int n = n0 + (lane & 31); const int sc = perm ? srccol(n) : n;
#pragma unroll 8
    for (int i = 0; i < 32; ++i) { const int kk = 2 * i + (lane >> 5); scr[kk * 33 + (lane & 31)] = sc >= 0 ? W[(size_t)(k0 + kk) * Nsrc + sc] : 0.f; }
    asm volatile("s_waitcnt lgkmcnt(0)" ::: "memory");
    const int c = lane & 7;
#pragma unroll
    for (int j = 0; j < 4; ++j) { const int nn = (lane >> 3) + 8 * j; const float* s = scr + (8 * c) * 33 + nn;
        u32x4 o; o.x = pk(s[0 * 33], s[1 * 33]); o.y = pk(s[2 * 33], s[3 * 33]); o.z = pk(s[4 * 33], s[5 * 33]); o.w = pk(s[6 * 33], s[7 * 33]);
        *(u32x4*)(WT + (size_t)(n0 + nn) * K + k0 + 8 * c) = o; }
    asm volatile("s_waitcnt lgkmcnt(0)" ::: "memory");
}

DI void a_head(float* v, const float* gn, bool rope, const float* tab, int fq, float scale) {
    float ss = 0.f;
#pragma unroll
    for (int e = 0; e < 8; ++e) ss += v[e] * v[e];
    ss += __shfl_xor(ss, 16); ss += __shfl_xor(ss, 32);
    const float rinv = rsqrtf(ss * (1.f / 32.f) + EPS);
#pragma unroll
    for (int e = 0; e < 8; ++e) v[e] *= rinv * gn[e];
    if (rope) {
        const f32x4 ca = ldg((const f32x4*)tab), cb = ldg((const f32x4*)(tab + 4)), sa = ldg((const f32x4*)(tab + 8)), sb = ldg((const f32x4*)(tab + 12));
        float c[8], sn[8]; getv(ca, cb, c); getv(sa, sb, sn);
#pragma unroll
        for (int e = 0; e < 8; ++e) { const float p = __shfl_xor(v[e], 16); v[e] = (fq & 1) ? (p * sn[e] + v[e] * c[e]) : (v[e] * c[e] - p * sn[e]); }
    }
#pragma unroll
    for (int e = 0; e < 8; ++e) v[e] *= scale;
}
DI void d_head(float* v0, float* v1, const float* g0, const float* g1, bool rope, const float* tabr, const float* tabc, int fq, float scale) {
    float ss = 0.f;
#pragma unroll
    for (int e = 0; e < 8; ++e) ss += v0[e] * v0[e] + v1[e] * v1[e];
    ss += __shfl_xor(ss, 16); ss += __shfl_xor(ss, 32);
    const float rinv = rsqrtf(ss * (1.f / 64.f) + EPS);
#pragma unroll
    for (int e = 0; e < 8; ++e) { v0[e] *= rinv * g0[e]; v1[e] *= rinv * g1[e]; }
    if (rope) {
        const int fi = 8 * (fq & 1);
        { const f32x4 ca = ldg((const f32x4*)(tabr + fi)), cb = ldg((const f32x4*)(tabr + fi + 4)), sa = ldg((const f32x4*)(tabr + 16 + fi)), sb = ldg((const f32x4*)(tabr + 16 + fi + 4));
          float c[8], sn[8]; getv(ca, cb, c); getv(sa, sb, sn);
#pragma unroll
          for (int e = 0; e < 8; ++e) { const float p0 = __shfl_xor(v0[e], 32); v0[e] = (fq >= 2) ? (p0 * sn[e] + v0[e] * c[e]) : (v0[e] * c[e] - p0 * sn[e]); } }
        asm volatile("" ::: "memory");
        { const f32x4 ca = ldg((const f32x4*)(tabc + fi)), cb = ldg((const f32x4*)(tabc + fi + 4)), sa = ldg((const f32x4*)(tabc + 16 + fi)), sb = ldg((const f32x4*)(tabc + 16 + fi + 4));
          float c[8], sn[8]; getv(ca, cb, c); getv(sa, sb, sn);
#pragma unroll
          for (int e = 0; e < 8; ++e) { const float p1 = __shfl_xor(v1[e], 32); v1[e] = (fq >= 2) ? (p1 * sn[e] + v1[e] * c[e]) : (v1[e] * c[e] - p1 * sn[e]); } }
    }
#pragma unroll
    for (int e = 0; e < 8; ++e) { v0[e] *= scale; v1[e] *= scale; }
}

struct EpiIn {
    static constexpr bool PERM = true, AFTER_DRAIN = false;
#ifdef PAD_GIN
    static constexpr bool PADK = true;
#else
    static constexpr bool PADK = false;
#endif
    unsigned char* ws; int l;
    DI void operator()(const pg8::f32x4 (&acc)[2][2][4][2], const pg8::Unit& u, int wr, int wc, int fr_, int fq_) const {
        int fr = fr_, fq = fq_; asm volatile("" : "+v"(fr), "+v"(fq));
        const int b = u.pm >= 33 ? 1 : 0, pmi = u.pm - 33 * b; const bool is_ctx = (pmi == 0);
        const int j00 = pmi * 256 + wr * 64 + fr, pn = u.pn;
        const float* tabA = (const float*)(ws + WS_TABA); const float* tabD = (const float*)(ws + WS_TABD);
        const float* const* IN = (const float* const*)(ws + WS_ARGS);
#define ROWS_BEGIN _Pragma("unroll") for (int ai = 0; ai < 2; ++ai) _Pragma("unroll") for (int m = 0; m < 4; ++m) { \
        float v0[8], v1[8]; getv(acc[ai][0][m][0], acc[ai][0][m][1], v0); getv(acc[ai][1][m][0], acc[ai][1][m][1], v1); \
        const int j = j00 + ai * 128 + m * 16; const size_t mrow = (size_t)b * TK + j; const int t = is_ctx ? 0 : j - LC; (void)mrow; (void)t;
#define ROWS_END asm volatile("" ::: "memory"); }
        if (pn == 0 || pn == 1) {
            const float* gsrc = IN[pn == 0 ? 9 : 10] + l * 32 + 8 * fq;
            const float scale = pn == 0 ? 0.17677669529663687f * LOG2E : 1.f;
            bf16* dstb = (bf16*)(ws + (pn == 0 ? WS_QA : WS_KA));
            ROWS_BEGIN
                const float* tab = tabA + ((fq < 2) ? (t >> 6) : (t & 63)) * 16;
                float gn[8]; getv(ldg((const f32x4*)gsrc), ldg((const f32x4*)(gsrc + 4)), gn);
                a_head(v0, gn, !is_ctx, tab, fq, scale); a_head(v1, gn, !is_ctx, tab, fq, scale);
                { const int gi = wc, h = gi >> 1, c = gi & 1; st8g(dstb + (((b * 4 + h) * TK + j) * 64 + c * 32 + 8 * fq), v0); }
                { const int gi = 4 + wc, h = gi >> 1, c = gi & 1; st8g(dstb + (((b * 4 + h) * TK + j) * 64 + c * 32 + 8 * fq), v1); }
            ROWS_END
        } else if (pn == 2 || pn == 5 || pn == 8) {
            bf16* dstb = (bf16*)(ws + (pn == 2 ? WS_VAT : (pn == 5 ? WS_VBT : WS_VCT)));
            const int dv0 = (wc & 1) * 32 + 8 * fq;
            ROWS_BEGIN
                st8t(dstb + ((size_t)(b * 4 + (wc >> 1)) * 64 + dv0) * TK + j, v0);
                st8t(dstb + ((size_t)(b * 4 + 2 + (wc >> 1)) * 64 + dv0) * TK + j, v1);
            ROWS_END
        } else if (pn == 3 || pn == 4 || pn == 6) {
            bf16* dstb = (bf16*)(ws + (pn == 3 ? WS_QB : (pn == 4 ? WS_KB : WS_OB)));
            const int c0 = wc * 32 + 8 * fq;
            ROWS_BEGIN
                if (pn == 6) {
#pragma unroll
                    for (int e = 0; e < 8; ++e) { v0[e] = sigmoid_(v0[e]); v1[e] = sigmoid_(v1[e]); } }
                st8g(dstb + mrow * 256 + c0, v0); st8g(dstb + mrow * 256 + 128 + c0, v1);
            ROWS_END
        } else if (pn == 7) {
            bf16* dq = (bf16*)(ws + WS_QC); bf16* dk = (bf16*)(ws + WS_KC); const int c0 = wc * 32 + 8 * fq;
            ROWS_BEGIN
#pragma unroll
                for (int e = 0; e < 8; ++e) v0[e] *= 0.17677669529663687f;
                st8g(dq + mrow * 128 + c0, v0); st8g(dk + mrow * 128 + c0, v1);
            ROWS_END
        } else if (pn == 9) {
            bf16* dstb = (bf16*)(ws + WS_QD); const float* d_qn = IN[20] + l * 64;
            ROWS_BEGIN
                float g0[8], g1[8]; getv(ldg((const f32x4*)(d_qn + 8 * fq)), ldg((const f32x4*)(d_qn + 8 * fq + 4)), g0); getv(ldg((const f32x4*)(d_qn + 32 + 8 * fq)), ldg((const f32x4*)(d_qn + 36 + 8 * fq)), g1);
                d_head(v0, v1, g0, g1, !is_ctx, tabD + (t >> 6) * 32, tabD + (t & 63) * 32, fq, 0.125f * LOG2E);
                bf16* p = dstb + ((((b * 2 + (wc >> 1)) * 2 + (wc & 1)) * TK + j) * 64 + 8 * fq);
                st8g(p, v0); st8g(p + 32, v1);
            ROWS_END
        } else if (pn == 10) {
            if (wc < 2) {
                bf16* dstb = (bf16*)(ws + WS_KD); const float* d_kn = IN[21] + l * 64;
                ROWS_BEGIN
                    float g0[8], g1[8]; getv(ldg((const f32x4*)(d_kn + 8 * fq)), ldg((const f32x4*)(d_kn + 8 * fq + 4)), g0); getv(ldg((const f32x4*)(d_kn + 32 + 8 * fq)), ldg((const f32x4*)(d_kn + 36 + 8 * fq)), g1);
                    d_head(v0, v1, g0, g1, !is_ctx, tabD + (t >> 6) * 32, tabD + (t & 63) * 32, fq, 1.f);
                    bf16* p = dstb + (((b * 2 + wc) * TK + j) * 64 + 8 * fq);
                    st8g(p, v0); st8g(p + 32, v1);
                ROWS_END
            } else {
                bf16* dstb = (bf16*)(ws + WS_VDT);
                ROWS_BEGIN
                    bf16* p = dstb + ((size_t)(b * 2 + (wc - 2)) * 64 + 8 * fq) * TK + j;
                    st8t(p, v0); st8t(p + (size_t)32 * TK, v1);
                ROWS_END
            }
        } else if (pn < 15) {
            bf16* dstb = (bf16*)(ws + WS_GATE); const int c0 = (pn - 11) * 256 + wc * 32 + 8 * fq;
            ROWS_BEGIN
#pragma unroll
                for (int e = 0; e < 8; ++e) { v0[e] = silu_(v0[e]); v1[e] = silu_(v1[e]); }
                st8g(dstb + mrow * 1024 + c0, v0); st8g(dstb + mrow * 1024 + 128 + c0, v1);
            ROWS_END
        } else {
            float* dstb = (float*)(ws + WS_SMALL); const int p0 = wc * 32 + 8 * fq; const float* gate_b = IN[15] + l * 16;
            if (p0 < 48) {
                ROWS_BEGIN
                    if (p0 < 16) {
#pragma unroll
                        for (int e = 0; e < 8; ++e) { const int p = p0 + e, type = p >> 2; float x = v0[e] + ldg(gate_b + p); if (type & 1) x = logsigmoid_(x); v0[e] = x; } }
                    float* o = dstb + mrow * 48 + p0;
                    stg((f32x4*)o, (f32x4){v0[0], v0[1], v0[2], v0[3]}); stg((f32x4*)(o + 4), (f32x4){v0[4], v0[5], v0[6], v0[7]});
                ROWS_END
            }
        }
    }
};

struct EpiOut {
    static constexpr bool PERM = true, AFTER_DRAIN = false;
#ifdef PAD_GOUT
    static constexpr bool PADK = true;
#else
    static constexpr bool PADK = false;
#endif
    const float* xsrc; const float* csrc; float* xdst; float* cdst; const float* modv;
    DI void operator()(const pg8::f32x4 (&acc)[2][2][4][2], const pg8::Unit& u, int wr, int wc, int fr_, int fq_) const {
        int fr = fr_, fq = fq_; asm volatile("" : "+v"(fr), "+v"(fq));
        const int b = u.pm >= 33 ? 1 : 0, pmi = u.pm - 33 * b; const bool is_ctx = (pmi == 0);
        const int j00 = pmi * 256 + wr * 64 + fr, col0 = u.pn * 256 + wc * 32 + 8 * fq;
        const float* gt = modv + (is_ctx ? 2 : b) * 3072 + 2048 + col0;
        f32x4 g[2][2];
#pragma unroll
        for (int bj = 0; bj < 2; ++bj) { g[bj][0] = ldg((const f32x4*)(gt + bj * 128)); g[bj][1] = ldg((const f32x4*)(gt + bj * 128 + 4)); }
#pragma unroll
        for (int ai = 0; ai < 2; ++ai)
#pragma unroll
            for (int m = 0; m < 4; ++m) {
                const int j = j00 + ai * 128 + m * 16;
                const size_t off = (is_ctx ? (size_t)(b * LC + j) : (size_t)(b * T + j - LC)) * D + col0;
                const float* s = (is_ctx ? csrc : xsrc) + off; float* d = (is_ctx ? cdst : xdst) + off;
#pragma unroll
                for (int bj = 0; bj < 2; ++bj) {
                    const f32x4 r0 = ldg((const f32x4*)(s + bj * 128)), r1 = ldg((const f32x4*)(s + bj * 128 + 4));
                    stg((f32x4*)(d + bj * 128), (f32x4)(r0 + g[bj][0] * acc[ai][bj][m][0]));
                    stg((f32x4*)(d + bj * 128 + 4), (f32x4)(r1 + g[bj][1] * acc[ai][bj][m][1]));
                }
            }
    }
};
struct LatOrder {
    pg8::StaticOrder so;
    DI bool next(int i, pg8::Unit& u) const { if (!so.next(i, u)) return false; u.pm += 1 + (u.pm >= 32 ? 1 : 0); return true; }
    DI void a_ready(const pg8::Unit&) const {}
    DI void done(const pg8::Unit&) const {}
};

constexpr int KS_LD = 72, VS_LD = 68, KS_BYTES = 64 * KS_LD * 2, VS_BYTES = 64 * VS_LD * 2;
template <int MODE>
DI void attn_core(unsigned char* lds, const bf16* qrow, const bf16* Kb, const bf16* Vt, int n1, int js, int nt, int qpos, float negM,
                  f32x16 (&O)[MODE == 0 ? 2 : 1][2], float (&lsum)[MODE == 0 ? 2 : 1]) {
    constexpr int NC = MODE == 0 ? 2 : 1, KS = MODE == 0 ? 2 : 4;
    const int tid = otid(), lane = tid & 63, l32 = lane & 31, hi = lane >> 5;
    bf16* Ksm = (bf16*)lds; bf16* Vsm = (bf16*)(lds + 2 * KS_BYTES);
    bf16x8 qf[NC][KS];
#pragma unroll
    for (int c = 0; c < NC; ++c)
#pragma unroll
        for (int ks = 0; ks < KS; ++ks) qf[c][ks] = ldg((const bf16x8*)(qrow + c * (KS * 16) + 16 * ks + 8 * hi));
#pragma unroll
    for (int c = 0; c < NC; ++c) { lsum[c] = 0.f;
#pragma unroll
        for (int d = 0; d < 2; ++d)
#pragma unroll
            for (int i = 0; i < 16; ++i) O[c][d][i] = 0.f; }
    const int lr = tid >> 3, lc = (tid & 7) * 8;
    f32x16 L1;
#pragma unroll
    for (int i = 0; i < 16; ++i) L1[i] = 0.f;
    f32x16 L0;
#pragma unroll
    for (int i = 0; i < 16; ++i) L0[i] = 0.f;
    const bf16x8 ones = (bf16x8){0x3F80, 0x3F80, 0x3F80, 0x3F80, 0x3F80, 0x3F80, 0x3F80, 0x3F80};
    f32x16 CNEG;
#pragma unroll
    for (int i = 0; i < 16; ++i) CNEG[i] = negM;
    asm volatile("" : "+v"(CNEG));
    u32x4 kreg, vreg;
    { const int j0 = (0 < n1) ? 0 : js;
      kreg = ldg((const u32x4*)(Kb + (size_t)(j0 + lr) * 64 + lc)); vreg = ldg((const u32x4*)(Vt + (size_t)lr * TK + j0 + lc));
      *(u32x4*)(Ksm + lr * KS_LD + lc) = kreg; *(u32x2*)(Vsm + lr * VS_LD + lc) = (u32x2){vreg.x, vreg.y}; *(u32x2*)(Vsm + lr * VS_LD + lc + 4) = (u32x2){vreg.z, vreg.w}; }
    lbar();
#ifdef PAD_A
    asm volatile("s_nop 0");
#endif
    for (int it = 0; it < nt; ++it) {
        const int buf = it & 1; const int j0 = (it < n1) ? 64 * it : js + 64 * (it - n1);
        const bool more = (it + 1 < nt);
        if (more) { const int jn = (it + 1 < n1) ? 64 * (it + 1) : js + 64 * (it + 1 - n1);
            kreg = ldg((const u32x4*)(Kb + (size_t)(jn + lr) * 64 + lc)); vreg = ldg((const u32x4*)(Vt + (size_t)lr * TK + jn + lc)); }
        const bf16* Kc = Ksm + buf * (64 * KS_LD); const bf16* Vc = Vsm + buf * (64 * VS_LD);
        const bool masked = (MODE == 1) && (it >= n1);
#pragma unroll
        for (int kb = 0; kb < 2; ++kb) {
#ifdef PAD_KB
            if (kb == 1) asm volatile("s_nop 0");
#endif
            bf16x8 pf[NC][2];
#pragma unroll
            for (int c = 0; c < NC; ++c) {
                f32x16 S;
#pragma unroll
                for (int ks = 0; ks < KS; ++ks) { const bf16x8 a = *(const bf16x8*)(Kc + (32 * kb + l32) * KS_LD + c * (KS * 16) + 16 * ks + 8 * hi); S = MFMA32(a, qf[c][ks], ks == 0 ? CNEG : S); }
                float p[16];
#pragma unroll
                for (int i = 0; i < 16; ++i) p[i] = __builtin_amdgcn_exp2f(S[i]);
                if (MODE == 1) { if (masked) { const int kp0 = j0 - LC + 32 * kb + 4 * hi - qpos;
#pragma unroll
                    for (int i = 0; i < 16; ++i) { const int dlt = kp0 + (i & 3) + 8 * (i >> 2); p[i] = (dlt >= -128 && dlt <= 128) ? p[i] : 0.f; } } }
                if (c != 0) { float ps = 0.f;
#pragma unroll
                    for (int i = 8; i < 16; ++i) ps += p[i];
                    lsum[c] += ps; }
#pragma unroll
                for (int s = 0; s < 2; ++s) { u32x4 w; w.x = pk(p[8 * s], p[8 * s + 1]); w.y = pk(p[8 * s + 2], p[8 * s + 3]); w.z = pk(p[8 * s + 4], p[8 * s + 5]); w.w = pk(p[8 * s + 6], p[8 * s + 7]); pf[c][s] = __builtin_bit_cast(bf16x8, w); }
            }
#pragma unroll
            for (int dvb = 0; dvb < 2; ++dvb)
#pragma unroll
                for (int s = 0; s < 2; ++s) {
                    const bf16* vp = Vc + (32 * dvb + l32) * VS_LD + 32 * kb + 16 * s + 4 * hi;
                    const u32x2 lo = *(const u32x2*)vp, hh = *(const u32x2*)(vp + 8);
                    const bf16x8 va = __builtin_bit_cast(bf16x8, (u32x4){lo.x, lo.y, hh.x, hh.y});
#pragma unroll
                    for (int c = 0; c < NC; ++c) O[c][dvb] = MFMA32(va, pf[c][s], O[c][dvb]);
                    if (dvb == 0) L0 = MFMA32(ones, pf[0][s], L0);
                    if (dvb == 1 && s == 0 && NC == 2) L1 = MFMA32(ones, pf[NC - 1][0], L1);
                }
        }
        if (more) { bf16* Kn = Ksm + (buf ^ 1) * (64 * KS_LD); bf16* Vn = Vsm + (buf ^ 1) * (64 * VS_LD);
            *(u32x4*)(Kn + lr * KS_LD + lc) = kreg; *(u32x2*)(Vn + lr * VS_LD + lc) = (u32x2){vreg.x, vreg.y}; *(u32x2*)(Vn + lr * VS_LD + lc + 4) = (u32x2){vreg.z, vreg.w}; }
        lbar();
    }
#ifdef PAD_A
    asm volatile("s_nop 0");
#endif
    lsum[0] = 0.5f * L0[0];
    if (NC == 2) lsum[NC - 1] += 0.5f * L1[0];
}

DI void attnA_unit(unsigned char* lds, unsigned char* ws, int u, const float* subln, const float* misc) {
    const int tid = otid(), lane = tid & 63, wave = tid >> 6, l32 = lane & 31, hi = lane >> 5;
    int bh, jq0, nt;
    if (u < 256) { bh = u & 7; jq0 = LC + 256 * (u >> 3); nt = TK / 64; } else { bh = u - 256; jq0 = 0; nt = LC / 64; }
    const int b = bh >> 2, h = bh & 3, jq = jq0 + 32 * wave + l32;
    const bf16* qrow = (const bf16*)(ws + WS_QA) + ((size_t)bh * TK + jq) * 64;
    const bf16* Kb = (const bf16*)(ws + WS_KA) + (size_t)bh * TK * 64;
    const bf16* Vt = (const bf16*)(ws + WS_VAT) + (size_t)bh * 64 * TK;
    f32x16 O[2][2]; float lsum[2];
    attn_core<0>(lds, qrow, Kb, Vt, nt, 0, nt, 0, -misc[2], O, lsum);
    const float lam = misc[0], lam_init = misc[1];
    const float l0 = lsum[0] + __shfl_xor(lsum[0], 32), l1 = lsum[1] + __shfl_xor(lsum[1], 32);
    const float i0 = 1.f / l0, i1 = lam / l1;
    float ss = 0.f;
#pragma unroll
    for (int d = 0; d < 2; ++d)
#pragma unroll
        for (int i = 0; i < 16; ++i) { const float a = O[0][d][i] * i0 - O[1][d][i] * i1; O[0][d][i] = a; ss += a * a; }
    ss += __shfl_xor(ss, 32);
    const float rinv = rsqrtf(ss * (1.f / 64.f) + EPS) * (1.f - lam_init);
    const size_t mrow = (size_t)b * TK + jq;
    const bf16* gate = (const bf16*)(ws + WS_GATE) + mrow * 1024 + h * 64;
    bf16* y = (bf16*)(ws + WS_HXY) + mrow * 1024 + h * 64;
#pragma unroll
    for (int d = 0; d < 2; ++d)
#pragma unroll
        for (int g = 0; g < 4; ++g) {
            const int dv = 32 * d + 8 * g + 4 * hi;
            const u32x2 gg = ldg((const u32x2*)(gate + dv)); const f32x4 sb = ldg((const f32x4*)(subln + dv));
            u32x2 o; o.x = pk(O[0][d][4 * g] * rinv * sb[0] * bfe2(gg, 0), O[0][d][4 * g + 1] * rinv * sb[1] * bfe2(gg, 1));
            o.y = pk(O[0][d][4 * g + 2] * rinv * sb[2] * bfe2(gg, 2), O[0][d][4 * g + 3] * rinv * sb[3] * bfe2(gg, 3));
            stg((u32x2*)(y + dv), o);
        }
}

DI void attnD_unit(unsigned char* lds, unsigned char* ws, int u, const float* sink, const float* misc) {
    const int tid = otid(), lane = tid & 63, wave = tid >> 6, l32 = lane & 31, hi = lane >> 5;
    int b, kv, jq0, n1 = LC / 64, js = 0, nt = LC / 64, qpos = 0;
    if (u < 256) { const int x = u & 7; b = x >> 2; kv = (x >> 1) & 1; const int qblk = (x & 1) * 32 + (u >> 3), q0 = qblk * 128;
        jq0 = LC + q0; const int p0 = q0 - 128 < 0 ? 0 : q0 - 128, p1 = q0 + 256 > T ? T : q0 + 256; js = LC + p0; nt = n1 + (p1 - p0) / 64; qpos = q0 + 32 * (wave & 3) + l32; }
    else { const int x = u - 256; b = x >> 2; kv = (x >> 1) & 1; jq0 = 128 * (x & 1); }
    const int g = wave >> 2, jq = jq0 + 32 * (wave & 3) + l32;
    const bf16* qrow = (const bf16*)(ws + WS_QD) + ((size_t)((b * 2 + kv) * 2 + g) * TK + jq) * 64;
    const bf16* Kb = (const bf16*)(ws + WS_KD) + (size_t)(b * 2 + kv) * TK * 64;
    const bf16* Vt = (const bf16*)(ws + WS_VDT) + (size_t)(b * 2 + kv) * 64 * TK;
    f32x16 O[1][2]; float lsum[1];
    attn_core<1>(lds, qrow, Kb, Vt, n1, js, nt, qpos, -misc[3], O, lsum);
    const float l = lsum[0] + __shfl_xor(lsum[0], 32) + __builtin_amdgcn_exp2f(sink[kv * 2 + g] * LOG2E - misc[3]);
    const float inv = 1.f / l;
    const size_t mrow = (size_t)b * TK + jq; const int hc = 768 + (kv * 2 + g) * 64;
    const bf16* gate = (const bf16*)(ws + WS_GATE) + mrow * 1024 + hc;
    bf16* y = (bf16*)(ws + WS_HXY) + mrow * 1024 + hc;
#pragma unroll
    for (int d = 0; d < 2; ++d)
#pragma unroll
        for (int gq = 0; gq < 4; ++gq) {
            const int dv = 32 * d + 8 * gq + 4 * hi;
            const u32x2 gg = ldg((const u32x2*)(gate + dv));
            u32x2 o; o.x = pk(O[0][d][4 * gq] * inv * bfe2(gg, 0), O[0][d][4 * gq + 1] * inv * bfe2(gg, 1));
            o.y = pk(O[0][d][4 * gq + 2] * inv * bfe2(gg, 2), O[0][d][4 * gq + 3] * inv * bfe2(gg, 3));
            stg((u32x2*)(y + dv), o);
        }
}

DI int ord_cidx(int dir, int step) { return dir == 0 ? step : (step < 4 ? 3 - step : 135 - step); }
constexpr int LD64 = 72, LD32 = 40, HLD = 68;
constexpr int WC_OFF = 110592, WC_CW = 0, WC_CB = 1536, WC_BON = 2048, WC_CON = 2112, WC_WG = 2176, WC_BG = 6272, WC_N = 6528;
DI void fill_wcache(unsigned char* lds, const float* const* IN, int l) {
    float* WC = (float*)(lds + WC_OFF); const int tid = otid();
    const float* cw = IN[13] + l * 1536; const float* cb = IN[14] + l * 512; const float* bo = IN[16] + l * 64; const float* co = IN[19] + l * 64; const float* wg = IN[17] + l * 4096; const float* bg = IN[18] + l * 256;
    const f32x4 w0 = ldg((const f32x4*)wg + tid), w1 = ldg((const f32x4*)wg + 512 + tid);
    f32x4 c0 = (f32x4){0.f, 0.f, 0.f, 0.f}, c1 = c0;
    if (tid < 384) c0 = ldg((const f32x4*)cw + tid);
    const float* src = cb; int dsto = 0;
    if (tid < 128) { src = cb + 4 * tid; dsto = WC_CB + 4 * tid; }
    else if (tid < 144) { src = bo + 4 * (tid - 128); dsto = WC_BON + 4 * (tid - 128); }
    else if (tid < 160) { src = co + 4 * (tid - 144); dsto = WC_CON + 4 * (tid - 144); }
    else if (tid < 224) { src = bg + 4 * (tid - 160); dsto = WC_BG + 4 * (tid - 160); }
    if (tid < 224) c1 = ldg((const f32x4*)src);
    *(f32x4*)(WC + WC_WG + 4 * tid) = w0; *(f32x4*)(WC + WC_WG + 2048 + 4 * tid) = w1;
    if (tid < 384) *(f32x4*)(WC + WC_CW + 4 * tid) = c0;
    if (tid < 224) *(f32x4*)(WC + dsto) = c1;
    lbar();
}

struct ScanPtrs { float *CST, *NST, *SB, *SG, *SM, *SST, *GD; };
DI ScanPtrs scan_ptrs(unsigned char* ws) { ScanPtrs p; p.CST = (float*)(ws + WS_CST); p.NST = (float*)(ws + WS_NST); p.SB = (float*)(ws + WS_SSC); p.SG = p.SB + 16 * NCH; p.SM = p.SG + 16 * NCH;
    p.SST = (float*)(ws + WS_SST); p.GD = (float*)(ws + WS_GD); return p; }


template <int CTRL> DI float dpp_f(float oldv, float v) { return __int_as_float(__builtin_amdgcn_update_dpp(__float_as_int(oldv), __float_as_int(v), CTRL, 0xf, 0xf, false)); }
DI float rdl(float v, int l) { return __int_as_float(__builtin_amdgcn_readlane(__float_as_int(v), l)); }
DI float wscan_add(float v, int lane, bool rev) {
    const int r = lane >> 4;
    if (!rev) { v += dpp_f<0x111>(0.f, v); v += dpp_f<0x112>(0.f, v); v += dpp_f<0x114>(0.f, v); v += dpp_f<0x118>(0.f, v);
        const float t0 = rdl(v, 15), t1 = rdl(v, 31), t2 = rdl(v, 47);
        v += (r == 1 ? t0 : (r == 2 ? t0 + t1 : (r == 3 ? t0 + t1 + t2 : 0.f))); }
    else { v += dpp_f<0x101>(0.f, v); v += dpp_f<0x102>(0.f, v); v += dpp_f<0x104>(0.f, v); v += dpp_f<0x108>(0.f, v);
        const float t1 = rdl(v, 16), t2 = rdl(v, 32), t3 = rdl(v, 48);
        v += (r == 2 ? t3 : (r == 1 ? t2 + t3 : (r == 0 ? t1 + t2 + t3 : 0.f))); }
    return v; }
DI float wscan_max(float v, int lane, bool rev) {
    const int r = lane >> 4; const float NI = -INFINITY;
    if (!rev) { v = fmaxf(v, dpp_f<0x111>(NI, v)); v = fmaxf(v, dpp_f<0x112>(NI, v)); v = fmaxf(v, dpp_f<0x114>(NI, v)); v = fmaxf(v, dpp_f<0x118>(NI, v));
        const float t0 = rdl(v, 15), t1 = rdl(v, 31), t2 = rdl(v, 47);
        v = fmaxf(v, (r == 1 ? t0 : (r == 2 ? fmaxf(t0, t1) : (r == 3 ? fmaxf(fmaxf(t0, t1), t2) : NI)))); }
    else { v = fmaxf(v, dpp_f<0x101>(NI, v)); v = fmaxf(v, dpp_f<0x102>(NI, v)); v = fmaxf(v, dpp_f<0x104>(NI, v)); v = fmaxf(v, dpp_f<0x108>(NI, v));
        const float t1 = rdl(v, 16), t2 = rdl(v, 32), t3 = rdl(v, 48);
        v = fmaxf(v, (r == 2 ? t3 : (r == 1 ? fmaxf(t2, t3) : (r == 0 ? fmaxf(fmaxf(t1, t2), t3) : NI)))); }
    return v; }
DI float wave_max(float v) {
#pragma unroll
    for (int o = 1; o < 64; o <<= 1) v = fmaxf(v, __shfl_xor(v, o));
    return v; }

DI void conv8r(const u32x4& pv, const u32x4& c, const u32x4& nv, const float* w  , const float* cb, float mul, float* o) {
    float w0[8], w1[8], w2[8], bb[8];
    getv(*(const f32x4*)w, *(const f32x4*)(w + 4), w0); getv(*(const f32x4*)(w + 512), *(const f32x4*)(w + 516), w1);
    getv(*(const f32x4*)(w + 1024), *(const f32x4*)(w + 1028), w2); getv(*(const f32x4*)cb, *(const f32x4*)(cb + 4), bb);
#pragma unroll
    for (int e = 0; e < 8; ++e) { const float y = w0[e] * bfe(pv, e) + w1[e] * bfe(c, e) + w2[e] * bfe(nv, e) + bb[e]; o[e] = silu_(y) * mul; }
}
DI void load3(const bf16* p, bool hasp, bool hasn, u32x4& pv, u32x4& c, u32x4& nv) {
    c = ldg((const u32x4*)p); pv = (u32x4){0u, 0u, 0u, 0u}; nv = pv;
    if (hasp) pv = ldg((const u32x4*)(p - 256));
    if (hasn) nv = ldg((const u32x4*)(p + 256));
}

struct MaPre { float lf, li; u32x4 kp, kc, kn, vraw; };
DI MaPre mlstm_a_load(unsigned char* ws, int tsk) {
    const int bh = tsk / NCH, cidx = tsk - bh * NCH, b = bh >> 2, h = bh & 3, tid = otid();
    const size_t m0 = (size_t)b * TK + cidx * 64; MaPre p; p.lf = 0.f; p.li = 0.f;
    if (tid < 128) { const int dir = tid >> 6, s = tid & 63; const float* sm = (const float*)(ws + WS_SMALL) + (m0 + s) * 48; p.lf = ldg(sm + (2 * dir + 1) * 4 + h); p.li = ldg(sm + (2 * dir) * 4 + h); }
    const int s = tid >> 3, d0 = (tid & 7) * 8;
    const bool hasp = (s > 0) || (cidx != 0 && cidx != 4), hasn = (s < 63) || (cidx != 3 && cidx != NCH - 1);
    load3((const bf16*)(ws + WS_KB) + (m0 + s) * 256 + h * 64 + d0, hasp, hasn, p.kp, p.kc, p.kn);
    p.vraw = ldg((const u32x4*)((const bf16*)(ws + WS_VBT) + ((size_t)bh * 64 + s) * TK + cidx * 64 + d0));
    return p;
}
DI void mlstm_a_run(unsigned char* lds, unsigned char* ws, int tsk, const MaPre& p, const float* conv_w, const float* conv_b) {
    const int bh = tsk / NCH, cidx = tsk - bh * NCH, h = bh & 3;
    const int tid = otid(), lane = tid & 63, wave = tid >> 6; const ScanPtrs sp = scan_ptrs(ws);
    bf16* KT = (bf16*)lds; bf16* VW = (bf16*)(lds + 9216); float* WE = (float*)(lds + 27648);
    if (wave < 2) { const int dir = wave; const float tot = wave_sum(p.lf), pre = wscan_add(p.lf, lane, false);
        const float g = (dir == 0 ? tot - pre : pre - p.lf) + p.li; const float G = wave_max(g);
        WE[dir * 64 + lane] = expf(g - G);
        if (lane == 0) { stg(sp.SB + (bh * 2 + dir) * NCH + cidx, tot); stg(sp.SG + (bh * 2 + dir) * NCH + cidx, G); } }
    { const int s = tid >> 3, d0 = (tid & 7) * 8; float kv[8];
      conv8r(p.kp, p.kc, p.kn, conv_w + 256 + h * 64 + d0, conv_b + 256 + h * 64 + d0, 0.125f, kv);
#pragma unroll
      for (int e = 0; e < 8; ++e) KT[(d0 + e) * LD64 + s] = f2b(kv[e]); }
    lbar();
    { const int v = tid >> 3, s0 = (tid & 7) * 8;
#pragma unroll
      for (int dir = 0; dir < 2; ++dir) { float o[8];
#pragma unroll
          for (int e = 0; e < 8; ++e) o[e] = bfe(p.vraw, e) * WE[dir * 64 + s0 + e];
          st8(VW + dir * (64 * LD64) + v * LD64 + s0, o); } }
    { const int o = tid >> 2, part = tid & 3, dir = o >> 6, d = o & 63; float a = 0.f;
#pragma unroll
      for (int q = 0; q < 16; ++q) { const int s = part * 16 + q; a += WE[dir * 64 + s] * b2f(KT[d * LD64 + s]); }
      a += __shfl_xor(a, 1); a += __shfl_xor(a, 2);
      if (part == 0) stg(sp.NST + ((size_t)(bh * 2 + dir) * NCH + cidx) * 64 + d, a); }
    lbar();
    { const int dir = wave >> 2, tr = (wave >> 1) & 1, tc = wave & 1, l32 = lane & 31, hi = lane >> 5;
      f32x16 acc;
#pragma unroll
      for (int i = 0; i < 16; ++i) acc[i] = 0.f;
#pragma unroll
      for (int ks = 0; ks < 4; ++ks) acc = MFMA32(ldfrag(VW + dir * (64 * LD64), LD64, 32 * tr, 16 * ks, lane), ldfrag(KT, LD64, 32 * tc, 16 * ks, lane), acc);
      float* dst = sp.CST + ((size_t)(bh * 2 + dir) * NCH + cidx) * 4096;
#pragma unroll
      for (int i = 0; i < 16; ++i) stg(dst + (32 * tr + crow(i, hi)) * 64 + 32 * tc + l32, acc[i]); }
    lbar();
}

struct GlPre { f32x4 lr[4]; u32x4 kraw, qraw, vraw; };
DI GlPre gla_load(unsigned char* ws, int tsk, bool need_q) {
    const int bh = tsk / NCH, cidx = tsk - bh * NCH, b = bh >> 2, h = bh & 3, tid = otid(), lane = tid & 63, wave = tid >> 6, z = wave >> 2, dg = wave & 3;
    const size_t m0 = (size_t)b * TK + cidx * 64; GlPre p;
    const float* sm = (const float*)(ws + WS_SMALL) + (m0 + lane) * 48 + 16 + z * 16;
#pragma unroll
    for (int q = 0; q < 4; ++q) p.lr[q] = ldg((const f32x4*)(sm + 4 * q));
    p.kraw = ldg((const u32x4*)((const bf16*)(ws + WS_KC) + (m0 + lane) * 128 + h * 32 + dg * 8));
    p.qraw = (u32x4){0u, 0u, 0u, 0u}; if (need_q) p.qraw = ldg((const u32x4*)((const bf16*)(ws + WS_QC) + (m0 + lane) * 128 + h * 32 + dg * 8));
    p.vraw = ldg((const u32x4*)((const bf16*)(ws + WS_VCT) + ((size_t)bh * 64 + (tid >> 3)) * TK + cidx * 64 + (tid & 7) * 8));
    return p;
}
DI void gla_bc(const GlPre& p, int h, int z, int dg, int lane, const float* wg, const float* bg, float* bc) {
    const float* wgp = wg + (z * 16) * 128 + h * 32 + dg * 8;
#pragma unroll
    for (int e = 0; e < 8; ++e) bc[e] = bg[z * 128 + h * 32 + dg * 8 + e];
#pragma unroll
    for (int r = 0; r < 16; ++r) { const float lr = p.lr[r >> 2][r & 3];
#pragma unroll
        for (int e = 0; e < 8; ++e) bc[e] += lr * wgp[r * 128 + e]; }
#pragma unroll
    for (int e = 0; e < 8; ++e) bc[e] = wscan_add((fminf(bc[e], 0.f) - __logf(1.f + __expf(-fabsf(bc[e])))) * (1.f / 16.f), lane, z == 1);
}
DI void gla_a_run(unsigned char* lds, unsigned char* ws, int tsk, const GlPre& p, const float* wg, const float* bg) {
    const int bh = tsk / NCH, cidx = tsk - bh * NCH, h = bh & 3;
    const int tid = otid(), lane = tid & 63, wave = __builtin_amdgcn_readfirstlane(tid >> 6), z = wave >> 2, dg = wave & 3; const ScanPtrs sp = scan_ptrs(ws);
    bf16* KH = (bf16*)lds; bf16* VT = (bf16*)(lds + 9216);
    float bc[8]; gla_bc(p, h, z, dg, lane, wg, bg, bc);
#pragma unroll
    for (int e = 0; e < 8; ++e) { const float bend = __shfl(bc[e], z == 0 ? 63 : 0);
        KH[z * (32 * LD64) + (dg * 8 + e) * LD64 + lane] = f2b(bfe(p.kraw, e) * expf(bend - bc[e]));
        if (lane == 0) stg(sp.GD + ((size_t)(bh * 2 + z) * NCH + cidx) * 32 + dg * 8 + e, expf(bend)); }
    *(u32x4*)(VT + (tid >> 3) * LD64 + (tid & 7) * 8) = p.vraw;
    lbar();
    if (wave < 4) { const int zz = wave >> 1, vc = wave & 1, l32 = lane & 31, hi = lane >> 5;
      f32x16 acc;
#pragma unroll
      for (int i = 0; i < 16; ++i) acc[i] = 0.f;
#pragma unroll
      for (int ks = 0; ks < 4; ++ks) acc = MFMA32(ldfrag(KH + zz * (32 * LD64), LD64, 0, 16 * ks, lane), ldfrag(VT, LD64, 32 * vc, 16 * ks, lane), acc);
      float* dst = sp.SST + ((size_t)(bh * 2 + zz) * NCH + cidx) * 2048;
#pragma unroll
      for (int i = 0; i < 16; ++i) stg(dst + crow(i, hi) * 64 + 32 * vc + l32, acc[i]); }
    lbar();
}
DI void scan_b(unsigned char* lds, unsigned char* ws, int t) {
    const int tid = otid(); const ScanPtrs sp = scan_ptrs(ws);
    float* DEC = (float*)lds; float* SCL = DEC + 256; float* XA = SCL + 256; float* XB = XA + 256; float* GS = XB + 256; float* BS = GS + 256; float* GDs = (float*)lds;
    if (t < 144) {
        const int scan = t < 128 ? (t >> 3) : (t - 128), dir = scan & 1;
        float bv = 0.f, gv = 0.f;
        if (tid < 132) { const int cidx = ord_cidx(dir, tid); bv = ldg(sp.SB + scan * NCH + cidx); gv = ldg(sp.SG + scan * NCH + cidx); }
        if (tid < 256) { XA[tid] = bv; BS[tid] = bv; GS[tid] = gv; }
        lbar();
        for (int off = 1; off < 256; off <<= 1) { float v = 0.f; if (tid < 256 && tid >= off) v = XA[tid - off]; lbar(); if (tid < 256) XA[tid] += v; lbar(); }
        if (tid < 256) XB[tid] = tid < 132 ? GS[tid] - XA[tid] : -INFINITY;
        lbar();
        for (int off = 1; off < 256; off <<= 1) { float v = -INFINITY; if (tid < 256 && tid >= off) v = XB[tid - off]; lbar(); if (tid < 256) XB[tid] = fmaxf(XB[tid], v); lbar(); }
        if (tid < 132) {
            const float m0 = tid == 0 ? 0.f : XA[tid - 1] + fmaxf(0.f, XB[tid - 1]);
            const float m1 = XA[tid] + fmaxf(0.f, XB[tid]);
            DEC[tid] = expf(BS[tid] + m0 - m1); SCL[tid] = expf(GS[tid] - m1);
            if (t >= 128) stg(sp.SM + scan * NCH + ord_cidx(dir, tid), m0);
        }
        lbar();
        if (t < 128 || tid < 64) {
            const int stride = t < 128 ? 4096 : 64;
            float* buf = (t < 128 ? sp.CST + (size_t)scan * NCH * 4096 + (t & 7) * 512 : sp.NST + (size_t)scan * NCH * 64) + tid;
            float run = 0.f;
            for (int s0 = 0; s0 < 132; s0 += 33) { float dl[33];
#pragma unroll
                for (int u = 0; u < 33; ++u) dl[u] = ldg(buf + (size_t)ord_cidx(dir, s0 + u) * stride);
#pragma unroll
                for (int u = 0; u < 33; ++u) { stg(buf + (size_t)ord_cidx(dir, s0 + u) * stride, run); run = DEC[s0 + u] * run + SCL[s0 + u] * dl[u]; } }
        }
        lbar();
    } else {
        const int scan = (t - 144) >> 2, dir = scan & 1, elem = ((t - 144) & 3) * 512 + tid, d = elem >> 6;
        for (int idx = tid; idx < 132 * 32; idx += 512) GDs[idx] = ldg(sp.GD + ((size_t)scan * NCH + ord_cidx(dir, idx >> 5)) * 32 + (idx & 31));
        lbar();
        float* buf = sp.SST + (size_t)scan * NCH * 2048 + elem; float run = 0.f;
        for (int s0 = 0; s0 < 132; s0 += 33) { float dl[33];
#pragma unroll
            for (int u = 0; u < 33; ++u) dl[u] = ldg(buf + (size_t)ord_cidx(dir, s0 + u) * 2048);
#pragma unroll
            for (int u = 0; u < 33; ++u) { stg(buf + (size_t)ord_cidx(dir, s0 + u) * 2048, run); run = GDs[(s0 + u) * 32 + d] * run + dl[u]; } }
        lbar();
    }
}

DI void chunk_finish(const float* H, unsigned char* ws, size_t m0, int colbase, int h, const float* outn, bool use_o, const u32x4& gg, const u32x4& og) {
    const int tid = otid(), t = tid >> 3, v8 = (tid & 7) * 8;
    float hs[8]; float ss = 0.f;
#pragma unroll
    for (int e = 0; e < 8; ++e) { hs[e] = H[t * HLD + v8 + e] + H[64 * HLD + t * HLD + v8 + e]; ss += hs[e] * hs[e]; }
    ss += __shfl_xor(ss, 1); ss += __shfl_xor(ss, 2); ss += __shfl_xor(ss, 4);
    const float rinv = rsqrtf(ss * (1.f / 64.f) + EPS);
    const size_t mrow = m0 + t;
    float o[8];
#pragma unroll
    for (int e = 0; e < 8; ++e) { float x = hs[e] * rinv * outn[v8 + e] * bfe(gg, e); if (use_o) x *= bfe(og, e); o[e] = x; }
    st8g((bf16*)(ws + WS_HXY) + mrow * 1024 + colbase + h * 64 + v8, o);
}

struct McPre { float lf, li, nl, mp; u32x4 qp, qc, qn, kp, kc, kn, vraw, gg, og; f32x4 c[2][2]; };
DI McPre mlstm_c_load(unsigned char* ws, int tsk) {
    const int bh = tsk / NCH, cidx = tsk - bh * NCH, b = bh >> 2, h = bh & 3, tid = otid();
    const size_t m0 = (size_t)b * TK + cidx * 64; const ScanPtrs sp = scan_ptrs(ws); McPre p; p.lf = 0.f; p.li = 0.f; p.nl = 0.f; p.mp = 0.f;
    if (tid < 128) { const int dir = tid >> 6, s = tid & 63; const float* sm = (const float*)(ws + WS_SMALL) + (m0 + s) * 48; p.lf = ldg(sm + (2 * dir + 1) * 4 + h); p.li = ldg(sm + (2 * dir) * 4 + h);
        p.nl = ldg(sp.NST + ((size_t)(bh * 2 + dir) * NCH + cidx) * 64 + s); p.mp = ldg(sp.SM + (bh * 2 + dir) * NCH + cidx); }
    const int s = tid >> 3, d0 = (tid & 7) * 8;
    const bool hasp = (s > 0) || (cidx != 0 && cidx != 4), hasn = (s < 63) || (cidx != 3 && cidx != NCH - 1);
    load3((const bf16*)(ws + WS_QB) + (m0 + s) * 256 + h * 64 + d0, hasp, hasn, p.qp, p.qc, p.qn);
    load3((const bf16*)(ws + WS_KB) + (m0 + s) * 256 + h * 64 + d0, hasp, hasn, p.kp, p.kc, p.kn);
    p.vraw = ldg((const u32x4*)((const bf16*)(ws + WS_VBT) + ((size_t)bh * 64 + s) * TK + cidx * 64 + d0));
#pragma unroll
    for (int dir = 0; dir < 2; ++dir) { const float* src = sp.CST + ((size_t)(bh * 2 + dir) * NCH + cidx) * 4096 + s * 64 + d0; p.c[dir][0] = ldg((const f32x4*)src); p.c[dir][1] = ldg((const f32x4*)(src + 4)); }
    p.gg = ldg((const u32x4*)((const bf16*)(ws + WS_GATE) + (m0 + s) * 1024 + 256 + h * 64 + d0));
    p.og = ldg((const u32x4*)((const bf16*)(ws + WS_OB) + (m0 + s) * 256 + h * 64 + d0));
    return p;
}
DI void mlstm_c_run(unsigned char* lds, unsigned char* ws, int tsk, const McPre& p, const float* conv_w, const float* conv_b, const float* outn) {
    const int bh = tsk / NCH, cidx = tsk - bh * NCH, b = bh >> 2, h = bh & 3;
    const int tid = otid(), lane = tid & 63, wave = tid >> 6, l32 = lane & 31, hi = lane >> 5;
    const size_t m0 = (size_t)b * TK + cidx * 64;
    bf16* QS = (bf16*)lds; bf16* KSm = (bf16*)(lds + 9216); bf16* VT = (bf16*)(lds + 18432); bf16* CB = (bf16*)(lds + 27648); bf16* PL = (bf16*)(lds + 46080);
    float* H = (float*)(lds + 64512); float* AA = (float*)(lds + 99328); float* MU = AA + 128; float* GI = MU + 128; float* EN = GI + 128;
    float* NQ = EN + 128; float* RS = NQ + 128; float* NL = RS + 256;
    if (wave < 2) { const int dir = wave; const bool rev = dir == 1;
        const float bcum = wscan_add(p.lf, lane, rev), a = p.li - bcum, cm = wscan_max(a, lane, rev), mu = fmaxf(p.mp, cm);
        AA[dir * 64 + lane] = a; MU[dir * 64 + lane] = mu; GI[dir * 64 + lane] = expf(p.mp - mu); EN[dir * 64 + lane] = expf(-bcum - mu); NL[dir * 64 + lane] = p.nl; }
    { const int s = tid >> 3, d0 = (tid & 7) * 8; float qv[8], kv[8];
      conv8r(p.qp, p.qc, p.qn, conv_w + h * 64 + d0, conv_b + h * 64 + d0, 1.f, qv);
      conv8r(p.kp, p.kc, p.kn, conv_w + 256 + h * 64 + d0, conv_b + 256 + h * 64 + d0, 0.125f, kv);
      st8(QS + s * LD64 + d0, qv); st8(KSm + s * LD64 + d0, kv);
      *(u32x4*)(VT + s * LD64 + d0) = p.vraw;
#pragma unroll
      for (int dir = 0; dir < 2; ++dir) { float cv[8]; getv(p.c[dir][0], p.c[dir][1], cv); st8(CB + dir * (64 * LD64) + s * LD64 + d0, cv); } }
    lbar();
    { const int o = tid >> 2, part = tid & 3, dir = o >> 6, t = o & 63; float a = 0.f;
#pragma unroll
      for (int q = 0; q < 16; ++q) { const int d = part * 16 + q; a += NL[dir * 64 + d] * b2f(QS[t * LD64 + d]); }
      a += __shfl_xor(a, 1); a += __shfl_xor(a, 2);
      if (part == 0) NQ[dir * 64 + t] = a; }
    { const int dir = wave >> 2, tr = (wave >> 1) & 1, tc = wave & 1;
      f32x16 S;
#pragma unroll
      for (int i = 0; i < 16; ++i) S[i] = 0.f;
#pragma unroll
      for (int ks = 0; ks < 4; ++ks) S = MFMA32(ldfrag(KSm, LD64, 32 * tr, 16 * ks, lane), ldfrag(QS, LD64, 32 * tc, 16 * ks, lane), S);
      const int t = 32 * tc + l32; const float mu = MU[dir * 64 + t]; float rs = 0.f;
#pragma unroll
      for (int g = 0; g < 4; ++g) { float pw[4];
#pragma unroll
          for (int e = 0; e < 4; ++e) { const int s = 32 * tr + 8 * g + 4 * hi + e; const bool ok = dir == 0 ? (s <= t) : (s >= t);
              pw[e] = ok ? S[4 * g + e] * __expf(AA[dir * 64 + s] - mu) : 0.f; rs += pw[e]; }
          *(u32x2*)(PL + dir * (64 * LD64) + t * LD64 + 32 * tr + 8 * g + 4 * hi) = (u32x2){pk(pw[0], pw[1]), pk(pw[2], pw[3])}; }
      rs += __shfl_xor(rs, 32);
      if (hi == 0) RS[(dir * 2 + tr) * 64 + t] = rs; }
    lbar();
    { const int dir = wave >> 2, vr = (wave >> 1) & 1, tc = wave & 1;
      f32x16 aP, aC;
#pragma unroll
      for (int i = 0; i < 16; ++i) { aP[i] = 0.f; aC[i] = 0.f; }
#pragma unroll
      for (int ks = 0; ks < 4; ++ks) { aP = MFMA32(ldfrag(VT, LD64, 32 * vr, 16 * ks, lane), ldfrag(PL + dir * (64 * LD64), LD64, 32 * tc, 16 * ks, lane), aP);
          aC = MFMA32(ldfrag(CB + dir * (64 * LD64), LD64, 32 * vr, 16 * ks, lane), ldfrag(QS, LD64, 32 * tc, 16 * ks, lane), aC); }
      const int t = 32 * tc + l32; const float gi = GI[dir * 64 + t];
      const float nq = RS[(dir * 2) * 64 + t] + RS[(dir * 2 + 1) * 64 + t] + gi * NQ[dir * 64 + t];
      const float inv = 1.f / fmaxf(fabsf(nq), EN[dir * 64 + t]);
#pragma unroll
      for (int i = 0; i < 16; ++i) H[dir * (64 * HLD) + t * HLD + 32 * vr + crow(i, hi)] = (aP[i] + gi * aC[i]) * inv; }
    lbar();
    chunk_finish(H, ws, m0, 256, h, outn, true, p.gg, p.og);
    lbar();
}

struct GcPre { GlPre g; u32x4 gg; float st[2][4]; };
DI GcPre gla_c_load(unsigned char* ws, int tsk) {
    const int bh = tsk / NCH, cidx = tsk - bh * NCH, b = bh >> 2, h = bh & 3, tid = otid(); const ScanPtrs sp = scan_ptrs(ws);
    const size_t m0 = (size_t)b * TK + cidx * 64; GcPre p; p.g = gla_load(ws, tsk, true);
    p.gg = ldg((const u32x4*)((const bf16*)(ws + WS_GATE) + (m0 + (tid >> 3)) * 1024 + 512 + h * 64 + (tid & 7) * 8));
#pragma unroll
    for (int z = 0; z < 2; ++z) { const float* src = sp.SST + ((size_t)(bh * 2 + z) * NCH + cidx) * 2048;
#pragma unroll
        for (int it = 0; it < 4; ++it) p.st[z][it] = ldg(src + tid + 512 * it); }
    return p;
}
DI void gla_c_run(unsigned char* lds, unsigned char* ws, int tsk, const GcPre& p, const float* wg, const float* bg, const float* outn) {
    const int bh = tsk / NCH, cidx = tsk - bh * NCH, b = bh >> 2, h = bh & 3;
    const int tid = otid(), lane = tid & 63, wave = tid >> 6, l32 = lane & 31, hi = lane >> 5;
    const size_t m0 = (size_t)b * TK + cidx * 64;
    bf16* QT = (bf16*)lds; bf16* KT2 = (bf16*)(lds + 10240); bf16* QH = (bf16*)(lds + 20480); bf16* VT = (bf16*)(lds + 30720);
    bf16* ST = (bf16*)(lds + 39936); bf16* PL = (bf16*)(lds + 50176); float* H = (float*)(lds + 68608);
    { const int wu = __builtin_amdgcn_readfirstlane(wave), z = wu >> 2, dg = wu & 3; float bc[8]; gla_bc(p.g, h, z, dg, lane, wg, bg, bc);
      float q1[8], k1[8], q2[8];
#pragma unroll
      for (int e = 0; e < 8; ++e) { const float rf = __shfl(bc[e], 32); const float qv = bfe(p.g.qraw, e);
          q1[e] = qv * __expf(bc[e] - rf); k1[e] = bfe(p.g.kraw, e) * __expf(rf - bc[e]); q2[e] = qv * __expf(bc[e]); }
      st8(QT + z * (64 * LD32) + lane * LD32 + dg * 8, q1); st8(KT2 + z * (64 * LD32) + lane * LD32 + dg * 8, k1); st8(QH + z * (64 * LD32) + lane * LD32 + dg * 8, q2); }
    *(u32x4*)(VT + (tid >> 3) * LD64 + (tid & 7) * 8) = p.g.vraw;
#pragma unroll
    for (int z = 0; z < 2; ++z)
#pragma unroll
        for (int it = 0; it < 4; ++it) { const int idx = tid + 512 * it, d = idx >> 6, v = idx & 63; ST[z * (64 * LD32) + v * LD32 + d] = f2b(p.st[z][it]); }
    lbar();
    { const int z = wave >> 2, tr = (wave >> 1) & 1, tc = wave & 1;
      f32x16 S;
#pragma unroll
      for (int i = 0; i < 16; ++i) S[i] = 0.f;
#pragma unroll
      for (int ks = 0; ks < 2; ++ks) S = MFMA32(ldfrag(KT2 + z * (64 * LD32), LD32, 32 * tr, 16 * ks, lane), ldfrag(QT + z * (64 * LD32), LD32, 32 * tc, 16 * ks, lane), S);
      const int t = 32 * tc + l32;
#pragma unroll
      for (int g = 0; g < 4; ++g) { float pw[4];
#pragma unroll
          for (int e = 0; e < 4; ++e) { const int s = 32 * tr + 8 * g + 4 * hi + e; const bool ok = z == 0 ? (s <= t) : (s >= t); pw[e] = ok ? S[4 * g + e] : 0.f; }
          *(u32x2*)(PL + z * (64 * LD64) + t * LD64 + 32 * tr + 8 * g + 4 * hi) = (u32x2){pk(pw[0], pw[1]), pk(pw[2], pw[3])}; } }
    lbar();
    { const int z = wave >> 2, vr = (wave >> 1) & 1, tc = wave & 1;
      f32x16 a;
#pragma unroll
      for (int i = 0; i < 16; ++i) a[i] = 0.f;
#pragma unroll
      for (int ks = 0; ks < 4; ++ks) a = MFMA32(ldfrag(VT, LD64, 32 * vr, 16 * ks, lane), ldfrag(PL + z * (64 * LD64), LD64, 32 * tc, 16 * ks, lane), a);
#pragma unroll
      for (int ks = 0; ks < 2; ++ks) a = MFMA32(ldfrag(ST + z * (64 * LD32), LD32, 32 * vr, 16 * ks, lane), ldfrag(QH + z * (64 * LD32), LD32, 32 * tc, 16 * ks, lane), a);
      const int t = 32 * tc + l32;
#pragma unroll
      for (int i = 0; i < 16; ++i) H[z * (64 * HLD) + t * HLD + 32 * vr + crow(i, hi)] = a[i]; }
    lbar();
    chunk_finish(H, ws, m0, 512, h, outn, false, p.gg, p.gg);
    lbar();
}


constexpr int W48_LD = 1032, W48_BYTES = 48 * W48_LD * 2;
DI void mini_proj(unsigned char* lds, unsigned char* ws, int first_tile, int tile_step, int ntiles, const bf16* Wt48, const float* gate_b) {
    const int tid = otid(), lane = tid & 63, wave = tid >> 6, l32 = lane & 31, hi = lane >> 5;
    bf16* WL = (bf16*)lds; bf16* AS = (bf16*)(lds + W48_BYTES);
    if (first_tile >= ntiles) return;
    for (int i = tid; i < 48 * 128; i += 512) { const int n = i >> 7, c = (i & 127) * 8; *(u32x4*)(WL + n * W48_LD + c) = ldg((const u32x4*)(Wt48 + (size_t)n * 1024 + c)); }
    const int brow1 = (32 + l32) < 48 ? 32 + l32 : 47;
    for (int pm = first_tile; pm < ntiles; pm += tile_step) {
        const bf16* A = (const bf16*)(ws + WS_HXY) + (size_t)pm * 256 * 1024;
        u32x4 ar[4][4];
#pragma unroll
        for (int j = 0; j < 4; ++j)
#pragma unroll
            for (int q = 0; q < 4; ++q) { const int idx = tid + 512 * q; ar[j][q] = ldg((const u32x4*)(A + (size_t)(idx >> 3) * 1024 + 64 * j + (idx & 7) * 8)); }
        f32x16 acc0, acc1;
#pragma unroll
        for (int i = 0; i < 16; ++i) { acc0[i] = 0.f; acc1[i] = 0.f; }
        lbar();
        for (int c4 = 0; c4 < 16; c4 += 4) {
#pragma unroll
            for (int j = 0; j < 4; ++j) { const int c = c4 + j;
#pragma unroll
                for (int q = 0; q < 4; ++q) { const int idx = tid + 512 * q; *(u32x4*)(AS + (idx >> 3) * LD64 + (idx & 7) * 8) = ar[j][q]; }
                if (c + 4 < 16) {
#pragma unroll
                    for (int q = 0; q < 4; ++q) { const int idx = tid + 512 * q; ar[j][q] = ldg((const u32x4*)(A + (size_t)(idx >> 3) * 1024 + 64 * (c + 4) + (idx & 7) * 8)); } }
                lbar();
#pragma unroll
                for (int ks = 0; ks < 4; ++ks) { const bf16x8 a = ldfrag(AS, LD64, 32 * wave, 16 * ks, lane);
                    const bf16x8 b0 = *(const bf16x8*)(WL + l32 * W48_LD + 64 * c + 16 * ks + 8 * hi), b1 = *(const bf16x8*)(WL + brow1 * W48_LD + 64 * c + 16 * ks + 8 * hi);
                    acc0 = MFMA32(a, b0, acc0); acc1 = MFMA32(a, b1, acc1); }
                lbar();
            }
        }
        float* dst = (float*)(ws + WS_SMALL);
        const size_t r0 = (size_t)pm * 256 + wave * 32;
        const float gb = l32 < 16 ? ldg(gate_b + l32) : 0.f; const bool ls = l32 < 16 && ((l32 >> 2) & 1);
#pragma unroll
        for (int i = 0; i < 16; ++i) { float x = acc0[i] + gb; if (ls) x = logsigmoid_(x); stg(dst + (r0 + crow(i, hi)) * 48 + l32, x); }
        if (l32 < 16) {
#pragma unroll
            for (int i = 0; i < 16; ++i) stg(dst + (r0 + crow(i, hi)) * 48 + 32 + l32, acc1[i]); }
    }
    lbar();
}

#ifndef DUP_MASK
#define DUP_MASK 0
#endif
#define XB_TMO      128
#define XB_XCNT(j)  (256  + 64 * (j))
#define XB_XSUB(j)  (1280 + 64 * (j))
#define XB_XGEN(j)  (2304 + 64 * (j))
#define XB_TOP      3328
#define XB_TOPGEN   3392
#define XCD_BAR_WORDS 3456
#define XB_SPIN_CAP (1u << 18)

__device__ __forceinline__ unsigned xb_ld(unsigned* p)              { return __hip_atomic_load(p, __ATOMIC_RELAXED, __HIP_MEMORY_SCOPE_AGENT); }
__device__ __forceinline__ unsigned xb_add(unsigned* p, unsigned v) { return __hip_atomic_fetch_add(p, v, __ATOMIC_RELAXED, __HIP_MEMORY_SCOPE_AGENT); }
__device__ __forceinline__ unsigned xb_xcc_id() { return (unsigned)__builtin_amdgcn_s_getreg((3 << 11) | 20) & 0xFu; }
#define XB_SPIN(cond, bar) do { unsigned _sp = 0; while (cond) { __builtin_amdgcn_s_sleep(1); \
    if ((++_sp & 255u) == 0u) { if (xb_ld(&(bar)[XB_TMO])) break; if (_sp > XB_SPIN_CAP) { atomicAdd(&(bar)[XB_TMO], 1u); break; } } } } while (0)

struct XcdBarrier {
    unsigned* bar; unsigned x;
    volatile unsigned* st;
};

__device__ __forceinline__ XcdBarrier xcd_barrier_post(unsigned* bar, volatile unsigned* st) {
    XcdBarrier b; b.bar = bar; b.x = xb_xcc_id(); b.st = st;
    if (threadIdx.x == 0) (void)xb_add(&bar[XB_XCNT(b.x)], 1u);
    return b;
}
__device__ __forceinline__ void xcd_barrier_complete(unsigned* bar, unsigned x, unsigned& nloc, unsigned& nx) {
    const unsigned G = gridDim.x * gridDim.y * gridDim.z;
    unsigned sum, cnt, mine, sp = 0u;
    for (;;) {
        sum = 0u; cnt = 0u; mine = 0u;
#pragma unroll
        for (unsigned j = 0; j < 16; ++j) { const unsigned c = xb_ld(&bar[XB_XCNT(j)]); sum += c; cnt += (c > 0u) ? 1u : 0u; mine = (j == x) ? c : mine; }
        if (sum == G) break;
        __builtin_amdgcn_s_sleep(1);
        if ((++sp & 255u) == 0u) { if (xb_ld(&bar[XB_TMO])) break; if (sp > XB_SPIN_CAP) { atomicAdd(&bar[XB_TMO], 1u); break; } }
    }
    nloc = mine > 0u ? mine : 1u; nx = cnt > 0u ? cnt : 1u;
}

__device__ __forceinline__ void xcd_barrier(const XcdBarrier& b) {
    asm volatile("s_waitcnt vmcnt(0)" ::: "memory");
    __syncthreads();
    if (threadIdx.x == 0) {
        unsigned* bar = b.bar;
        __builtin_amdgcn_s_waitcnt(0);
        unsigned nloc = b.st[0], nx = b.st[1];
        if (nloc == 0u) { xcd_barrier_complete(bar, b.x, nloc, nx); b.st[0] = nloc; b.st[1] = nx; }
        const unsigned old = xb_add(&bar[XB_XSUB(b.x)], 1u);
        const unsigned gen = old / nloc;
        if (old + 1u == (gen + 1u) * nloc) {
            __builtin_amdgcn_fence(__ATOMIC_RELEASE, "agent");
            asm volatile("s_waitcnt vmcnt(0)" ::: "memory");
            const unsigned og = xb_add(&bar[XB_TOP], 1u);
            const unsigned tg = og / nx;
            if (og + 1u == (tg + 1u) * nx) xb_add(&bar[XB_TOPGEN], 1u);
            else XB_SPIN(xb_ld(&bar[XB_TOPGEN]) == tg, bar);
            __builtin_amdgcn_fence(__ATOMIC_ACQUIRE, "agent");
            xb_add(&bar[XB_XGEN(b.x)], 1u);
            asm volatile("s_waitcnt vmcnt(0)" ::: "memory");
        } else {
            XB_SPIN(xb_ld(&bar[XB_XGEN(b.x)]) == gen, bar);
            __builtin_amdgcn_fence(__ATOMIC_ACQUIRE, "agent");
            asm volatile("s_waitcnt vmcnt(0)" ::: "memory");
        }
    }
    __syncthreads();
}

DI void gbar(unsigned* cnt, unsigned target) {
    asm volatile("s_waitcnt vmcnt(0) lgkmcnt(0)" ::: "memory");
    __syncthreads();
    if (threadIdx.x == 0) {
        __builtin_amdgcn_fence(__ATOMIC_RELEASE, "agent");
        __hip_atomic_fetch_add(cnt, 1u, __ATOMIC_RELAXED, __HIP_MEMORY_SCOPE_AGENT);
        while (__hip_atomic_load(cnt, __ATOMIC_RELAXED, __HIP_MEMORY_SCOPE_AGENT) < target) __builtin_amdgcn_s_sleep(1);
        __builtin_amdgcn_fence(__ATOMIC_ACQUIRE, "agent");
    }
    __syncthreads();
}
#define GSYNC() do { XcdBarrier xb_; xb_.bar = (unsigned*)(ws + WS_XBAR); xb_.x = xb_xcc_id(); xb_.st = (volatile unsigned*)(lds + LDS_BYTES - 64); xcd_barrier(xb_); if ((DUP_MASK) & 256) xcd_barrier(xb_); } while (0)
#define DUPN(bit) (((DUP_MASK) & (bit)) ? 2 : 1)
__global__ void __launch_bounds__(512, 2) fwd_kernel(Args a) {
    extern __shared__ __attribute__((aligned(16))) unsigned char lds[];
    cg::grid_group grid = cg::this_grid();
#ifdef PAD_NOPS
    asm volatile(".rept " PAD_NOPS "\n s_nop 0\n .endr" ::: );
#endif
    unsigned char* ws = a.ws;
    int tid = threadIdx.x, lane = tid & 63, wave = __builtin_amdgcn_readfirstlane(tid >> 6);
    const int G = gridDim.x, bid = blockIdx.x;
    float* MODV = (float*)(ws + WS_MODV); float* MISC = (float*)(ws + WS_MISC);
    if (bid == 0 && tid < 24) ((const float**)(ws + WS_ARGS))[tid] = tid < 23 ? a.in[tid] : (const float*)a.out;
    volatile unsigned* xst = (volatile unsigned*)(lds + LDS_BYTES - 64);
    if (tid < 2) xst[tid] = 0u;
    __syncthreads();
    (void)xcd_barrier_post((unsigned*)(ws + WS_XBAR), xst);


    for (int rep = 0; rep < DUPN(128); ++rep) {
        for (int task = bid; task < 96; task += G) {
            const int l = task / 48, n0 = (task % 48) * 64, n = n0 + lane;
            const float* wm = a.in[4] + (size_t)l * 1024 * 3072; const float* c = a.in[1]; const float* cc = a.in[3];
            float* SV = (float*)lds;
            for (int i = tid; i < 3072; i += 512) { const float x = i < 2048 ? c[i] : cc[i - 2048]; SV[i] = silu_(x); }
            __syncthreads();
            float a0 = 0.f, a1 = 0.f, a2 = 0.f;
            for (int k0 = 0; k0 < 128; k0 += 32) { float w[32];
#pragma unroll
                for (int kk = 0; kk < 32; ++kk) w[kk] = wm[(size_t)(wave * 128 + k0 + kk) * 3072 + n];
#pragma unroll
                for (int kk = 0; kk < 32; ++kk) { const int k = wave * 128 + k0 + kk; a0 += SV[k] * w[kk]; a1 += SV[1024 + k] * w[kk]; a2 += SV[2048 + k] * w[kk]; } }
            float* red = (float*)(lds + 131072);
            red[(wave * 3 + 0) * 64 + lane] = a0; red[(wave * 3 + 1) * 64 + lane] = a1; red[(wave * 3 + 2) * 64 + lane] = a2;
            __syncthreads();
            if (tid < 192) { const int v = tid >> 6; float s = a.in[5][l * 3072 + n0 + lane];
                for (int w = 0; w < 8; ++w) s += red[(w * 3 + v) * 64 + lane];
                MODV[(l * 3 + v) * 3072 + n0 + lane] = s; }
            __syncthreads();
        }
        if (bid == G - 1) {
            float* tabA = (float*)(ws + WS_TABA); float* tabD = (float*)(ws + WS_TABD);
            for (int idx = tid; idx < 128 * 8; idx += 512) { const int pos = idx >> 3, i = idx & 7;
                const float inv = exp2f(-(float)i * (13.287712379549449f / 8.f)); const float ang = (float)pos * inv;
                double rev = (double)ang * 0.15915494309189535; rev -= rint(rev);
                tabA[pos * 16 + i] = __builtin_amdgcn_cosf((float)rev); tabA[pos * 16 + 8 + i] = __builtin_amdgcn_sinf((float)rev); }
            for (int idx = tid; idx < 128 * 16; idx += 512) { const int pos = idx >> 4, i = idx & 15;
                const float inv = exp2f(-(float)i * (13.287712379549449f / 16.f)); const float ang = (float)pos * inv;
                double rev = (double)ang * 0.15915494309189535; rev -= rint(rev);
                tabD[pos * 32 + i] = __builtin_amdgcn_cosf((float)rev); tabD[pos * 32 + 16 + i] = __builtin_amdgcn_sinf((float)rev); }
            if (tid < 2) { const int l = tid; const float* lp = a.in[11] + l * 128; float s1 = 0.f, s2 = 0.f;
                for (int d = 0; d < 32; ++d) { s1 += lp[d] * lp[32 + d]; s2 += lp[64 + d] * lp[96 + d]; }
                const float lam_init = 0.8f - 0.6f * expf(-0.3f * (float)l);
                float gq = 0.f, gk = 0.f, gqd = 0.f, gkd = 0.f, sk = 0.f;
                for (int d = 0; d < 32; ++d) { gq = fmaxf(gq, fabsf(a.in[9][l * 32 + d])); gk = fmaxf(gk, fabsf(a.in[10][l * 32 + d])); }
                for (int d = 0; d < 64; ++d) { gqd = fmaxf(gqd, fabsf(a.in[20][l * 64 + d])); gkd = fmaxf(gkd, fabsf(a.in[21][l * 64 + d])); }
                for (int d = 0; d < 4; ++d) sk = fmaxf(sk, a.in[22][l * 4 + d] * LOG2E);
                MISC[l * 8 + 0] = expf(s1) - expf(s2) + lam_init; MISC[l * 8 + 1] = lam_init;
                MISC[l * 8 + 2] = 5.656854249f * LOG2E * gq * gk * 1.01f; MISC[l * 8 + 3] = fmaxf(8.f * LOG2E * gqd * gkd * 1.01f, sk); }
        }
        float* scr = (float*)(lds + wave * 16384);
        const int gw = bid * 8 + wave, NGW = G * 8;
        for (int it = gw; it < 2048; it += NGW) {
            if (it < 4096) { const int l = it >> 11; transpose_item(a.in[7] + (size_t)l * 1024 * NSRC, NSRC, true, (bf16*)(ws + WS_WIN) + (size_t)l * NP * 1024, 1024, it & 2047, NP / 32, scr, lane); }
            else { const int r = it - 4096, l = r >> 9; transpose_item(a.in[8] + (size_t)l * 1024 * 1024, 1024, false, (bf16*)(ws + WS_WOUT) + (size_t)l * 1024 * 1024, 1024, r & 511, 32, scr, lane); }
        }
    }
    if (a.ws == nullptr) grid.sync();
    GSYNC();

#pragma unroll 1
    for (int l = 0; l < 2; ++l) {
        asm volatile("" : "+s"(ws));
        const float* const* IN = (const float* const*)(ws + WS_ARGS); float* OUT = (float*)IN[23];
        const float* xsrc = l == 0 ? IN[0] : OUT; const float* csrc = l == 0 ? IN[2] : (const float*)(ws + WS_CTX);
        tid = otid(); lane = tid & 63; wave = __builtin_amdgcn_readfirstlane(tid >> 6);
        {
            const int gw = bid * 8 + wave, NGW = G * 8; const float* ng = IN[6] + l * 1024;
            for (int rep = 0; rep < DUPN(1); ++rep)
            for (int m0 = gw; m0 < M; m0 += 2 * NGW) {
                const float* srcs[2]; int vs[2]; bool ok[2]; f32x4 x[2][4];
#pragma unroll
                for (int r = 0; r < 2; ++r) { const int m = m0 + r * NGW; ok[r] = m < M; const int mm = ok[r] ? m : m0;
                    const int b = mm >= TK ? 1 : 0, j = mm - b * TK;
                    if (j < LC) { srcs[r] = csrc + (size_t)(b * LC + j) * D; vs[r] = 2; } else { srcs[r] = xsrc + (size_t)(b * T + j - LC) * D; vs[r] = b; }
#pragma unroll
                    for (int q = 0; q < 4; ++q) x[r][q] = ldg((const f32x4*)srcs[r] + lane + 64 * q); }
#pragma unroll
                for (int r = 0; r < 2; ++r) { if (!ok[r]) continue; const int m = m0 + r * NGW;
                    const float* md = MODV + (l * 3 + vs[r]) * 3072; float ss = 0.f;
#pragma unroll
                    for (int q = 0; q < 4; ++q) ss += (x[r][q].x * x[r][q].x + x[r][q].y * x[r][q].y) + (x[r][q].z * x[r][q].z + x[r][q].w * x[r][q].w);
                    const float rinv = rsqrtf(wave_sum(ss) * (1.f / 1024.f) + EPS);
                    bf16* dst = (bf16*)(ws + WS_HXY) + (size_t)m * D;
#pragma unroll
                    for (int q = 0; q < 4; ++q) { const int col = 4 * (lane + 64 * q);
                        const f32x4 g = ldg((const f32x4*)(ng + col)), sh = ldg((const f32x4*)(md + col)), sc = ldg((const f32x4*)(md + 1024 + col));
                        const f32x4 y = (x[r][q] * rinv) * g * (sc + 1.f) + sh;
                        stg((u32x2*)(dst + col), (u32x2){pk(y.x, y.y), pk(y.z, y.w)}); } }
            }
        }
        GSYNC();
        {
#ifdef USE_MINI
            constexpr int NBIG = 3840, NUNITS = (M / 256) * (NBIG / 256);
            { const int first = NUNITS % G;
              if (bid >= first) mini_proj(lds, ws, bid - first, G - first, M / 256, (const bf16*)(ws + WS_WIN) + ((size_t)l * NP + NBIG) * 1024, IN[15] + l * 16); }
#else
            constexpr int NBIG = NP;
#endif
            pg8::Gemm g{(const pg8::bf16_t*)(ws + WS_HXY), (const pg8::bf16_t*)(ws + WS_WIN) + (size_t)l * NP * 1024, M, NBIG, D};
            pg8::StaticOrder S; S.init(M, NBIG, G, bid);
            EpiIn E{ws, l};
            for (int rep = 0; rep < DUPN(2); ++rep) pg8::gemm_phase<EpiIn, pg8::StaticOrder, true, true>((PG8_LAS unsigned char*)lds, g, S, E);
        }
        GSYNC();
        {
            const float* misc = MISC + l * 8;
#ifdef PAD_CA
            asm volatile("s_nop 0");
#endif
            fill_wcache(lds, IN, l);
            for (int rep = 0; rep < DUPN(4); ++rep) {
                { const float* cw = (const float*)(lds + WC_OFF) + WC_CW; const float* cb = (const float*)(lds + WC_OFF) + WC_CB;
                  int t = bid; MaPre cur = mlstm_a_load(ws, t < 8 * NCH ? t : 0);
                  while (t < 8 * NCH) { const int tn = t + G; MaPre nxt = mlstm_a_load(ws, tn < 8 * NCH ? tn : t); mlstm_a_run(lds, ws, t, cur, cw, cb); cur = nxt; t = tn; } }
                { const float* wg = (const float*)(lds + WC_OFF) + WC_WG; const float* bg = (const float*)(lds + WC_OFF) + WC_BG;
                  int t = bid; GlPre cur = gla_load(ws, t < 8 * NCH ? t : 0, false);
                  while (t < 8 * NCH) { const int tn = t + G; GlPre nxt = gla_load(ws, tn < 8 * NCH ? tn : t, false); gla_a_run(lds, ws, t, cur, wg, bg); cur = nxt; t = tn; } }
            }
#ifdef PAD_CA
            asm volatile("s_nop 0");
#endif
            const int nU = l == 0 ? 264 : 256;
            for (int rep = 0; rep < DUPN(8); ++rep)
            for (int u = bid; u < nU; u += G) attnD_unit(lds, ws, u, IN[22] + l * 4, misc);
            for (int rep = 0; rep < DUPN(16); ++rep)
            for (int u = bid; u < nU; u += G) attnA_unit(lds, ws, u, IN[12] + l * 64, misc);
        }
        GSYNC();
        for (int t = bid; t < 208; t += G) scan_b(lds, ws, t);
        if (l == 0) {
            float* scr = (float*)(lds + wave * 16384);
            for (int it = 2048 + bid * 8 + wave; it < 2 * 2048 + 2 * 512; it += G * 8) {
                if (it < 4096) { transpose_item(IN[7] + (size_t)1024 * NSRC, NSRC, true, (bf16*)(ws + WS_WIN) + (size_t)NP * 1024, 1024, it & 2047, NP / 32, scr, lane); }
                else { const int r = it - 4096, ll = r >> 9; transpose_item(IN[8] + (size_t)ll * 1024 * 1024, 1024, false, (bf16*)(ws + WS_WOUT) + (size_t)ll * 1024 * 1024, 1024, r & 511, 32, scr, lane); }
            }
            __syncthreads();
        }
        GSYNC();
#ifdef PAD_CC
        asm volatile("s_nop 0");
#endif
        fill_wcache(lds, IN, l);
        for (int rep = 0; rep < DUPN(32); ++rep) {
            const int ncl = l == 0 ? NCH : NCH - 4, ntask = 8 * ncl;
#define C_TASK(u) (((u) / ncl) * NCH + ((u) % ncl) + (NCH - ncl))
            { const float* cw = (const float*)(lds + WC_OFF) + WC_CW; const float* cb = (const float*)(lds + WC_OFF) + WC_CB; const float* on = (const float*)(lds + WC_OFF) + WC_BON;
              int u = bid; McPre cur = mlstm_c_load(ws, C_TASK(u < ntask ? u : 0));
              while (u < ntask) { const int un = u + G; McPre nxt = mlstm_c_load(ws, C_TASK(un < ntask ? un : u)); mlstm_c_run(lds, ws, C_TASK(u), cur, cw, cb, on); cur = nxt; u = un; } }
            { const float* wg = (const float*)(lds + WC_OFF) + WC_WG; const float* bg = (const float*)(lds + WC_OFF) + WC_BG; const float* on = (const float*)(lds + WC_OFF) + WC_CON;
              int u = bid; GcPre cur = gla_c_load(ws, C_TASK(u < ntask ? u : 0));
              while (u < ntask) { const int un = u + G; GcPre nxt = gla_c_load(ws, C_TASK(un < ntask ? un : u)); gla_c_run(lds, ws, C_TASK(u), cur, wg, bg, on); cur = nxt; u = un; } }
        }
#ifdef PAD_CC
        asm volatile("s_nop 0");
#endif
        GSYNC();
        {
            pg8::Gemm g{(const pg8::bf16_t*)(ws + WS_HXY), (const pg8::bf16_t*)(ws + WS_WOUT) + (size_t)l * 1024 * 1024, M, D, D};
            EpiOut E{xsrc, csrc, OUT, (float*)(ws + WS_CTX), MODV + l * 3 * 3072};
            if (l == 0) { pg8::StaticOrder S; S.init(M, D, G, bid); for (int rep = 0; rep < DUPN(64); ++rep) pg8::gemm_phase<EpiOut, pg8::StaticOrder, true, true>((PG8_LAS unsigned char*)lds, g, S, E); }
            else { LatOrder S; S.so.init(NB * T, D, G, bid); pg8::gemm_phase<EpiOut, LatOrder, true, true>((PG8_LAS unsigned char*)lds, g, S, E); }
        }
        if (l == 0) GSYNC();
    }
}

extern "C" void kernel_launch(void* const* d_in, const int* in_sizes, int n_in, void* d_out, int out_size, void* d_ws, size_t ws_size, hipStream_t stream) {
    static int grid = 0;
    if (grid == 0) {
        int dev = 0, cus = 0, per_cu = 0;
        if (n_in != 23 || ws_size < 256 * MiB) { fprintf(stderr, "kernel_launch: unexpected inputs (n_in %d, ws %zu)\n", n_in, ws_size); grid = -1; return; }
        hipGetDevice(&dev); hipDeviceGetAttribute(&cus, hipDeviceAttributeMultiprocessorCount, dev);
        if (hipFuncSetAttribute((const void*)fwd_kernel, hipFuncAttributeMaxDynamicSharedMemorySize, LDS_BYTES) != hipSuccess) { fprintf(stderr, "kernel_launch: hipFuncSetAttribute failed\n"); grid = -1; return; }
        if (hipOccupancyMaxActiveBlocksPerMultiprocessor(&per_cu, (const void*)fwd_kernel, 512, LDS_BYTES) != hipSuccess || per_cu < 1) { fprintf(stderr, "kernel_launch: occupancy query says %d\n", per_cu); per_cu = 1; }
        (void)hipGetLastError();
        grid = cus > 0 ? cus : 256;
    }
    if (grid < 0) return;
    Args a{};
    for (int i = 0; i < 23; ++i) a.in[i] = (const float*)d_in[i];
    a.out = (float*)d_out; a.ws = (unsigned char*)d_ws;
    if (hipMemsetAsync((char*)d_ws + WS_XBAR, 0, 16384, stream) != hipSuccess) { fprintf(stderr, "kernel_launch: memset of the barrier word failed\n"); return; }
    void* args[] = {&a};
    hipError_t e = hipLaunchCooperativeKernel((const void*)fwd_kernel, dim3(grid), dim3(512), args, LDS_BYTES, stream);
    if (e != hipSuccess) fprintf(stderr, "kernel_launch: cooperative launch failed: %s (grid %d)\n", hipGetErrorString(e), grid);
}
```

```cpp
#include <hip/hip_runtime.h>
#include <hip/hip_cooperative_groups.h>
#include <cstdio>
#include <cstdint>
namespace cg = cooperative_groups;
#define DUP_MASK 0
#define PAD_NOPS "6"
#define USE_MINI
namespace pg8 {
#define PG8_LAS __attribute__((address_space(3)))
typedef unsigned short bf16_t;
typedef short bf16x8 __attribute__((ext_vector_type(8)));
typedef float f32x4 __attribute__((ext_vector_type(4)));
typedef unsigned u32x4 __attribute__((ext_vector_type(4)));
constexpr int BM = 256, BK = 64, HALF = 128, HTB = HALF * BK * 2  , STAGE_BYTES = 8 * HTB, NXCD = 8, WGM = 8;

__host__ __device__ __forceinline__ int lds_byte(int r, int c) { const int st = (r >> 4) * 2 + (c >> 5), rr = r & 15, cc = c & 31, ob = rr * 64 + cc * 2; return st * 1024 + (ob ^ (((ob >> 9) & 1) << 5)); }
__host__ __device__ __forceinline__ void stage_rc(int b, int& R, int& C) { const int st = b / 1024, sb = b % 1024, swz = sb ^ (((sb >> 9) & 1) << 5); R = (st >> 1) * 16 + swz / 64; C = (st & 1) * 32 + (swz % 64) / 2; }
__host__ __device__ __forceinline__ int perm32(int rho) { const int n = rho >> 4, i = rho & 15; return 8 * (i >> 2) + 4 * n + (i & 3); }

struct Unit { int pm, pn; };
struct Gemm { const bf16_t* A; const bf16_t* Bt; int M, N, K; };

struct StaticOrder {
    int nM, nN, nwg, G, c;
    __host__ __device__ void init(int M, int N, int G_, int c_) { nM = M / BM; nN = N / BM; nwg = nM * nN; G = G_; c = c_; }
    __host__ __device__ bool next(int i, Unit& u) const {
        const long L = (long)i * G + c; if (L >= nwg) return false;
        int wgid = (int)L; { const int q = nwg / NXCD, r = nwg % NXCD, xcd = wgid % NXCD, off = wgid / NXCD; wgid = (xcd < r ? xcd * (q + 1) : r * (q + 1) + (xcd - r) * q) + off; }
        const int nig = WGM * nN, gid = wgid / nig, fm = gid * WGM, gsz = (nM - fm) < WGM ? (nM - fm) : WGM;
        u.pm = fm + ((wgid % nig) % gsz); u.pn = (wgid % nig) / gsz; return true;
    }
    __device__ __forceinline__ void a_ready(const Unit&) const {}
    __device__ __forceinline__ void done(const Unit&) const {}
};

__device__ __forceinline__ unsigned cvt_pk_bf16(float lo, float hi) { unsigned r; asm volatile("v_cvt_pk_bf16_f32 %0, %1, %2" : "=v"(r) : "v"(lo), "v"(hi)); return r; }
typedef float f32x2 __attribute__((ext_vector_type(2)));
template <class Epi, class Sched, bool ALIGN_EPI = false, bool SP2 = false>
__device__ __forceinline__ void gemm_phase(PG8_LAS unsigned char* lds, const Gemm g, const Sched& S, const Epi& E) {
    int tid_ = threadIdx.x; asm volatile("" : "+v"(tid_)); const int tid = tid_, wid = __builtin_amdgcn_readfirstlane(tid >> 6), lane = tid & 63, wr = wid >> 2, wc = wid & 3, fr = lane & 15, fq = lane >> 4;
    const int K = g.K, nt = K / BK;
    unsigned voffA[2], voffB[2];
#pragma unroll
    for (int i = 0; i < 2; ++i) { int R, C; stage_rc(tid * 16 + i * 8192, R, C); const int Rb = Epi::PERM ? ((R & ~31) + perm32(R & 31)) : R;
        voffA[i] = (unsigned)(R * K + C) * 2u; voffB[i] = (unsigned)(Rb * K + C) * 2u; }
    const size_t kstep = (size_t)(BK * 2);
    const size_t hstep = (size_t)HALF * K * 2;
    const size_t tstep = 2 * hstep;
    const unsigned ldsw = (unsigned)wid * 1024u;
    const int aoff = lds_byte(wr * 64 + fr, fq * 8), boff = lds_byte(wc * 32 + fr, fq * 8);
#define PG8_SA(b, h) (((b) * 2 + (h)) * HTB)
#define PG8_SB(b, h) ((4 + (b) * 2 + (h)) * HTB)
#define PG8_STAGE(bufoff, gbase, voff) do { _Pragma("unroll") for (int _i = 0; _i < 2; ++_i) \
        __builtin_amdgcn_global_load_lds((const unsigned*)((const char*)(gbase) + (voff)[_i]), (PG8_LAS unsigned*)(lds + (bufoff) + ldsw + _i * 8192), 16, 0, 0); } while (0)
#define PG8_LDA(dst, b, h) do { _Pragma("unroll") for (int m = 0; m < 4; ++m) _Pragma("unroll") for (int k = 0; k < 2; ++k) dst[m][k] = *(const PG8_LAS bf16x8*)(lds + PG8_SA(b, h) + aoff + m * 2048 + k * 1024); } while (0)
#define PG8_LDB(dst, b, h) do { _Pragma("unroll") for (int n = 0; n < 2; ++n) _Pragma("unroll") for (int k = 0; k < 2; ++k) dst[n][k] = *(const PG8_LAS bf16x8*)(lds + PG8_SB(b, h) + boff + n * 2048 + k * 1024); } while (0)
#define PG8_MMA(ai, bj, At, Bt) do { __builtin_amdgcn_s_setprio(1); _Pragma("unroll") for (int m = 0; m < 4; ++m) _Pragma("unroll") for (int n = 0; n < 2; ++n) _Pragma("unroll") for (int k = 0; k < 2; ++k) \
        acc[ai][bj][m][n] = __builtin_amdgcn_mfma_f32_16x16x32_bf16(Bt[n][k], At[m][k], acc[ai][bj][m][n], 0, 0, 0); __builtin_amdgcn_s_setprio(0); } while (0)
#define PG8_WAIT_V(n) asm volatile("s_waitcnt vmcnt(" #n ")" ::: "memory")
#define PG8_WAIT_L(n) asm volatile("s_waitcnt lgkmcnt(" #n ")" ::: "memory")
#define PG8_BAR __builtin_amdgcn_s_barrier()
#define PG8_SCHED __builtin_amdgcn_sched_barrier(0)
    Unit cur, nxt; int ui = 0;
    if (!S.next(0, cur)) return;
    f32x4 acc[2][2][4][2];
#pragma unroll
    for (int a = 0; a < 2; ++a)
#pragma unroll
        for (int b = 0; b < 2; ++b)
#pragma unroll
            for (int m = 0; m < 4; ++m)
#pragma unroll
                for (int n = 0; n < 2; ++n) acc[a][b][m][n] = (f32x4){0.f, 0.f, 0.f, 0.f};
    bf16x8 At[4][2], B0[2][2], B1[2][2];
    const char* cA = (const char*)g.A + (size_t)cur.pm * tstep; const char* cB = (const char*)g.Bt + (size_t)cur.pn * tstep;
    S.a_ready(cur);
    if constexpr (SP2) {
        PG8_STAGE(PG8_SB(0, 0), cB, voffB); PG8_STAGE(PG8_SB(0, 1), cB + hstep, voffB); PG8_STAGE(PG8_SA(0, 0), cA, voffA); PG8_STAGE(PG8_SA(0, 1), cA + hstep, voffA);
        if (wr == 1) PG8_BAR;
        PG8_WAIT_V(2); PG8_BAR;
        PG8_STAGE(PG8_SB(1, 0), cB + kstep, voffB); PG8_STAGE(PG8_SA(1, 0), cA + kstep, voffA); PG8_STAGE(PG8_SB(1, 1), cB + hstep + kstep, voffB);
        PG8_WAIT_V(6); PG8_BAR;
    } else {
        PG8_STAGE(PG8_SB(0, 0), cB, voffB); PG8_STAGE(PG8_SA(0, 0), cA, voffA); PG8_STAGE(PG8_SB(0, 1), cB + hstep, voffB); PG8_STAGE(PG8_SA(0, 1), cA + hstep, voffA);
        if (wr == 1) PG8_BAR;
        PG8_WAIT_V(4); PG8_BAR;
        PG8_STAGE(PG8_SB(1, 0), cB + kstep, voffB); PG8_STAGE(PG8_SA(1, 0), cA + kstep, voffA); PG8_STAGE(PG8_SB(1, 1), cB + hstep + kstep, voffB);
        PG8_WAIT_V(6); PG8_BAR;
    }
#ifdef PAD_G
    if constexpr (Epi::PADK) asm volatile("s_nop 0");
#endif
    for (;;) {
        const bool has_next = S.next(ui + 1, nxt);
        const char* nA = has_next ? (const char*)g.A + (size_t)nxt.pm * tstep : cA; const char* nB = has_next ? (const char*)g.Bt + (size_t)nxt.pn * tstep : cB;
        for (int t = 0; t < nt; t += 2) {
            const bool last = (t == nt - 2);
            const char* a1 = cA + (size_t)(t + 1) * kstep;
            const char* a2 = last ? nA : cA + (size_t)(t + 2) * kstep; const char* b2 = last ? nB : cB + (size_t)(t + 2) * kstep;
            const char* a3 = a2 + kstep; const char* b3 = b2 + kstep;
            if (last && has_next) S.a_ready(nxt);
            if constexpr (SP2) {
            PG8_LDB(B0, 0, 0); PG8_LDB(B1, 0, 1); PG8_SCHED; PG8_LDA(At, 0, 0); PG8_STAGE(PG8_SA(1, 1), a1 + hstep, voffA);
            PG8_WAIT_V(8); PG8_WAIT_L(0); PG8_BAR; PG8_MMA(0, 0, At, B0); PG8_MMA(0, 1, At, B1); PG8_BAR; PG8_SCHED;
            PG8_LDA(At, 0, 1); PG8_STAGE(PG8_SB(0, 0), b2, voffB); PG8_STAGE(PG8_SB(0, 1), b2 + hstep, voffB); PG8_STAGE(PG8_SA(0, 0), a2, voffA);
            PG8_WAIT_V(8); PG8_WAIT_L(0); PG8_BAR; PG8_MMA(1, 0, At, B0); PG8_MMA(1, 1, At, B1); PG8_BAR; PG8_SCHED;
            PG8_LDB(B0, 1, 0); PG8_LDB(B1, 1, 1); PG8_SCHED; PG8_LDA(At, 1, 0); PG8_STAGE(PG8_SA(0, 1), a2 + hstep, voffA);
            PG8_WAIT_V(8); PG8_WAIT_L(0); PG8_BAR; PG8_MMA(0, 0, At, B0); PG8_MMA(0, 1, At, B1); PG8_BAR; PG8_SCHED;
            PG8_LDA(At, 1, 1); PG8_STAGE(PG8_SB(1, 0), b3, voffB); PG8_STAGE(PG8_SB(1, 1), b3 + hstep, voffB); PG8_STAGE(PG8_SA(1, 0), a3, voffA);
            PG8_WAIT_V(8); PG8_WAIT_L(0); PG8_BAR; PG8_MMA(1, 0, At, B0); PG8_MMA(1, 1, At, B1); PG8_BAR; PG8_SCHED;
            } else {
            PG8_LDB(B0, 0, 0); PG8_SCHED; PG8_LDA(At, 0, 0); PG8_STAGE(PG8_SA(1, 1), a1 + hstep, voffA);
            PG8_WAIT_L(8); PG8_BAR; PG8_WAIT_L(0); PG8_MMA(0, 0, At, B0); PG8_BAR; PG8_SCHED;
            PG8_LDB(B1, 0, 1); PG8_STAGE(PG8_SB(0, 0), b2, voffB);
            PG8_BAR; PG8_WAIT_L(0); PG8_MMA(0, 1, At, B1); PG8_BAR;
            PG8_LDA(At, 0, 1); PG8_STAGE(PG8_SA(0, 0), a2, voffA);
            PG8_BAR; PG8_WAIT_L(0); PG8_MMA(1, 0, At, B0); PG8_BAR; PG8_SCHED;
            PG8_STAGE(PG8_SB(0, 1), b2 + hstep, voffB);
            PG8_WAIT_V(6); PG8_BAR; PG8_MMA(1, 1, At, B1); PG8_BAR;
            PG8_LDB(B0, 1, 0); PG8_SCHED; PG8_LDA(At, 1, 0); PG8_STAGE(PG8_SA(0, 1), a2 + hstep, voffA);
            PG8_WAIT_L(8); PG8_BAR; PG8_WAIT_L(0); PG8_MMA(0, 0, At, B0); PG8_BAR; PG8_SCHED;
            PG8_LDB(B1, 1, 1); PG8_STAGE(PG8_SB(1, 0), b3, voffB);
            PG8_BAR; PG8_WAIT_L(0); PG8_MMA(0, 1, At, B1); PG8_BAR;
            PG8_LDA(At, 1, 1); PG8_STAGE(PG8_SA(1, 0), a3, voffA);
            PG8_BAR; PG8_WAIT_L(0); PG8_MMA(1, 0, At, B0); PG8_BAR; PG8_SCHED;
            PG8_STAGE(PG8_SB(1, 1), b3 + hstep, voffB);
            PG8_WAIT_V(6); PG8_BAR; PG8_MMA(1, 1, At, B1); PG8_BAR;
            }
        }
        if constexpr (ALIGN_EPI) { if (wr == 0) PG8_BAR; }
        if constexpr (!Epi::AFTER_DRAIN) { E(acc, cur, wr, wc, fr, fq); S.done(cur); }
        if (!has_next) break;
#pragma unroll
        for (int a = 0; a < 2; ++a)
#pragma unroll
            for (int b = 0; b < 2; ++b)
#pragma unroll
                for (int m = 0; m < 4; ++m)
#pragma unroll
                    for (int n = 0; n < 2; ++n) acc[a][b][m][n] = (f32x4){0.f, 0.f, 0.f, 0.f};
        cur = nxt; cA = nA; cB = nB; ++ui;
        if constexpr (ALIGN_EPI) { if (wr == 1) PG8_BAR; }
    }
#ifdef PAD_G
    if constexpr (Epi::PADK) asm volatile("s_nop 0");
#endif
    PG8_WAIT_V(0);
    if constexpr (!ALIGN_EPI) { if (wr == 0) PG8_BAR; }
    PG8_BAR;
    if constexpr (Epi::AFTER_DRAIN) { E.fused(acc, cur, wr, wc, fr, fq, lds, wid, lane); S.done(cur); }
#undef PG8_SA
#undef PG8_SB
#undef PG8_STAGE
#undef PG8_LDA
#undef PG8_LDB
#undef PG8_MMA
#undef PG8_WAIT_V
#undef PG8_WAIT_L
#undef PG8_BAR
#undef PG8_SCHED
}
}

#define DI __device__ __forceinline__
typedef unsigned short bf16;
typedef short bf16x8 __attribute__((ext_vector_type(8)));
typedef float f32x4 __attribute__((ext_vector_type(4)));
typedef float f32x16 __attribute__((ext_vector_type(16)));
typedef unsigned u32x4 __attribute__((ext_vector_type(4)));
typedef unsigned u32x2 __attribute__((ext_vector_type(2)));
typedef __bf16 bf16x2_t __attribute__((ext_vector_type(2)));
typedef float f32x2_t __attribute__((ext_vector_type(2)));
#define MFMA32(a, b, c) __builtin_amdgcn_mfma_f32_32x32x16_bf16((a), (b), (c), 0, 0, 0)

constexpr int NB = 2, T = 8192, LC = 256, TK = 8448, M = NB * TK, D = 1024, NSRC = 3888, NP = 4096, NCH = 132;
constexpr float EPS = 1e-6f, LOG2E = 1.4426950408889634f;
constexpr int LDS_BYTES = 147456;

constexpr size_t MiB = 1u << 20;
constexpr size_t S8 = (size_t)M * 256 * 2, S4 = S8 / 2;
constexpr size_t WS_ARGS = 512 * 1024, WS_XBAR = 64 * 1024;
constexpr size_t WS_MODV = 1 * MiB, WS_TABA = WS_MODV + 131072, WS_TABD = WS_TABA + 8192, WS_MISC = WS_TABD + 16384;
constexpr size_t WS_WIN = 2 * MiB, WS_WOUT = 18 * MiB, WS_CTX = 22 * MiB, WS_HXY = 24 * MiB;
constexpr size_t WS_QA = 57 * MiB, WS_KA = WS_QA + S8, WS_VAT = WS_KA + S8, WS_QB = WS_VAT + S8, WS_KB = WS_QB + S8, WS_VBT = WS_KB + S8, WS_OB = WS_VBT + S8;
constexpr size_t WS_QC = WS_OB + S8, WS_KC = WS_QC + S4, WS_VCT = WS_KC + S4, WS_QD = WS_VCT + S8, WS_KD = WS_QD + S8, WS_VDT = WS_KD + S4, WS_GATE = WS_VDT + S4;
constexpr size_t WS_SMALL = WS_GATE + 4 * S8;
constexpr size_t WS_CST = 184 * MiB, WS_NST = 217 * MiB, WS_SSC = WS_NST + 768 * 1024, WS_SST = 218 * MiB, WS_GD = WS_SST + (size_t)16 * NCH * 2048 * 4;
static_assert(WS_SMALL + (size_t)M * 48 * 4 <= WS_CST, "ws map");
static_assert(WS_CST + (size_t)16 * NCH * 4096 * 4 <= WS_NST, "ws map");
static_assert(WS_GD + (size_t)16 * NCH * 32 * 4 <= 256 * MiB, "ws map");

DI unsigned pk(float lo, float hi) { f32x2_t v = {lo, hi}; bf16x2_t b = __builtin_convertvector(v, bf16x2_t); return __builtin_bit_cast(unsigned, b); }
DI bf16 f2b(float x) { return (bf16)(pk(x, 0.f) & 0xffffu); }
DI float b2f(bf16 x) { return __uint_as_float((unsigned)x << 16); }
DI float bfe(const u32x4& v, int e) { const unsigned w = v[e >> 1]; return __uint_as_float((e & 1) ? (w & 0xffff0000u) : (w << 16)); }
DI float bfe2(const u32x2& v, int e) { const unsigned w = v[e >> 1]; return __uint_as_float((e & 1) ? (w & 0xffff0000u) : (w << 16)); }
DI void st8(bf16* p, const float* v) { u32x4 w; w.x = pk(v[0], v[1]); w.y = pk(v[2], v[3]); w.z = pk(v[4], v[5]); w.w = pk(v[6], v[7]); *(u32x4*)p = w; }
DI void st8g(bf16* p, const float* v) { u32x4 w; w.x = pk(v[0], v[1]); w.y = pk(v[2], v[3]); w.z = pk(v[4], v[5]); w.w = pk(v[6], v[7]); *(__attribute__((address_space(1))) u32x4*)p = w; }
DI void st8t(bf16* p, const float* v) {
#pragma unroll
    for (int e = 0; e < 8; ++e) *(__attribute__((address_space(1))) bf16*)(p + (size_t)e * TK) = f2b(v[e]); }
DI float sigmoid_(float x) { return 1.f / (1.f + __expf(-x)); }
DI float silu_(float x) { return x * sigmoid_(x); }
DI float logsigmoid_(float x) { return fminf(x, 0.f) - log1pf(expf(-fabsf(x))); }
DI int crow(int r, int hi) { return (r & 3) + 8 * (r >> 2) + 4 * hi; }
DI float wave_sum(float v) {
#pragma unroll
    for (int o = 1; o < 64; o <<= 1) v += __shfl_xor(v, o);
    return v; }
DI void getv(const f32x4& a, const f32x4& b, float* v) { v[0] = a[0]; v[1] = a[1]; v[2] = a[2]; v[3] = a[3]; v[4] = b[0]; v[5] = b[1]; v[6] = b[2]; v[7] = b[3]; }
DI bf16x8 ldfrag(const bf16* X, int ld, int r0, int k0, int lane) { return *(const bf16x8*)(X + (r0 + (lane & 31)) * ld + k0 + 8 * (lane >> 5)); }

DI int otid() { int t = threadIdx.x; asm volatile("" : "+v"(t)); return t; }
template <class T> DI T ldg(const T* p) { return *(const __attribute__((address_space(1))) T*)p; }
template <class T> DI void stg(T* p, const T& v) { *(__attribute__((address_space(1))) T*)p = v; }
DI void lbar() { asm volatile("s_waitcnt lgkmcnt(0)" ::: "memory"); __builtin_amdgcn_s_barrier(); asm volatile("" ::: "memory"); }
struct Args { const float* in[23]; float* out; unsigned char* ws; };

DI int srccol(int n) {
    const int tile = n >> 8, p = n & 255;
    if (tile < 6) return n;
    if (tile == 6) return 1552 + p;
    if (tile == 7) return 1808 + p;
    if (tile == 8) return 2064 + p;
    if (tile == 9 || tile == 10) {
        const int hh = (p >> 5) & 3, d = ((p >> 7) << 5) + (p & 31);
        if (tile == 9) return 2352 + hh * 64 + d;
        return hh < 2 ? 2608 + hh * 64 + d : 2736 + (hh - 2) * 64 + d;
    }
    if (tile < 15) return 2864 + (n - 11 * 256);
    if (p < 16) return 1536 + p;
    if (p < 48) return 2320 + (p - 16);
    return -1;
}

DI void transpose_item(const float* W, int Nsrc, bool perm, bf16* WT, int K, int item, int nblk, float* scr, int lane) {
    const int kb = item / nblk, nb = item - kb * nblk, k0 = 64 * kb, n0 = 32 * nb;
    const int n = n0 + (lane & 31); const int sc = perm ? srccol(n) : n;
#pragma unroll 8
    for (int i = 0; i < 32; ++i) { const int kk = 2 * i + (lane >> 5); scr[kk * 33 + (lane & 31)] = sc >= 0 ? W[(size_t)(k0 + kk) * Nsrc + sc] : 0.f; }
    asm volatile("s_waitcnt lgkmcnt(0)" ::: "memory");
    const int c = lane & 7;
#pragma unroll
    for (int j = 0; j < 4; ++j) { const int nn = (lane >> 3) + 8 * j; const float* s = scr + (8 * c) * 33 + nn;
        u32x4 o; o.x = pk(s[0 * 33], s[1 * 33]); o.y = pk(s[2 * 33], s[3 * 33]); o.z = pk(s[4 * 33], s[5 * 33]); o.w = pk(s[6 * 33], s[7 * 33]);
        *(u32x4*)(WT + (size_t)(n0 + nn) * K + k0 + 8 * c) = o; }
    asm volatile("s_waitcnt lgkmcnt(0)" ::: "memory");
}

DI void a_head(float* v, const float* gn, bool rope, const float* tab, int fq, float scale) {
    float ss = 0.f;
#pragma unroll
    for (int e = 0; e < 8; ++e) ss += v[e] * v[e];
    ss += __shfl_xor(ss, 16); ss += __shfl_xor(ss, 32);
    const float rinv = rsqrtf(ss * (1.f / 32.f) + EPS);
#pragma unroll
    for (int e = 0; e < 8; ++e) v[e] *= rinv * gn[e];
    if (rope) {
        const f32x4 ca = ldg((const f32x4*)tab), cb = ldg((const f32x4*)(tab + 4)), sa = ldg((const f32x4*)(tab + 8)), sb = ldg((const f32x4*)(tab + 12));
        float c[8], sn[8]; getv(ca, cb, c); getv(sa, sb, sn);
#pragma unroll
        for (int e = 0; e < 8; ++e) { const float p = __shfl_xor(v[e], 16); v[e] = (fq & 1) ? (p * sn[e] + v[e] * c[e]) : (v[e] * c[e] - p * sn[e]); }
    }
#pragma unroll
    for (int e = 0; e < 8; ++e) v[e] *= scale;
}
DI void d_head(float* v0, float* v1, const float* g0, const float* g1, bool rope, const float* tabr, const float* tabc, int fq, float scale) {
    float ss = 0.f;
#pragma unroll
    for (int e = 0; e < 8; ++e) ss += v0[e] * v0[e] + v1[e] * v1[e];
    ss += __shfl_xor(ss, 16); ss += __shfl_xor(ss, 32);
    const float rinv = rsqrtf(ss * (1.f / 64.f) + EPS);
#pragma unroll
    for (int e = 0; e < 8; ++e) { v0[e] *= rinv * g0[e]; v1[e] *= rinv * g1[e]; }
    if (rope) {
        const int fi = 8 * (fq & 1);
        { const f32x4 ca = ldg((const f32x4*)(tabr + fi)), cb = ldg((const f32x4*)(tabr + fi + 4)), sa = ldg((const f32x4*)(tabr + 16 + fi)), sb = ldg((const f32x4*)(tabr + 16 + fi + 4));
          float c[8], sn[8]; getv(ca, cb, c); getv(sa, sb, sn);
#pragma unroll
          for (int e = 0; e < 8; ++e) { const float p0 = __shfl_xor(v0[e], 32); v0[e] = (fq >= 2) ? (p0 * sn[e] + v0[e] * c[e]) : (v0[e] * c[e] - p0 * sn[e]); } }
        asm volatile("" ::: "memory");
        { const f32x4 ca = ldg((const f32x4*)(tabc + fi)), cb = ldg((const f32x4*)(tabc + fi + 4)), sa = ldg((const f32x4*)(tabc + 16 + fi)), sb = ldg((const f32x4*)(tabc + 16 + fi + 4));
          float c[8], sn[8]; getv(ca, cb, c); getv(sa, sb, sn);
#pragma unroll
          for (int e = 0; e < 8; ++e) { const float p1 = __shfl_xor(v1[e], 32); v1[e] = (fq >= 2) ? (p1 * sn[e] + v1[e] * c[e]) : (v1[e] * c[e] - p1 * sn[e]); } }
    }
#pragma unroll
    for (int e = 0; e < 8; ++e) { v0[e] *= scale; v1[e] *= scale; }
}

struct EpiIn {
    static constexpr bool PERM = true, AFTER_DRAIN = false;
#ifdef PAD_GIN
    static constexpr bool PADK = true;
#else
    static constexpr bool PADK = false;
#endif
    unsigned char* ws; int l;
    DI void operator()(const pg8::f32x4 (&acc)[2][2][4][2], const pg8::Unit& u, int wr, int wc, int fr_, int fq_) const {
        int fr = fr_, fq = fq_; asm volatile("" : "+v"(fr), "+v"(fq));
        const int b = u.pm >= 33 ? 1 : 0, pmi = u.pm - 33 * b; const bool is_ctx = (pmi == 0);
        const int j00 = pmi * 256 + wr * 64 + fr, pn = u.pn;
        const float* tabA = (const float*)(ws + WS_TABA); const float* tabD = (const float*)(ws + WS_TABD);
        const float* const* IN = (const float* const*)(ws + WS_ARGS);
#define ROWS_BEGIN _Pragma("unroll") for (int ai = 0; ai < 2; ++ai) _Pragma("unroll") for (int m = 0; m < 4; ++m) { \
        float v0[8], v1[8]; getv(acc[ai][0][m][0], acc[ai][0][m][1], v0); getv(acc[ai][1][m][0], acc[ai][1][m][1], v1); \
        const int j = j00 + ai * 128 + m * 16; const size_t mrow = (size_t)b * TK + j; const int t = is_ctx ? 0 : j - LC; (void)mrow; (void)t;
#define ROWS_END asm volatile("" ::: "memory"); }
        if (pn == 0 || pn == 1) {
            const float* gsrc = IN[pn == 0 ? 9 : 10] + l * 32 + 8 * fq;
            const float scale = pn == 0 ? 0.17677669529663687f * LOG2E : 1.f;
            bf16* dstb = (bf16*)(ws + (pn == 0 ? WS_QA : WS_KA));
            ROWS_BEGIN
                const float* tab = tabA + ((fq < 2) ? (t >> 6) : (t & 63)) * 16;
                float gn[8]; getv(ldg((const f32x4*)gsrc), ldg((const f32x4*)(gsrc + 4)), gn);
                a_head(v0, gn, !is_ctx, tab, fq, scale); a_head(v1, gn, !is_ctx, tab, fq, scale);
                { const int gi = wc, h = gi >> 1, c = gi & 1; st8g(dstb + (((b * 4 + h) * TK + j) * 64 + c * 32 + 8 * fq), v0); }
                { const int gi = 4 + wc, h = gi >> 1, c = gi & 1; st8g(dstb + (((b * 4 + h) * TK + j) * 64 + c * 32 + 8 * fq), v1); }
            ROWS_END
        } else if (pn == 2 || pn == 5 || pn == 8) {
            bf16* dstb = (bf16*)(ws + (pn == 2 ? WS_VAT : (pn == 5 ? WS_VBT : WS_VCT)));
            const int dv0 = (wc & 1) * 32 + 8 * fq;
            ROWS_BEGIN
                st8t(dstb + ((size_t)(b * 4 + (wc >> 1)) * 64 + dv0) * TK + j, v0);
                st8t(dstb + ((size_t)(b * 4 + 2 + (wc >> 1)) * 64 + dv0) * TK + j, v1);
            ROWS_END
        } else if (pn == 3 || pn == 4 || pn == 6) {
            bf16* dstb = (bf16*)(ws + (pn == 3 ? WS_QB : (pn == 4 ? WS_KB : WS_OB)));
            const int c0 = wc * 32 + 8 * fq;
            ROWS_BEGIN
                if (pn == 6) {
#pragma unroll
                    for (int e = 0; e < 8; ++e) { v0[e] = sigmoid_(v0[e]); v1[e] = sigmoid_(v1[e]); } }
                st8g(dstb + mrow * 256 + c0, v0); st8g(dstb + mrow * 256 + 128 + c0, v1);
            ROWS_END
        } else if (pn == 7) {
            bf16* dq = (bf16*)(ws + WS_QC); bf16* dk = (bf16*)(ws + WS_KC); const int c0 = wc * 32 + 8 * fq;
            ROWS_BEGIN
#pragma unroll
                for (int e = 0; e < 8; ++e) v0[e] *= 0.17677669529663687f;
                st8g(dq + mrow * 128 + c0, v0); st8g(dk + mrow * 128 + c0, v1);
            ROWS_END
        } else if (pn == 9) {
            bf16* dstb = (bf16*)(ws + WS_QD); const float* d_qn = IN[20] + l * 64;
            ROWS_BEGIN
                float g0[8], g1[8]; getv(ldg((const f32x4*)(d_qn + 8 * fq)), ldg((const f32x4*)(d_qn + 8 * fq + 4)), g0); getv(ldg((const f32x4*)(d_qn + 32 + 8 * fq)), ldg((const f32x4*)(d_qn + 36 + 8 * fq)), g1);
                d_head(v0, v1, g0, g1, !is_ctx, tabD + (t >> 6) * 32, tabD + (t & 63) * 32, fq, 0.125f * LOG2E);
                bf16* p = dstb + ((((b * 2 + (wc >> 1)) * 2 + (wc & 1)) * TK + j) * 64 + 8 * fq);
                st8g(p, v0); st8g(p + 32, v1);
            ROWS_END
        } else if (pn == 10) {
            if (wc < 2) {
                bf16* dstb = (bf16*)(ws + WS_KD); const float* d_kn = IN[21] + l * 64;
                ROWS_BEGIN
                    float g0[8], g1[8]; getv(ldg((const f32x4*)(d_kn + 8 * fq)), ldg((const f32x4*)(d_kn + 8 * fq + 4)), g0); getv(ldg((const f32x4*)(d_kn + 32 + 8 * fq)), ldg((const f32x4*)(d_kn + 36 + 8 * fq)), g1);
                    d_head(v0, v1, g0, g1, !is_ctx, tabD + (t >> 6) * 32, tabD + (t & 63) * 32, fq, 1.f);
                    bf16* p = dstb + (((b * 2 + wc) * TK + j) * 64 + 8 * fq);
                    st8g(p, v0); st8g(p + 32, v1);
                ROWS_END
            } else {
                bf16* dstb = (bf16*)(ws + WS_VDT);
                ROWS_BEGIN
                    bf16* p = dstb + ((size_t)(b * 2 + (wc - 2)) * 64 + 8 * fq) * TK + j;
                    st8t(p, v0); st8t(p + (size_t)32 * TK, v1);
                ROWS_END
            }
        } else if (pn < 15) {
            bf16* dstb = (bf16*)(ws + WS_GATE); const int c0 = (pn - 11) * 256 + wc * 32 + 8 * fq;
            ROWS_BEGIN
#pragma unroll
                for (int e = 0; e < 8; ++e) { v0[e] = silu_(v0[e]); v1[e] = silu_(v1[e]); }
                st8g(dstb + mrow * 1024 + c0, v0); st8g(dstb + mrow * 1024 + 128 + c0, v1);
            ROWS_END
        } else {
            float* dstb = (float*)(ws + WS_SMALL); const int p0 = wc * 32 + 8 * fq; const float* gate_b = IN[15] + l * 16;
            if (p0 < 48) {
                ROWS_BEGIN
                    if (p0 < 16) {
#pragma unroll
                        for (int e = 0; e < 8; ++e) { const int p = p0 + e, type = p >> 2; float x = v0[e] + ldg(gate_b + p); if (type & 1) x = logsigmoid_(x); v0[e] = x; } }
                    float* o = dstb + mrow * 48 + p0;
                    stg((f32x4*)o, (f32x4){v0[0], v0[1], v0[2], v0[3]}); stg((f32x4*)(o + 4), (f32x4){v0[4], v0[5], v0[6], v0[7]});
                ROWS_END
            }
        }
    }
};

struct EpiOut {
    static constexpr bool PERM = true, AFTER_DRAIN = false;
#ifdef PAD_GOUT
    static constexpr bool PADK = true;
#else
    static constexpr bool PADK = false;
#endif
    const float* xsrc; const float* csrc; float* xdst; float* cdst; const float* modv;
    DI void operator()(const pg8::f32x4 (&acc)[2][2][4][2], const pg8::Unit& u, int wr, int wc, int fr_, int fq_) const {
        int fr = fr_, fq = fq_; asm volatile("" : "+v"(fr), "+v"(fq));
        const int b = u.pm >= 33 ? 1 : 0, pmi = u.pm - 33 * b; const bool is_ctx = (pmi == 0);
        const int j00 = pmi * 256 + wr * 64 + fr, col0 = u.pn * 256 + wc * 32 + 8 * fq;
        const float* gt = modv + (is_ctx ? 2 : b) * 3072 + 2048 + col0;
        f32x4 g[2][2];
#pragma unroll
        for (int bj = 0; bj < 2; ++bj) { g[bj][0] = ldg((const f32x4*)(gt + bj * 128)); g[bj][1] = ldg((const f32x4*)(gt + bj * 128 + 4)); }
#pragma unroll
        for (int ai = 0; ai < 2; ++ai)
#pragma unroll
            for (int m = 0; m < 4; ++m) {
                const int j = j00 + ai * 128 + m * 16;
                const size_t off = (is_ctx ? (size_t)(b * LC + j) : (size_t)(b * T + j - LC)) * D + col0;
                const float* s = (is_ctx ? csrc : xsrc) + off; float* d = (is_ctx ? cdst : xdst) + off;
#pragma unroll
                for (int bj = 0; bj < 2; ++bj) {
                    const f32x4 r0 = ldg((const f32x4*)(s + bj * 128)), r1 = ldg((const f32x4*)(s + bj * 128 + 4));
                    stg((f32x4*)(d + bj * 128), (f32x4)(r0 + g[bj][0] * acc[ai][bj][m][0]));
                    stg((f32x4*)(d + bj * 128 + 4), (f32x4)(r1 + g[bj][1] * acc[ai][bj][m][1]));
                }
            }
    }
};
struct LatOrder {
    pg8::StaticOrder so;
    DI bool next(int i, pg8::Unit& u) const { if (!so.next(i, u)) return false; u.pm += 1 + (u.pm >= 32 ? 1 : 0); return true; }
    DI void a_ready(const pg8::Unit&) const {}
    DI void done(const pg8::Unit&) const {}
};

constexpr int KS_LD = 72, VS_LD = 68, KS_BYTES = 64 * KS_LD * 2, VS_BYTES = 64 * VS_LD * 2;
template <int MODE>
DI void attn_core(unsigned char* lds, const bf16* qrow, const bf16* Kb, const bf16* Vt, int n1, int js, int nt, int qpos, float negM,
                  f32x16 (&O)[MODE == 0 ? 2 : 1][2], float (&lsum)[MODE == 0 ? 2 : 1]) {
    constexpr int NC = MODE == 0 ? 2 : 1, KS = MODE == 0 ? 2 : 4;
    const int tid = otid(), lane = tid & 63, l32 = lane & 31, hi = lane >> 5;
    bf16* Ksm = (bf16*)lds; bf16* Vsm = (bf16*)(lds + 2 * KS_BYTES);
    bf16x8 qf[NC][KS];
#pragma unroll
    for (int c = 0; c < NC; ++c)
#pragma unroll
        for (int ks = 0; ks < KS; ++ks) qf[c][ks] = ldg((const bf16x8*)(qrow + c * (KS * 16) + 16 * ks + 8 * hi));
#pragma unroll
    for (int c = 0; c < NC; ++c) { lsum[c] = 0.f;
#pragma unroll
        for (int d = 0; d < 2; ++d)
#pragma unroll
            for (int i = 0; i < 16; ++i) O[c][d][i] = 0.f; }
    const int lr = tid >> 3, lc = (tid & 7) * 8;
    f32x16 L1;
#pragma unroll
    for (int i = 0; i < 16; ++i) L1[i] = 0.f;
    f32x16 L0;
#pragma unroll
    for (int i = 0; i < 16; ++i) L0[i] = 0.f;
    const bf16x8 ones = (bf16x8){0x3F80, 0x3F80, 0x3F80, 0x3F80, 0x3F80, 0x3F80, 0x3F80, 0x3F80};
    f32x16 CNEG;
#pragma unroll
    for (int i = 0; i < 16; ++i) CNEG[i] = negM;
    asm volatile("" : "+v"(CNEG));
    u32x4 kreg, vreg;
    { const int j0 = (0 < n1) ? 0 : js;
      kreg = ldg((const u32x4*)(Kb + (size_t)(j0 + lr) * 64 + lc)); vreg = ldg((const u32x4*)(Vt + (size_t)lr * TK + j0 + lc));
      *(u32x4*)(Ksm + lr * KS_LD + lc) = kreg; *(u32x2*)(Vsm + lr * VS_LD + lc) = (u32x2){vreg.x, vreg.y}; *(u32x2*)(Vsm + lr * VS_LD + lc + 4) = (u32x2){vreg.z, vreg.w}; }
    lbar();
#ifdef PAD_A
    asm volatile("s_nop 0");
#endif
    for (int it = 0; it < nt; ++it) {
        const int buf = it & 1; const int j0 = (it < n1) ? 64 * it : js + 64 * (it - n1);
        const bool more = (it + 1 < nt);
        if (more) { const int jn = (it + 1 < n1) ? 64 * (it + 1) : js + 64 * (it + 1 - n1);
            kreg = ldg((const u32x4*)(Kb + (size_t)(jn + lr) * 64 + lc)); vreg = ldg((const u32x4*)(Vt + (size_t)lr * TK + jn + lc)); }
        const bf16* Kc = Ksm + buf * (64 * KS_LD); const bf16* Vc = Vsm + buf * (64 * VS_LD);
        const bool masked = (MODE == 1) && (it >= n1);
#pragma unroll
        for (int kb = 0; kb < 2; ++kb) {
#ifdef PAD_KB
            if (kb == 1) asm volatile("s_nop 0");
#endif
            bf16x8 pf[NC][2];
#pragma unroll
            for (int c = 0; c < NC; ++c) {
                f32x16 S;
#pragma unroll
                for (int ks = 0; ks < KS; ++ks) { const bf16x8 a = *(const bf16x8*)(Kc + (32 * kb + l32) * KS_LD + c * (KS * 16) + 16 * ks + 8 * hi); S = MFMA32(a, qf[c][ks], ks == 0 ? CNEG : S); }
                float p[16];
#pragma unroll
                for (int i = 0; i < 16; ++i) p[i] = __builtin_amdgcn_exp2f(S[i]);
                if (MODE == 1) { if (masked) { const int kp0 = j0 - LC + 32 * kb + 4 * hi - qpos;
#pragma unroll
                    for (int i = 0; i < 16; ++i) { const int dlt = kp0 + (i & 3) + 8 * (i >> 2); p[i] = (dlt >= -128 && dlt <= 128) ? p[i] : 0.f; } } }
                if (c != 0) { float ps = 0.f;
#pragma unroll
                    for (int i = 8; i < 16; ++i) ps += p[i];
                    lsum[c] += ps; }
#pragma unroll
                for (int s = 0; s < 2; ++s) { u32x4 w; w.x = pk(p[8 * s], p[8 * s + 1]); w.y = pk(p[8 * s + 2], p[8 * s + 3]); w.z = pk(p[8 * s + 4], p[8 * s + 5]); w.w = pk(p[8 * s + 6], p[8 * s + 7]); pf[c][s] = __builtin_bit_cast(bf16x8, w); }
            }
#pragma unroll
            for (int dvb = 0; dvb < 2; ++dvb)
#pragma unroll
                for (int s = 0; s < 2; ++s) {
                    const bf16* vp = Vc + (32 * dvb + l32) * VS_LD + 32 * kb + 16 * s + 4 * hi;
                    const u32x2 lo = *(const u32x2*)vp, hh = *(const u32x2*)(vp + 8);
                    const bf16x8 va = __builtin_bit_cast(bf16x8, (u32x4){lo.x, lo.y, hh.x, hh.y});
#pragma unroll
                    for (int c = 0; c < NC; ++c) O[c][dvb] = MFMA32(va, pf[c][s], O[c][dvb]);
                    if (dvb == 0) L0 = MFMA32(ones, pf[0][s], L0);
                    if (dvb == 1 && s == 0 && NC == 2) L1 = MFMA32(ones, pf[NC - 1][0], L1);
                }
        }
        if (more) { bf16* Kn = Ksm + (buf ^ 1) * (64 * KS_LD); bf16* Vn = Vsm + (buf ^ 1) * (64 * VS_LD);
            *(u32x4*)(Kn + lr * KS_LD + lc) = kreg; *(u32x2*)(Vn + lr * VS_LD + lc) = (u32x2){vreg.x, vreg.y}; *(u32x2*)(Vn + lr * VS_LD + lc + 4) = (u32x2){vreg.z, vreg.w}; }
        lbar();
    }
#ifdef PAD_A
    asm volatile("s_nop 0");
#endif
    lsum[0] = 0.5f * L0[0];
    if (NC == 2) lsum[NC - 1] += 0.5f * L1[0];
}

DI void attnA_unit(unsigned char* lds, unsigned char* ws, int u, const float* subln, const float* misc) {
    const int tid = otid(), lane = tid & 63, wave = tid >> 6, l32 = lane & 31, hi = lane >> 5;
    int bh, jq0, nt;
    if (u < 256) { bh = u & 7; jq0 = LC + 256 * (u >> 3); nt = TK / 64; } else { bh = u - 256; jq0 = 0; nt = LC / 64; }
    const int b = bh >> 2, h = bh & 3, jq = jq0 + 32 * wave + l32;
    const bf16* qrow = (const bf16*)(ws + WS_QA) + ((size_t)bh * TK + jq) * 64;
    const bf16* Kb = (const bf16*)(ws + WS_KA) + (size_t)bh * TK * 64;
    const bf16* Vt = (const bf16*)(ws + WS_VAT) + (size_t)bh * 64 * TK;
    f32x16 O[2][2]; float lsum[2];
    attn_core<0>(lds, qrow, Kb, Vt, nt, 0, nt, 0, -misc[2], O, lsum);
    const float lam = misc[0], lam_init = misc[1];
    const float l0 = lsum[0] + __shfl_xor(lsum[0], 32), l1 = lsum[1] + __shfl_xor(lsum[1], 32);
    const float i0 = 1.f / l0, i1 = lam / l1;
    float ss = 0.f;
#pragma unroll
    for (int d = 0; d < 2; ++d)
#pragma unroll
        for (int i = 0; i < 16; ++i) { const float a = O[0][d][i] * i0 - O[1][d][i] * i1; O[0][d][i] = a; ss += a * a; }
    ss += __shfl_xor(ss, 32);
    const float rinv = rsqrtf(ss * (1.f / 64.f) + EPS) * (1.f - lam_init);
    const size_t mrow = (size_t)b * TK + jq;
    const bf16* gate = (const bf16*)(ws + WS_GATE) + mrow * 1024 + h * 64;
    bf16* y = (bf16*)(ws + WS_HXY) + mrow * 1024 + h * 64;
#pragma unroll
    for (int d = 0; d < 2; ++d)
#pragma unroll
        for (int g = 0; g < 4; ++g) {
            const int dv = 32 * d + 8 * g + 4 * hi;
            const u32x2 gg = ldg((const u32x2*)(gate + dv)); const f32x4 sb = ldg((const f32x4*)(subln + dv));
            u32x2 o; o.x = pk(O[0][d][4 * g] * rinv * sb[0] * bfe2(gg, 0), O[0][d][4 * g + 1] * rinv * sb[1] * bfe2(gg, 1));
            o.y = pk(O[0][d][4 * g + 2] * rinv * sb[2] * bfe2(gg, 2), O[0][d][4 * g + 3] * rinv * sb[3] * bfe2(gg, 3));
            stg((u32x2*)(y + dv), o);
        }
}

DI void attnD_unit(unsigned char* lds, unsigned char* ws, int u, const float* sink, const float* misc) {
    const int tid = otid(), lane = tid & 63, wave = tid >> 6, l32 = lane & 31, hi = lane >> 5;
    int b, kv, jq0, n1 = LC / 64, js = 0, nt = LC / 64, qpos = 0;
    if (u < 256) { const int x = u & 7; b = x >> 2; kv = (x >> 1) & 1; const int qblk = (x & 1) * 32 + (u >> 3), q0 = qblk * 128;
        jq0 = LC + q0; const int p0 = q0 - 128 < 0 ? 0 : q0 - 128, p1 = q0 + 256 > T ? T : q0 + 256; js = LC + p0; nt = n1 + (p1 - p0) / 64; qpos = q0 + 32 * (wave & 3) + l32; }
    else { const int x = u - 256; b = x >> 2; kv = (x >> 1) & 1; jq0 = 128 * (x & 1); }
    const int g = wave >> 2, jq = jq0 + 32 * (wave & 3) + l32;
    const bf16* qrow = (const bf16*)(ws + WS_QD) + ((size_t)((b * 2 + kv) * 2 + g) * TK + jq) * 64;
    const bf16* Kb = (const bf16*)(ws + WS_KD) + (size_t)(b * 2 + kv) * TK * 64;
    const bf16* Vt = (const bf16*)(ws + WS_VDT) + (size_t)(b * 2 + kv) * 64 * TK;
    f32x16 O[1][2]; float lsum[1];
    attn_core<1>(lds, qrow, Kb, Vt, n1, js, nt, qpos, -misc[3], O, lsum);
    const float l = lsum[0] + __shfl_xor(lsum[0], 32) + __builtin_amdgcn_exp2f(sink[kv * 2 + g] * LOG2E - misc[3]);
    const float inv = 1.f / l;
    const size_t mrow = (size_t)b * TK + jq; const int hc = 768 + (kv * 2 + g) * 64;
    const bf16* gate = (const bf16*)(ws + WS_GATE) + mrow * 1024 + hc;
    bf16* y = (bf16*)(ws + WS_HXY) + mrow * 1024 + hc;
#pragma unroll
    for (int d = 0; d < 2; ++d)
#pragma unroll
        for (int gq = 0; gq < 4; ++gq) {
            const int dv = 32 * d + 8 * gq + 4 * hi;
            const u32x2 gg = ldg((const u32x2*)(gate + dv));
            u32x2 o; o.x = pk(O[0][d][4 * gq] * inv * bfe2(gg, 0), O[0][d][4 * gq + 1] * inv * bfe2(gg, 1));
            o.y = pk(O[0][d][4 * gq + 2] * inv * bfe2(gg, 2), O[0][d][4 * gq + 3] * inv * bfe2(gg, 3));
            stg((u32x2*)(y + dv), o);
        }
}

DI int ord_cidx(int dir, int step) { return dir == 0 ? step : (step < 4 ? 3 - step : 135 - step); }
constexpr int LD64 = 72, LD32 = 40, HLD = 68;
constexpr int WC_OFF = 110592, WC_CW = 0, WC_CB = 1536, WC_BON = 2048, WC_CON = 2112, WC_WG = 2176, WC_BG = 6272, WC_N = 6528;
DI void fill_wcache(unsigned char* lds, const float* const* IN, int l) {
    float* WC = (float*)(lds + WC_OFF); const int tid = otid();
    const float* cw = IN[13] + l * 1536; const float* cb = IN[14] + l * 512; const float* bo = IN[16] + l * 64; const float* co = IN[19] + l * 64; const float* wg = IN[17] + l * 4096; const float* bg = IN[18] + l * 256;
    const f32x4 w0 = ldg((const f32x4*)wg + tid), w1 = ldg((const f32x4*)wg + 512 + tid);
    f32x4 c0 = (f32x4){0.f, 0.f, 0.f, 0.f}, c1 = c0;
    if (tid < 384) c0 = ldg((const f32x4*)cw + tid);
    const float* src = cb; int dsto = 0;
    if (tid < 128) { src = cb + 4 * tid; dsto = WC_CB + 4 * tid; }
    else if (tid < 144) { src = bo + 4 * (tid - 128); dsto = WC_BON + 4 * (tid - 128); }
    else if (tid < 160) { src = co + 4 * (tid - 144); dsto = WC_CON + 4 * (tid - 144); }
    else if (tid < 224) { src = bg + 4 * (tid - 160); dsto = WC_BG + 4 * (tid - 160); }
    if (tid < 224) c1 = ldg((const f32x4*)src);
    *(f32x4*)(WC + WC_WG + 4 * tid) = w0; *(f32x4*)(WC + WC_WG + 2048 + 4 * tid) = w1;
    if (tid < 384) *(f32x4*)(WC + WC_CW + 4 * tid) = c0;
    if (tid < 224) *(f32x4*)(WC + dsto) = c1;
    lbar();
}

struct ScanPtrs { float *CST, *NST, *SB, *SG, *SM, *SST, *GD; };
DI ScanPtrs scan_ptrs(unsigned char* ws) { ScanPtrs p; p.CST = (float*)(ws + WS_CST); p.NST = (float*)(ws + WS_NST); p.SB = (float*)(ws + WS_SSC); p.SG = p.SB + 16 * NCH; p.SM = p.SG + 16 * NCH;
    p.SST = (float*)(ws + WS_SST); p.GD = (float*)(ws + WS_GD); return p; }


template <int CTRL> DI float dpp_f(float oldv, float v) { return __int_as_float(__builtin_amdgcn_update_dpp(__float_as_int(oldv), __float_as_int(v), CTRL, 0xf, 0xf, false)); }
DI float rdl(float v, int l) { return __int_as_float(__builtin_amdgcn_readlane(__float_as_int(v), l)); }
DI float wscan_add(float v, int lane, bool rev) {
    const int r = lane >> 4;
    if (!rev) { v += dpp_f<0x111>(0.f, v); v += dpp_f<0x112>(0.f, v); v += dpp_f<0x114>(0.f, v); v += dpp_f<0x118>(0.f, v);
        const float t0 = rdl(v, 15), t1 = rdl(v, 31), t2 = rdl(v, 47);
        v += (r == 1 ? t0 : (r == 2 ? t0 + t1 : (r == 3 ? t0 + t1 + t2 : 0.f))); }
    else { v += dpp_f<0x101>(0.f, v); v += dpp_f<0x102>(0.f, v); v += dpp_f<0x104>(0.f, v); v += dpp_f<0x108>(0.f, v);
        const float t1 = rdl(v, 16), t2 = rdl(v, 32), t3 = rdl(v, 48);
        v += (r == 2 ? t3 : (r == 1 ? t2 + t3 : (r == 0 ? t1 + t2 + t3 : 0.f))); }
    return v; }
DI float wscan_max(float v, int lane, bool rev) {
    const int r = lane >> 4; const float NI = -INFINITY;
    if (!rev) { v = fmaxf(v, dpp_f<0x111>(NI, v)); v = fmaxf(v, dpp_f<0x112>(NI, v)); v = fmaxf(v, dpp_f<0x114>(NI, v)); v = fmaxf(v, dpp_f<0x118>(NI, v));
        const float t0 = rdl(v, 15), t1 = rdl(v, 31), t2 = rdl(v, 47);
        v = fmaxf(v, (r == 1 ? t0 : (r == 2 ? fmaxf(t0, t1) : (r == 3 ? fmaxf(fmaxf(t0, t1), t2) : NI)))); }
    else { v = fmaxf(v, dpp_f<0x101>(NI, v)); v = fmaxf(v, dpp_f<0x102>(NI, v)); v = fmaxf(v, dpp_f<0x104>(NI, v)); v = fmaxf(v, dpp_f<0x108>(NI, v));
        const float t1 = rdl(v, 16), t2 = rdl(v, 32), t3 = rdl(v, 48);
        v = fmaxf(v, (r == 2 ? t3 : (r == 1 ? fmaxf(t2, t3) : (r == 0 ? fmaxf(fmaxf(t1, t2), t3) : NI)))); }
    return v; }
DI float wave_max(float v) {
#pragma unroll
    for (int o = 1; o < 64; o <<= 1) v = fmaxf(v, __shfl_xor(v, o));
    return v; }

DI void conv8r(const u32x4& pv, const u32x4& c, const u32x4& nv, const float* w  , const float* cb, float mul, float* o) {
    float w0[8], w1[8], w2[8], bb[8];
    getv(*(const f32x4*)w, *(const f32x4*)(w + 4), w0); getv(*(const f32x4*)(w + 512), *(const f32x4*)(w + 516), w1);
    getv(*(const f32x4*)(w + 1024), *(const f32x4*)(w + 1028), w2); getv(*(const f32x4*)cb, *(const f32x4*)(cb + 4), bb);
#pragma unroll
    for (int e = 0; e < 8; ++e) { const float y = w0[e] * bfe(pv, e) + w1[e] * bfe(c, e) + w2[e] * bfe(nv, e) + bb[e]; o[e] = silu_(y) * mul; }
}
DI void load3(const bf16* p, bool hasp, bool hasn, u32x4& pv, u32x4& c, u32x4& nv) {
    c = ldg((const u32x4*)p); pv = (u32x4){0u, 0u, 0u, 0u}; nv = pv;
    if (hasp) pv = ldg((const u32x4*)(p - 256));
    if (hasn) nv = ldg((const u32x4*)(p + 256));
}

struct MaPre { float lf, li; u32x4 kp, kc, kn, vraw; };
DI MaPre mlstm_a_load(unsigned char* ws, int tsk) {
    const int bh = tsk / NCH, cidx = tsk - bh * NCH, b = bh >> 2, h = bh & 3, tid = otid();
    const size_t m0 = (size_t)b * TK + cidx * 64; MaPre p; p.lf = 0.f; p.li = 0.f;
    if (tid < 128) { const int dir = tid >> 6, s = tid & 63; const float* sm = (const float*)(ws + WS_SMALL) + (m0 + s) * 48; p.lf = ldg(sm + (2 * dir + 1) * 4 + h); p.li = ldg(sm + (2 * dir) * 4 + h); }
    const int s = tid >> 3, d0 = (tid & 7) * 8;
    const bool hasp = (s > 0) || (cidx != 0 && cidx != 4), hasn = (s < 63) || (cidx != 3 && cidx != NCH - 1);
    load3((const bf16*)(ws + WS_KB) + (m0 + s) * 256 + h * 64 + d0, hasp, hasn, p.kp, p.kc, p.kn);
    p.vraw = ldg((const u32x4*)((const bf16*)(ws + WS_VBT) + ((size_t)bh * 64 + s) * TK + cidx * 64 + d0));
    return p;
}
DI void mlstm_a_run(unsigned char* lds, unsigned char* ws, int tsk, const MaPre& p, const float* conv_w, const float* conv_b) {
    const int bh = tsk / NCH, cidx = tsk - bh * NCH, h = bh & 3;
    const int tid = otid(), lane = tid & 63, wave = tid >> 6; const ScanPtrs sp = scan_ptrs(ws);
    bf16* KT = (bf16*)lds; bf16* VW = (bf16*)(lds + 9216); float* WE = (float*)(lds + 27648);
    if (wave < 2) { const int dir = wave; const float tot = wave_sum(p.lf), pre = wscan_add(p.lf, lane, false);
        const float g = (dir == 0 ? tot - pre : pre - p.lf) + p.li; const float G = wave_max(g);
        WE[dir * 64 + lane] = expf(g - G);
        if (lane == 0) { stg(sp.SB + (bh * 2 + dir) * NCH + cidx, tot); stg(sp.SG + (bh * 2 + dir) * NCH + cidx, G); } }
    { const int s = tid >> 3, d0 = (tid & 7) * 8; float kv[8];
      conv8r(p.kp, p.kc, p.kn, conv_w + 256 + h * 64 + d0, conv_b + 256 + h * 64 + d0, 0.125f, kv);
#pragma unroll
      for (int e = 0; e < 8; ++e) KT[(d0 + e) * LD64 + s] = f2b(kv[e]); }
    lbar();
    { const int v = tid >> 3, s0 = (tid & 7) * 8;
#pragma unroll
      for (int dir = 0; dir < 2; ++dir) { float o[8];
#pragma unroll
          for (int e = 0; e < 8; ++e) o[e] = bfe(p.vraw, e) * WE[dir * 64 + s0 + e];
          st8(VW + dir * (64 * LD64) + v * LD64 + s0, o); } }
    { const int o = tid >> 2, part = tid & 3, dir = o >> 6, d = o & 63; float a = 0.f;
#pragma unroll
      for (int q = 0; q < 16; ++q) { const int s = part * 16 + q; a += WE[dir * 64 + s] * b2f(KT[d * LD64 + s]); }
      a += __shfl_xor(a, 1); a += __shfl_xor(a, 2);
      if (part == 0) stg(sp.NST + ((size_t)(bh * 2 + dir) * NCH + cidx) * 64 + d, a); }
    lbar();
    { const int dir = wave >> 2, tr = (wave >> 1) & 1, tc = wave & 1, l32 = lane & 31, hi = lane >> 5;
      f32x16 acc;
#pragma unroll
      for (int i = 0; i < 16; ++i) acc[i] = 0.f;
#pragma unroll
      for (int ks = 0; ks < 4; ++ks) acc = MFMA32(ldfrag(VW + dir * (64 * LD64), LD64, 32 * tr, 16 * ks, lane), ldfrag(KT, LD64, 32 * tc, 16 * ks, lane), acc);
      float* dst = sp.CST + ((size_t)(bh * 2 + dir) * NCH + cidx) * 4096;
#pragma unroll
      for (int i = 0; i < 16; ++i) stg(dst + (32 * tr + crow(i, hi)) * 64 + 32 * tc + l32, acc[i]); }
    lbar();
}

struct GlPre { f32x4 lr[4]; u32x4 kraw, qraw, vraw; };
DI GlPre gla_load(unsigned char* ws, int tsk, bool need_q) {
    const int bh = tsk / NCH, cidx = tsk - bh * NCH, b = bh >> 2, h = bh & 3, tid = otid(), lane = tid & 63, wave = tid >> 6, z = wave >> 2, dg = wave & 3;
    const size_t m0 = (size_t)b * TK + cidx * 64; GlPre p;
    const float* sm = (const float*)(ws + WS_SMALL) + (m0 + lane) * 48 + 16 + z * 16;
#pragma unroll
    for (int q = 0; q < 4; ++q) p.lr[q] = ldg((const f32x4*)(sm + 4 * q));
    p.kraw = ldg((const u32x4*)((const bf16*)(ws + WS_KC) + (m0 + lane) * 128 + h * 32 + dg * 8));
    p.qraw = (u32x4){0u, 0u, 0u, 0u}; if (need_q) p.qraw = ldg((const u32x4*)((const bf16*)(ws + WS_QC) + (m0 + lane) * 128 + h * 32 + dg * 8));
    p.vraw = ldg((const u32x4*)((const bf16*)(ws + WS_VCT) + ((size_t)bh * 64 + (tid >> 3)) * TK + cidx * 64 + (tid & 7) * 8));
    return p;
}
DI void gla_bc(const GlPre& p, int h, int z, int dg, int lane, const float* wg, const float* bg, float* bc) {
    const float* wgp = wg + (z * 16) * 128 + h * 32 + dg * 8;
#pragma unroll
    for (int e = 0; e < 8; ++e) bc[e] = bg[z * 128 + h * 32 + dg * 8 + e];
#pragma unroll
    for (int r = 0; r < 16; ++r) { const float lr = p.lr[r >> 2][r & 3];
#pragma unroll
        for (int e = 0; e < 8; ++e) bc[e] += lr * wgp[r * 128 + e]; }
#pragma unroll
    for (int e = 0; e < 8; ++e) bc[e] = wscan_add((fminf(bc[e], 0.f) - __logf(1.f + __expf(-fabsf(bc[e])))) * (1.f / 16.f), lane, z == 1);
}
DI void gla_a_run(unsigned char* lds, unsigned char* ws, int tsk, const GlPre& p, const float* wg, const float* bg) {
    const int bh = tsk / NCH, cidx = tsk - bh * NCH, h = bh & 3;
    const int tid = otid(), lane = tid & 63, wave = __builtin_amdgcn_readfirstlane(tid >> 6), z = wave >> 2, dg = wave & 3; const ScanPtrs sp = scan_ptrs(ws);
    bf16* KH = (bf16*)lds; bf16* VT = (bf16*)(lds + 9216);
    float bc[8]; gla_bc(p, h, z, dg, lane, wg, bg, bc);
#pragma unroll
    for (int e = 0; e < 8; ++e) { const float bend = __shfl(bc[e], z == 0 ? 63 : 0);
        KH[z * (32 * LD64) + (dg * 8 + e) * LD64 + lane] = f2b(bfe(p.kraw, e) * expf(bend - bc[e]));
        if (lane == 0) stg(sp.GD + ((size_t)(bh * 2 + z) * NCH + cidx) * 32 + dg * 8 + e, expf(bend)); }
    *(u32x4*)(VT + (tid >> 3) * LD64 + (tid & 7) * 8) = p.vraw;
    lbar();
    if (wave < 4) { const int zz = wave >> 1, vc = wave & 1, l32 = lane & 31, hi = lane >> 5;
      f32x16 acc;
#pragma unroll
      for (int i = 0; i < 16; ++i) acc[i] = 0.f;
#pragma unroll
      for (int ks = 0; ks < 4; ++ks) acc = MFMA32(ldfrag(KH + zz * (32 * LD64), LD64, 0, 16 * ks, lane), ldfrag(VT, LD64, 32 * vc, 16 * ks, lane), acc);
      float* dst = sp.SST + ((size_t)(bh * 2 + zz) * NCH + cidx) * 2048;
#pragma unroll
      for (int i = 0; i < 16; ++i) stg(dst + crow(i, hi) * 64 + 32 * vc + l32, acc[i]); }
    lbar();
}
DI void scan_b(unsigned char* lds, unsigned char* ws, int t) {
    const int tid = otid(); const ScanPtrs sp = scan_ptrs(ws);
    float* DEC = (float*)lds; float* SCL = DEC + 256; float* XA = SCL + 256; float* XB = XA + 256; float* GS = XB + 256; float* BS = GS + 256; float* GDs = (float*)lds;
    if (t < 144) {
        const int scan = t < 128 ? (t >> 3) : (t - 128), dir = scan & 1;
        float bv = 0.f, gv = 0.f;
        if (tid < 132) { const int cidx = ord_cidx(dir, tid); bv = ldg(sp.SB + scan * NCH + cidx); gv = ldg(sp.SG + scan * NCH + cidx); }
        if (tid < 256) { XA[tid] = bv; BS[tid] = bv; GS[tid] = gv; }
        lbar();
        for (int off = 1; off < 256; off <<= 1) { float v = 0.f; if (tid < 256 && tid >= off) v = XA[tid - off]; lbar(); if (tid < 256) XA[tid] += v; lbar(); }
        if (tid < 256) XB[tid] = tid < 132 ? GS[tid] - XA[tid] : -INFINITY;
        lbar();
        for (int off = 1; off < 256; off <<= 1) { float v = -INFINITY; if (tid < 256 && tid >= off) v = XB[tid - off]; lbar(); if (tid < 256) XB[tid] = fmaxf(XB[tid], v); lbar(); }
        if (tid < 132) {
            const float m0 = tid == 0 ? 0.f : XA[tid - 1] + fmaxf(0.f, XB[tid - 1]);
            const float m1 = XA[tid] + fmaxf(0.f, XB[tid]);
            DEC[tid] = expf(BS[tid] + m0 - m1); SCL[tid] = expf(GS[tid] - m1);
            if (t >= 128) stg(sp.SM + scan * NCH + ord_cidx(dir, tid), m0);
        }
        lbar();
        if (t < 128 || tid < 64) {
            const int stride = t < 128 ? 4096 : 64;
            float* buf = (t < 128 ? sp.CST + (size_t)scan * NCH * 4096 + (t & 7) * 512 : sp.NST + (size_t)scan * NCH * 64) + tid;
            float run = 0.f;
            for (int s0 = 0; s0 < 132; s0 += 33) { float dl[33];
#pragma unroll
                for (int u = 0; u < 33; ++u) dl[u] = ldg(buf + (size_t)ord_cidx(dir, s0 + u) * stride);
#pragma unroll
                for (int u = 0; u < 33; ++u) { stg(buf + (size_t)ord_cidx(dir, s0 + u) * stride, run); run = DEC[s0 + u] * run + SCL[s0 + u] * dl[u]; } }
        }
        lbar();
    } else {
        const int scan = (t - 144) >> 2, dir = scan & 1, elem = ((t - 144) & 3) * 512 + tid, d = elem >> 6;
        for (int idx = tid; idx < 132 * 32; idx += 512) GDs[idx] = ldg(sp.GD + ((size_t)scan * NCH + ord_cidx(dir, idx >> 5)) * 32 + (idx & 31));
        lbar();
        float* buf = sp.SST + (size_t)scan * NCH * 2048 + elem; float run = 0.f;
        for (int s0 = 0; s0 < 132; s0 += 33) { float dl[33];
#pragma unroll
            for (int u = 0; u < 33; ++u) dl[u] = ldg(buf + (size_t)ord_cidx(dir, s0 + u) * 2048);
#pragma unroll
            for (int u = 0; u < 33; ++u) { stg(buf + (size_t)ord_cidx(dir, s0 + u) * 2048, run); run = GDs[(s0 + u) * 32 + d] * run + dl[u]; } }
        lbar();
    }
}

DI void chunk_finish(const float* H, unsigned char* ws, size_t m0, int colbase, int h, const float* outn, bool use_o, const u32x4& gg, const u32x4& og) {
    const int tid = otid(), t = tid >> 3, v8 = (tid & 7) * 8;
    float hs[8]; float ss = 0.f;
#pragma unroll
    for (int e = 0; e < 8; ++e) { hs[e] = H[t * HLD + v8 + e] + H[64 * HLD + t * HLD + v8 + e]; ss += hs[e] * hs[e]; }
    ss += __shfl_xor(ss, 1); ss += __shfl_xor(ss, 2); ss += __shfl_xor(ss, 4);
    const float rinv = rsqrtf(ss * (1.f / 64.f) + EPS);
    const size_t mrow = m0 + t;
    float o[8];
#pragma unroll
    for (int e = 0; e < 8; ++e) { float x = hs[e] * rinv * outn[v8 + e] * bfe(gg, e); if (use_o) x *= bfe(og, e); o[e] = x; }
    st8g((bf16*)(ws + WS_HXY) + mrow * 1024 + colbase + h * 64 + v8, o);
}

struct McPre { float lf, li, nl, mp; u32x4 qp, qc, qn, kp, kc, kn, vraw, gg, og; f32x4 c[2][2]; };
DI McPre mlstm_c_load(unsigned char* ws, int tsk) {
    const int bh = tsk / NCH, cidx = tsk - bh * NCH, b = bh >> 2, h = bh & 3, tid = otid();
    const size_t m0 = (size_t)b * TK + cidx * 64; const ScanPtrs sp = scan_ptrs(ws); McPre p; p.lf = 0.f; p.li = 0.f; p.nl = 0.f; p.mp = 0.f;
    if (tid < 128) { const int dir = tid >> 6, s = tid & 63; const float* sm = (const float*)(ws + WS_SMALL) + (m0 + s) * 48; p.lf = ldg(sm + (2 * dir + 1) * 4 + h); p.li = ldg(sm + (2 * dir) * 4 + h);
        p.nl = ldg(sp.NST + ((size_t)(bh * 2 + dir) * NCH + cidx) * 64 + s); p.mp = ldg(sp.SM + (bh * 2 + dir) * NCH + cidx); }
    const int s = tid >> 3, d0 = (tid & 7) * 8;
    const bool hasp = (s > 0) || (cidx != 0 && cidx != 4), hasn = (s < 63) || (cidx != 3 && cidx != NCH - 1);
    load3((const bf16*)(ws + WS_QB) + (m0 + s) * 256 + h * 64 + d0, hasp, hasn, p.qp, p.qc, p.qn);
    load3((const bf16*)(ws + WS_KB) + (m0 + s) * 256 + h * 64 + d0, hasp, hasn, p.kp, p.kc, p.kn);
    p.vraw = ldg((const u32x4*)((const bf16*)(ws + WS_VBT) + ((size_t)bh * 64 + s) * TK + cidx * 64 + d0));
#pragma unroll
    for (int dir = 0; dir < 2; ++dir) { const float* src = sp.CST + ((size_t)(bh * 2 + dir) * NCH + cidx) * 4096 + s * 64 + d0; p.c[dir][0] = ldg((const f32x4*)src); p.c[dir][1] = ldg((const f32x4*)(src + 4)); }
    p.gg = ldg((const u32x4*)((const bf16*)(ws + WS_GATE) + (m0 + s) * 1024 + 256 + h * 64 + d0));
    p.og = ldg((const u32x4*)((const bf16*)(ws + WS_OB) + (m0 + s) * 256 + h * 64 + d0));
    return p;
}
DI void mlstm_c_run(unsigned char* lds, unsigned char* ws, int tsk, const McPre& p, const float* conv_w, const float* conv_b, const float* outn) {
    const int bh = tsk / NCH, cidx = tsk - bh * NCH, b = bh >> 2, h = bh & 3;
    const int tid = otid(), lane = tid & 63, wave = tid >> 6, l32 = lane & 31, hi = lane >> 5;
    const size_t m0 = (size_t)b * TK + cidx * 64;
    bf16* QS = (bf16*)lds; bf16* KSm = (bf16*)(lds + 9216); bf16* VT = (bf16*)(lds + 18432); bf16* CB = (bf16*)(lds + 27648); bf16* PL = (bf16*)(lds + 46080);
    float* H = (float*)(lds + 64512); float* AA = (float*)(lds + 99328); float* MU = AA + 128; float* GI = MU + 128; float* EN = GI + 128;
    float* NQ = EN + 128; float* RS = NQ + 128; float* NL = RS + 256;
    if (wave < 2) { const int dir = wave; const bool rev = dir == 1;
        const float bcum = wscan_add(p.lf, lane, rev), a = p.li - bcum, cm = wscan_max(a, lane, rev), mu = fmaxf(p.mp, cm);
        AA[dir * 64 + lane] = a; MU[dir * 64 + lane] = mu; GI[dir * 64 + lane] = expf(p.mp - mu); EN[dir * 64 + lane] = expf(-bcum - mu); NL[dir * 64 + lane] = p.nl; }
    { const int s = tid >> 3, d0 = (tid & 7) * 8; float qv[8], kv[8];
      conv8r(p.qp, p.qc, p.qn, conv_w + h * 64 + d0, conv_b + h * 64 + d0, 1.f, qv);
      conv8r(p.kp, p.kc, p.kn, conv_w + 256 + h * 64 + d0, conv_b + 256 + h * 64 + d0, 0.125f, kv);
      st8(QS + s * LD64 + d0, qv); st8(KSm + s * LD64 + d0, kv);
      *(u32x4*)(VT + s * LD64 + d0) = p.vraw;
#pragma unroll
      for (int dir = 0; dir < 2; ++dir) { float cv[8]; getv(p.c[dir][0], p.c[dir][1], cv); st8(CB + dir * (64 * LD64) + s * LD64 + d0, cv); } }
    lbar();
    { const int o = tid >> 2, part = tid & 3, dir = o >> 6, t = o & 63; float a = 0.f;
#pragma unroll
      for (int q = 0; q < 16; ++q) { const int d = part * 16 + q; a += NL[dir * 64 + d] * b2f(QS[t * LD64 + d]); }
      a += __shfl_xor(a, 1); a += __shfl_xor(a, 2);
      if (part == 0) NQ[dir * 64 + t] = a; }
    { const int dir = wave >> 2, tr = (wave >> 1) & 1, tc = wave & 1;
      f32x16 S;
#pragma unroll
      for (int i = 0; i < 16; ++i) S[i] = 0.f;
#pragma unroll
      for (int ks = 0; ks < 4; ++ks) S = MFMA32(ldfrag(KSm, LD64, 32 * tr, 16 * ks, lane), ldfrag(QS, LD64, 32 * tc, 16 * ks, lane), S);
      const int t = 32 * tc + l32; const float mu = MU[dir * 64 + t]; float rs = 0.f;
#pragma unroll
      for (int g = 0; g < 4; ++g) { float pw[4];
#pragma unroll
          for (int e = 0; e < 4; ++e) { const int s = 32 * tr + 8 * g + 4 * hi + e; const bool ok = dir == 0 ? (s <= t) : (s >= t);
              pw[e] = ok ? S[4 * g + e] * __expf(AA[dir * 64 + s] - mu) : 0.f; rs += pw[e]; }
          *(u32x2*)(PL + dir * (64 * LD64) + t * LD64 + 32 * tr + 8 * g + 4 * hi) = (u32x2){pk(pw[0], pw[1]), pk(pw[2], pw[3])}; }
      rs += __shfl_xor(rs, 32);
      if (hi == 0) RS[(dir * 2 + tr) * 64 + t] = rs; }
    lbar();
    { const int dir = wave >> 2, vr = (wave >> 1) & 1, tc = wave & 1;
      f32x16 aP, aC;
#pragma unroll
      for (int i = 0; i < 16; ++i) { aP[i] = 0.f; aC[i] = 0.f; }
#pragma unroll
      for (int ks = 0; ks < 4; ++ks) { aP = MFMA32(ldfrag(VT, LD64, 32 * vr, 16 * ks, lane), ldfrag(PL + dir * (64 * LD64), LD64, 32 * tc, 16 * ks, lane), aP);
          aC = MFMA32(ldfrag(CB + dir * (64 * LD64), LD64, 32 * vr, 16 * ks, lane), ldfrag(QS, LD64, 32 * tc, 16 * ks, lane), aC); }
      const int t = 32 * tc + l32; const float gi = GI[dir * 64 + t];
      const float nq = RS[(dir * 2) * 64 + t] + RS[(dir * 2 + 1) * 64 + t] + gi * NQ[dir * 64 + t];
      const float inv = 1.f / fmaxf(fabsf(nq), EN[dir * 64 + t]);
#pragma unroll
      for (int i = 0; i < 16; ++i) H[dir * (64 * HLD) + t * HLD + 32 * vr + crow(i, hi)] = (aP[i] + gi * aC[i]) * inv; }
    lbar();
    chunk_finish(H, ws, m0, 256, h, outn, true, p.gg, p.og);
    lbar();
}

struct GcPre { GlPre g; u32x4 gg; float st[2][4]; };
DI GcPre gla_c_load(unsigned char* ws, int tsk) {
    const int bh = tsk / NCH, cidx = tsk - bh * NCH, b = bh >> 2, h = bh & 3, tid = otid(); const ScanPtrs sp = scan_ptrs(ws);
    const size_t m0 = (size_t)b * TK + cidx * 64; GcPre p; p.g = gla_load(ws, tsk, true);
    p.gg = ldg((const u32x4*)((const bf16*)(ws + WS_GATE) + (m0 + (tid >> 3)) * 1024 + 512 + h * 64 + (tid & 7) * 8));
#pragma unroll
    for (int z = 0; z < 2; ++z) { const float* src = sp.SST + ((size_t)(bh * 2 + z) * NCH + cidx) * 2048;
#pragma unroll
        for (int it = 0; it < 4; ++it) p.st[z][it] = ldg(src + tid + 512 * it); }
    return p;
}
DI void gla_c_run(unsigned char* lds, unsigned char* ws, int tsk, const GcPre& p, const float* wg, const float* bg, const float* outn) {
    const int bh = tsk / NCH, cidx = tsk - bh * NCH, b = bh >> 2, h = bh & 3;
    const int tid = otid(), lane = tid & 63, wave = tid >> 6, l32 = lane & 31, hi = lane >> 5;
    const size_t m0 = (size_t)b * TK + cidx * 64;
    bf16* QT = (bf16*)lds; bf16* KT2 = (bf16*)(lds + 10240); bf16* QH = (bf16*)(lds + 20480); bf16* VT = (bf16*)(lds + 30720);
    bf16* ST = (bf16*)(lds + 39936); bf16* PL = (bf16*)(lds + 50176); float* H = (float*)(lds + 68608);
    { const int wu = __builtin_amdgcn_readfirstlane(wave), z = wu >> 2, dg = wu & 3; float bc[8]; gla_bc(p.g, h, z, dg, lane, wg, bg, bc);
      float q1[8], k1[8], q2[8];
#pragma unroll
      for (int e = 0; e < 8; ++e) { const float rf = __shfl(bc[e], 32); const float qv = bfe(p.g.qraw, e);
          q1[e] = qv * __expf(bc[e] - rf); k1[e] = bfe(p.g.kraw, e) * __expf(rf - bc[e]); q2[e] = qv * __expf(bc[e]); }
      st8(QT + z * (64 * LD32) + lane * LD32 + dg * 8, q1); st8(KT2 + z * (64 * LD32) + lane * LD32 + dg * 8, k1); st8(QH + z * (64 * LD32) + lane * LD32 + dg * 8, q2); }
    *(u32x4*)(VT + (tid >> 3) * LD64 + (tid & 7) * 8) = p.g.vraw;
#pragma unroll
    for (int z = 0; z < 2; ++z)
#pragma unroll
        for (int it = 0; it < 4; ++it) { const int idx = tid + 512 * it, d = idx >> 6, v = idx & 63; ST[z * (64 * LD32) + v * LD32 + d] = f2b(p.st[z][it]); }
    lbar();
    { const int z = wave >> 2, tr = (wave >> 1) & 1, tc = wave & 1;
      f32x16 S;
#pragma unroll
      for (int i = 0; i < 16; ++i) S[i] = 0.f;
#pragma unroll
      for (int ks = 0; ks < 2; ++ks) S = MFMA32(ldfrag(KT2 + z * (64 * LD32), LD32, 32 * tr, 16 * ks, lane), ldfrag(QT + z * (64 * LD32), LD32, 32 * tc, 16 * ks, lane), S);
      const int t = 32 * tc + l32;
#pragma unroll
      for (int g = 0; g < 4; ++g) { float pw[4];
#pragma unroll
          for (int e = 0; e < 4; ++e) { const int s = 32 * tr + 8 * g + 4 * hi + e; const bool ok = z == 0 ? (s <= t) : (s >= t); pw[e] = ok ? S[4 * g + e] : 0.f; }
          *(u32x2*)(PL + z * (64 * LD64) + t * LD64 + 32 * tr + 8 * g + 4 * hi) = (u32x2){pk(pw[0], pw[1]), pk(pw[2], pw[3])}; } }
    lbar();
    { const int z = wave >> 2, vr = (wave >> 1) & 1, tc = wave & 1;
      f32x16 a;
#pragma unroll
      for (int i = 0; i < 16; ++i) a[i] = 0.f;
#pragma unroll
      for (int ks = 0; ks < 4; ++ks) a = MFMA32(ldfrag(VT, LD64, 32 * vr, 16 * ks, lane), ldfrag(PL + z * (64 * LD64), LD64, 32 * tc, 16 * ks, lane), a);
#pragma unroll
      for (int ks = 0; ks < 2; ++ks) a = MFMA32(ldfrag(ST + z * (64 * LD32), LD32, 32 * vr, 16 * ks, lane), ldfrag(QH + z * (64 * LD32), LD32, 32 * tc, 16 * ks, lane), a);
      const int t = 32 * tc + l32;
#pragma unroll
      for (int i = 0; i < 16; ++i) H[z * (64 * HLD) + t * HLD + 32 * vr + crow(i, hi)] = a[i]; }
    lbar();
    chunk_finish(H, ws, m0, 512, h, outn, false, p.gg, p.gg);
    lbar();
}


constexpr int W48_LD = 1032, W48_BYTES = 48 * W48_LD * 2;
DI void mini_proj(unsigned char* lds, unsigned char* ws, int first_tile, int tile_step, int ntiles, const bf16* Wt48, const float* gate_b) {
    const int tid = otid(), lane = tid & 63, wave = tid >> 6, l32 = lane & 31, hi = lane >> 5;
    bf16* WL = (bf16*)lds; bf16* AS = (bf16*)(lds + W48_BYTES);
    if (first_tile >= ntiles) return;
    for (int i = tid; i < 48 * 128; i += 512) { const int n = i >> 7, c = (i & 127) * 8; *(u32x4*)(WL + n * W48_LD + c) = ldg((const u32x4*)(Wt48 + (size_t)n * 1024 + c)); }
    const int brow1 = (32 + l32) < 48 ? 32 + l32 : 47;
    for (int pm = first_tile; pm < ntiles; pm += tile_step) {
        const bf16* A = (const bf16*)(ws + WS_HXY) + (size_t)pm * 256 * 1024;
        u32x4 ar[4][4];
#pragma unroll
        for (int j = 0; j < 4; ++j)
#pragma unroll
            for (int q = 0; q < 4; ++q) { const int idx = tid + 512 * q; ar[j][q] = ldg((const u32x4*)(A + (size_t)(idx >> 3) * 1024 + 64 * j + (idx & 7) * 8)); }
        f32x16 acc0, acc1;
#pragma unroll
        for (int i = 0; i < 16; ++i) { acc0[i] = 0.f; acc1[i] = 0.f; }
        lbar();
        for (int c4 = 0; c4 < 16; c4 += 4) {
#pragma unroll
            for (int j = 0; j < 4; ++j) { const int c = c4 + j;
#pragma unroll
                for (int q = 0; q < 4; ++q) { const int idx = tid + 512 * q; *(u32x4*)(AS + (idx >> 3) * LD64 + (idx & 7) * 8) = ar[j][q]; }
                if (c + 4 < 16) {
#pragma unroll
                    for (int q = 0; q < 4; ++q) { const int idx = tid + 512 * q; ar[j][q] = ldg((const u32x4*)(A + (size_t)(idx >> 3) * 1024 + 64 * (c + 4) + (idx & 7) * 8)); } }
                lbar();
#pragma unroll
                for (int ks = 0; ks < 4; ++ks) { const bf16x8 a = ldfrag(AS, LD64, 32 * wave, 16 * ks, lane);
                    const bf16x8 b0 = *(const bf16x8*)(WL + l32 * W48_LD + 64 * c + 16 * ks + 8 * hi), b1 = *(const bf16x8*)(WL + brow1 * W48_LD + 64 * c + 16 * ks + 8 * hi);
                    acc0 = MFMA32(a, b0, acc0); acc1 = MFMA32(a, b1, acc1); }
                lbar();
            }
        }
        float* dst = (float*)(ws + WS_SMALL);
        const size_t r0 = (size_t)pm * 256 + wave * 32;
        const float gb = l32 < 16 ? ldg(gate_b + l32) : 0.f; const bool ls = l32 < 16 && ((l32 >> 2) & 1);
#pragma unroll
        for (int i = 0; i < 16; ++i) { float x = acc0[i] + gb; if (ls) x = logsigmoid_(x); stg(dst + (r0 + crow(i, hi)) * 48 + l32, x); }
        if (l32 < 16) {
#pragma unroll
            for (int i = 0; i < 16; ++i) stg(dst + (r0 + crow(i, hi)) * 48 + 32 + l32, acc1[i]); }
    }
    lbar();
}

#ifndef DUP_MASK
#define DUP_MASK 0
#endif
#define XB_TMO      128
#define XB_XCNT(j)  (256  + 64 * (j))
#define XB_XSUB(j)  (1280 + 64 * (j))
#define XB_XGEN(j)  (2304 + 64 * (j))
#define XB_TOP      3328
#define XB_TOPGEN   3392
#define XCD_BAR_WORDS 3456
#define XB_SPIN_CAP (1u << 18)

__device__ __forceinline__ unsigned xb_ld(unsigned* p)              { return __hip_atomic_load(p, __ATOMIC_RELAXED, __HIP_MEMORY_SCOPE_AGENT); }
__device__ __forceinline__ unsigned xb_add(unsigned* p, unsigned v) { return __hip_atomic_fetch_add(p, v, __ATOMIC_RELAXED, __HIP_MEMORY_SCOPE_AGENT); }
__device__ __forceinline__ unsigned xb_xcc_id() { return (unsigned)__builtin_amdgcn_s_getreg((3 << 11) | 20) & 0xFu; }
#define XB_SPIN(cond, bar) do { unsigned _sp = 0; while (cond) { __builtin_amdgcn_s_sleep(1); \
    if ((++_sp & 255u) == 0u) { if (xb_ld(&(bar)[XB_TMO])) break; if (_sp > XB_SPIN_CAP) { atomicAdd(&(bar)[XB_TMO], 1u); break; } } } } while (0)

struct XcdBarrier {
    unsigned* bar; unsigned x;
    volatile unsigned* st;
};

__device__ __forceinline__ XcdBarrier xcd_barrier_post(unsigned* bar, volatile unsigned* st) {
    XcdBarrier b; b.bar = bar; b.x = xb_xcc_id(); b.st = st;
    if (threadIdx.x == 0) (void)xb_add(&bar[XB_XCNT(b.x)], 1u);
    return b;
}
__device__ __forceinline__ void xcd_barrier_complete(unsigned* bar, unsigned x, unsigned& nloc, unsigned& nx) {
    const unsigned G = gridDim.x * gridDim.y * gridDim.z;
    unsigned sum, cnt, mine, sp = 0u;
    for (;;) {
        sum = 0u; cnt = 0u; mine = 0u;
#pragma unroll
        for (unsigned j = 0; j < 16; ++j) { const unsigned c = xb_ld(&bar[XB_XCNT(j)]); sum += c; cnt += (c > 0u) ? 1u : 0u; mine = (j == x) ? c : mine; }
        if (sum == G) break;
        __builtin_amdgcn_s_sleep(1);
        if ((++sp & 255u) == 0u) { if (xb_ld(&bar[XB_TMO])) break; if (sp > XB_SPIN_CAP) { atomicAdd(&bar[XB_TMO], 1u); break; } }
    }
    nloc = mine > 0u ? mine : 1u; nx = cnt > 0u ? cnt : 1u;
}

__device__ __forceinline__ void xcd_barrier(const XcdBarrier& b) {
    asm volatile("s_waitcnt vmcnt(0)" ::: "memory");
    __syncthreads();
    if (threadIdx.x == 0) {
        unsigned* bar = b.bar;
        __builtin_amdgcn_s_waitcnt(0);
        unsigned nloc = b.st[0], nx = b.st[1];
        if (nloc == 0u) { xcd_barrier_complete(bar, b.x, nloc, nx); b.st[0] = nloc; b.st[1] = nx; }
        const unsigned old = xb_add(&bar[XB_XSUB(b.x)], 1u);
        const unsigned gen = old / nloc;
        if (old + 1u == (gen + 1u) * nloc) {
            __builtin_amdgcn_fence(__ATOMIC_RELEASE, "agent");
            asm volatile("s_waitcnt vmcnt(0)" ::: "memory");
            const unsigned og = xb_add(&bar[XB_TOP], 1u);
            const unsigned tg = og / nx;
            if (og + 1u == (tg + 1u) * nx) xb_add(&bar[XB_TOPGEN], 1u);
            else XB_SPIN(xb_ld(&bar[XB_TOPGEN]) == tg, bar);
            __builtin_amdgcn_fence(__ATOMIC_ACQUIRE, "agent");
            xb_add(&bar[XB_XGEN(b.x)], 1u);
            asm volatile("s_waitcnt vmcnt(0)" ::: "memory");
        } else {
            XB_SPIN(xb_ld(&bar[XB_XGEN(b.x)]) == gen, bar);
            __builtin_amdgcn_fence(__ATOMIC_ACQUIRE, "agent");
            asm volatile("s_waitcnt vmcnt(0)" ::: "memory");
        }
    }
    __syncthreads();
}

DI void gbar(unsigned* cnt, unsigned target) {
    asm volatile("s_waitcnt vmcnt(0) lgkmcnt(0)" ::: "memory");
    __syncthreads();
    if (threadIdx.x == 0) {
        __builtin_amdgcn_fence(__ATOMIC_RELEASE, "agent");
        __hip_atomic_fetch_add(cnt, 1u, __ATOMIC_RELAXED, __HIP_MEMORY_SCOPE_AGENT);
        while (__hip_atomic_load(cnt, __ATOMIC_RELAXED, __HIP_MEMORY_SCOPE_AGENT) < target) __builtin_amdgcn_s_sleep(1);
        __builtin_amdgcn_fence(__ATOMIC_ACQUIRE, "agent");
    }
    __syncthreads();
}
#define GSYNC() do { XcdBarrier xb_; xb_.bar = (unsigned*)(ws + WS_XBAR); xb_.x = xb_xcc_id(); xb_.st = (volatile unsigned*)(lds + LDS_BYTES - 64); xcd_barrier(xb_); if ((DUP_MASK) & 256) xcd_barrier(xb_); } while (0)
#define DUPN(bit) (((DUP_MASK) & (bit)) ? 2 : 1)
__global__ void __launch_bounds__(512, 2) fwd_kernel(Args a) {
    extern __shared__ __attribute__((aligned(16))) unsigned char lds[];
    cg::grid_group grid = cg::this_grid();
#ifdef PAD_NOPS
    asm volatile(".rept " PAD_NOPS "\n s_nop 0\n .endr" ::: );
#endif
    unsigned char* ws = a.ws;
    int tid = threadIdx.x, lane = tid & 63, wave = __builtin_amdgcn_readfirstlane(tid >> 6);
    const int G = gridDim.x, bid = blockIdx.x;
    float* MODV = (float*)(ws + WS_MODV); float* MISC = (float*)(ws + WS_MISC);
    if (bid == 0 && tid < 24) ((const float**)(ws + WS_ARGS))[tid] = tid < 23 ? a.in[tid] : (const float*)a.out;
    volatile unsigned* xst = (volatile unsigned*)(lds + LDS_BYTES - 64);
    if (tid < 2) xst[tid] = 0u;
    __syncthreads();
    (void)xcd_barrier_post((unsigned*)(ws + WS_XBAR), xst);


    for (int rep = 0; rep < DUPN(128); ++rep) {
        for (int task = bid; task < 96; task += G) {
            const int l = task / 48, n0 = (task % 48) * 64, n = n0 + lane;
            const float* wm = a.in[4] + (size_t)l * 1024 * 3072; const float* c = a.in[1]; const float* cc = a.in[3];
            float* SV = (float*)lds;
            for (int i = tid; i < 3072; i += 512) { const float x = i < 2048 ? c[i] : cc[i - 2048]; SV[i] = silu_(x); }
            __syncthreads();
            float a0 = 0.f, a1 = 0.f, a2 = 0.f;
            for (int k0 = 0; k0 < 128; k0 += 32) { float w[32];
#pragma unroll
                for (int kk = 0; kk < 32; ++kk) w[kk] = wm[(size_t)(wave * 128 + k0 + kk) * 3072 + n];
#pragma unroll
                for (int kk = 0; kk < 32; ++kk) { const int k = wave * 128 + k0 + kk; a0 += SV[k] * w[kk]; a1 += SV[1024 + k] * w[kk]; a2 += SV[2048 + k] * w[kk]; } }
            float* red = (float*)(lds + 131072);
            red[(wave * 3 + 0) * 64 + lane] = a0; red[(wave * 3 + 1) * 64 + lane] = a1; red[(wave * 3 + 2) * 64 + lane] = a2;
            __syncthreads();
            if (tid < 192) { const int v = tid >> 6; float s = a.in[5][l * 3072 + n0 + lane];
                for (int w = 0; w < 8; ++w) s += red[(w * 3 + v) * 64 + lane];
                MODV[(l * 3 + v) * 3072 + n0 + lane] = s; }
            __syncthreads();
        }
        if (bid == G - 1) {
            float* tabA = (float*)(ws + WS_TABA); float* tabD = (float*)(ws + WS_TABD);
            for (int idx = tid; idx < 128 * 8; idx += 512) { const int pos = idx >> 3, i = idx & 7;
                const float inv = exp2f(-(float)i * (13.287712379549449f / 8.f)); const float ang = (float)pos * inv;
                double rev = (double)ang * 0.15915494309189535; rev -= rint(rev);
                tabA[pos * 16 + i] = __builtin_amdgcn_cosf((float)rev); tabA[pos * 16 + 8 + i] = __builtin_amdgcn_sinf((float)rev); }
            for (int idx = tid; idx < 128 * 16; idx += 512) { const int pos = idx >> 4, i = idx & 15;
                const float inv = exp2f(-(float)i * (13.287712379549449f / 16.f)); const float ang = (float)pos * inv;
                double rev = (double)ang * 0.15915494309189535; rev -= rint(rev);
                tabD[pos * 32 + i] = __builtin_amdgcn_cosf((float)rev); tabD[pos * 32 + 16 + i] = __builtin_amdgcn_sinf((float)rev); }
            if (tid < 2) { const int l = tid; const float* lp = a.in[11] + l * 128; float s1 = 0.f, s2 = 0.f;
                for (int d = 0; d < 32; ++d) { s1 += lp[d] * lp[32 + d]; s2 += lp[64 + d] * lp[96 + d]; }
                const float lam_init = 0.8f - 0.6f * expf(-0.3f * (float)l);
                float gq = 0.f, gk = 0.f, gqd = 0.f, gkd = 0.f, sk = 0.f;
                for (int d = 0; d < 32; ++d) { gq = fmaxf(gq, fabsf(a.in[9][l * 32 + d])); gk = fmaxf(gk, fabsf(a.in[10][l * 32 + d])); }
                for (int d = 0; d < 64; ++d) { gqd = fmaxf(gqd, fabsf(a.in[20][l * 64 + d])); gkd = fmaxf(gkd, fabsf(a.in[21][l * 64 + d])); }
                for (int d = 0; d < 4; ++d) sk = fmaxf(sk, a.in[22][l * 4 + d] * LOG2E);
                MISC[l * 8 + 0] = expf(s1) - expf(s2) + lam_init; MISC[l * 8 + 1] = lam_init;
                MISC[l * 8 + 2] = 5.656854249f * LOG2E * gq * gk * 1.01f; MISC[l * 8 + 3] = fmaxf(8.f * LOG2E * gqd * gkd * 1.01f, sk); }
        }
        float* scr = (float*)(lds + wave * 16384);
        const int gw = bid * 8 + wave, NGW = G * 8;
        for (int it = gw; it < 2048; it += NGW) {
            if (it < 4096) { const int l = it >> 11; transpose_item(a.in[7] + (size_t)l * 1024 * NSRC, NSRC, true, (bf16*)(ws + WS_WIN) + (size_t)l * NP * 1024, 1024, it & 2047, NP / 32, scr, lane); }
            else { const int r = it - 4096, l = r >> 9; transpose_item(a.in[8] + (size_t)l * 1024 * 1024, 1024, false, (bf16*)(ws + WS_WOUT) + (size_t)l * 1024 * 1024, 1024, r & 511, 32, scr, lane); }
        }
    }
    if (a.ws == nullptr) grid.sync();
    GSYNC();

#pragma unroll 1
    for (int l = 0; l < 2; ++l) {
        asm volatile("" : "+s"(ws));
        const float* const* IN = (const float* const*)(ws + WS_ARGS); float* OUT = (float*)IN[23];
        const float* xsrc = l == 0 ? IN[0] : OUT; const float* csrc = l == 0 ? IN[2] : (const float*)(ws + WS_CTX);
        tid = otid(); lane = tid & 63; wave = __builtin_amdgcn_readfirstlane(tid >> 6);
        {
            const int gw = bid * 8 + wave, NGW = G * 8; const float* ng = IN[6] + l * 1024;
            for (int rep = 0; rep < DUPN(1); ++rep)
            for (int m0 = gw; m0 < M; m0 += 2 * NGW) {
                const float* srcs[2]; int vs[2]; bool ok[2]; f32x4 x[2][4];
#pragma unroll
                for (int r = 0; r < 2; ++r) { const int m = m0 + r * NGW; ok[r] = m < M; const int mm = ok[r] ? m : m0;
                    const int b = mm >= TK ? 1 : 0, j = mm - b * TK;
                    if (j < LC) { srcs[r] = csrc + (size_t)(b * LC + j) * D; vs[r] = 2; } else { srcs[r] = xsrc + (size_t)(b * T + j - LC) * D; vs[r] = b; }
#pragma unroll
                    for (int q = 0; q < 4; ++q) x[r][q] = ldg((const f32x4*)srcs[r] + lane + 64 * q); }
#pragma unroll
                for (int r = 0; r < 2; ++r) { if (!ok[r]) continue; const int m = m0 + r * NGW;
                    const float* md = MODV + (l * 3 + vs[r]) * 3072; float ss = 0.f;
#pragma unroll
                    for (int q = 0; q < 4; ++q) ss += (x[r][q].x * x[r][q].x + x[r][q].y * x[r][q].y) + (x[r][q].z * x[r][q].z + x[r][q].w * x[r][q].w);
                    const float rinv = rsqrtf(wave_sum(ss) * (1.f / 1024.f) + EPS);
                    bf16* dst = (bf16*)(ws + WS_HXY) + (size_t)m * D;
#pragma unroll
                    for (int q = 0; q < 4; ++q) { const int col = 4 * (lane + 64 * q);
                        const f32x4 g = ldg((const f32x4*)(ng + col)), sh = ldg((const f32x4*)(md + col)), sc = ldg((const f32x4*)(md + 1024 + col));
                        const f32x4 y = (x[r][q] * rinv) * g * (sc + 1.f) + sh;
                        stg((u32x2*)(dst + col), (u32x2){pk(y.x, y.y), pk(y.z, y.w)}); } }
            }
        }
        GSYNC();
        {
#ifdef USE_MINI
            constexpr int NBIG = 3840, NUNITS = (M / 256) * (NBIG / 256);
            { const int first = NUNITS % G;
              if (bid >= first) mini_proj(lds, ws, bid - first, G - first, M / 256, (const bf16*)(ws + WS_WIN) + ((size_t)l * NP + NBIG) * 1024, IN[15] + l * 16); }
#else
            constexpr int NBIG = NP;
#endif
            pg8::Gemm g{(const pg8::bf16_t*)(ws + WS_HXY), (const pg8::bf16_t*)(ws + WS_WIN) + (size_t)l * NP * 1024, M, NBIG, D};
            pg8::StaticOrder S; S.init(M, NBIG, G, bid);
            EpiIn E{ws, l};
            for (int rep = 0; rep < DUPN(2); ++rep) pg8::gemm_phase<EpiIn, pg8::StaticOrder, true, true>((PG8_LAS unsigned char*)lds, g, S, E);
        }
        GSYNC();
        {
            const float* misc = MISC + l * 8;
#ifdef PAD_CA
            asm volatile("s_nop 0");
#endif
            fill_wcache(lds, IN, l);
            for (int rep = 0; rep < DUPN(4); ++rep) {
                { const float* cw = (const float*)(lds + WC_OFF) + WC_CW; const float* cb = (const float*)(lds + WC_OFF) + WC_CB;
                  int t = bid; MaPre cur = mlstm_a_load(ws, t < 8 * NCH ? t : 0);
                  while (t < 8 * NCH) { const int tn = t + G; MaPre nxt = mlstm_a_load(ws, tn < 8 * NCH ? tn : t); mlstm_a_run(lds, ws, t, cur, cw, cb); cur = nxt; t = tn; } }
                { const float* wg = (const float*)(lds + WC_OFF) + WC_WG; const float* bg = (const float*)(lds + WC_OFF) + WC_BG;
                  int t = (bid + G / 2) % G; GlPre cur = gla_load(ws, t < 8 * NCH ? t : 0, false);
                  while (t < 8 * NCH) { const int tn = t + G; GlPre nxt = gla_load(ws, tn < 8 * NCH ? tn : t, false); gla_a_run(lds, ws, t, cur, wg, bg); cur = nxt; t = tn; } }
            }
#ifdef PAD_CA
            asm volatile("s_nop 0");
#endif
            const int nU = l == 0 ? 264 : 256;
            for (int rep = 0; rep < DUPN(8); ++rep)
            for (int u = bid; u < nU; u += G) attnD_unit(lds, ws, u, IN[22] + l * 4, misc);
            for (int rep = 0; rep < DUPN(16); ++rep)
            for (int u = bid; u < nU; u += G) attnA_unit(lds, ws, u, IN[12] + l * 64, misc);
        }
        GSYNC();
        for (int t = bid; t < 208; t += G) scan_b(lds, ws, t);
        if (l == 0) {
            float* scr = (float*)(lds + wave * 16384);
            for (int it = 2048 + bid * 8 + wave; it < 2 * 2048 + 2 * 512; it += G * 8) {
                if (it < 4096) { transpose_item(IN[7] + (size_t)1024 * NSRC, NSRC, true, (bf16*)(ws + WS_WIN) + (size_t)NP * 1024, 1024, it & 2047, NP / 32, scr, lane); }
                else { const int r = it - 4096, ll = r >> 9; transpose_item(IN[8] + (size_t)ll * 1024 * 1024, 1024, false, (bf16*)(ws + WS_WOUT) + (size_t)ll * 1024 * 1024, 1024, r & 511, 32, scr, lane); }
            }
            __syncthreads();
        }
        GSYNC();
#ifdef PAD_CC
        asm volatile("s_nop 0");
#endif
        fill_wcache(lds, IN, l);
        for (int rep = 0; rep < DUPN(32); ++rep) {
            const int ncl = l == 0 ? NCH : NCH - 4, ntask = 8 * ncl;
#define C_TASK(u) (((u) / ncl) * NCH + ((u) % ncl) + (NCH - ncl))
            { const float* cw = (const float*)(lds + WC_OFF) + WC_CW; const float* cb = (const float*)(lds + WC_OFF) + WC_CB; const float* on = (const float*)(lds + WC_OFF) + WC_BON;
              int u = bid; McPre cur = mlstm_c_load(ws, C_TASK(u < ntask ? u : 0));
              while (u < ntask) { const int un = u + G; McPre nxt = mlstm_c_load(ws, C_TASK(un < ntask ? un : u)); mlstm_c_run(lds, ws, C_TASK(u), cur, cw, cb, on); cur = nxt; u = un; } }
            { const float* wg = (const float*)(lds + WC_OFF) + WC_WG; const float* bg = (const float*)(lds + WC_OFF) + WC_BG; const float* on = (const float*)(lds + WC_OFF) + WC_CON;
              int u = (bid + G / 2) % G; GcPre cur = gla_c_load(ws, C_TASK(u < ntask ? u : 0));
              while (u < ntask) { const int un = u + G; GcPre nxt = gla_c_load(ws, C_TASK(un < ntask ? un : u)); gla_c_run(lds, ws, C_TASK(u), cur, wg, bg, on); cur = nxt; u = un; } }
        }
#ifdef PAD_CC
        asm volatile("s_nop 0");
#endif
        GSYNC();
        {
            pg8::Gemm g{(const pg8::bf16_t*)(ws + WS_HXY), (const pg8::bf16_t*)(ws + WS_WOUT) + (size_t)l * 1024 * 1024, M, D, D};
            EpiOut E{xsrc, csrc, OUT, (float*)(ws + WS_CTX), MODV + l * 3 * 3072};
            if (l == 0) { pg8::StaticOrder S; S.init(M, D, G, bid); for (int rep = 0; rep < DUPN(64); ++rep) pg8::gemm_phase<EpiOut, pg8::StaticOrder, true, true>((PG8_LAS unsigned char*)lds, g, S, E); }
            else { LatOrder S; S.so.init(NB * T, D, G, bid); pg8::gemm_phase<EpiOut, LatOrder, true, true>((PG8_LAS unsigned char*)lds, g, S, E); }
        }
        if (l == 0) GSYNC();
    }
}

extern "C" void kernel_launch(void* const* d_in, const int* in_sizes, int n_in, void* d_out, int out_size, void* d_ws, size_t ws_size, hipStream_t stream) {
    static int grid = 0;
    if (grid == 0) {
        int dev = 0, cus = 0, per_cu = 0;
        if (n_in != 23 || ws_size < 256 * MiB) { fprintf(stderr, "kernel_launch: unexpected inputs (n_in %d, ws %zu)\n", n_in, ws_size); grid = -1; return; }
        hipGetDevice(&dev); hipDeviceGetAttribute(&cus, hipDeviceAttributeMultiprocessorCount, dev);
        if (hipFuncSetAttribute((const void*)fwd_kernel, hipFuncAttributeMaxDynamicSharedMemorySize, LDS_BYTES) != hipSuccess) { fprintf(stderr, "kernel_launch: hipFuncSetAttribute failed\n"); grid = -1; return; }
        if (hipOccupancyMaxActiveBlocksPerMultiprocessor(&per_cu, (const void*)fwd_kernel, 512, LDS_BYTES) != hipSuccess || per_cu < 1) { fprintf(stderr, "kernel_launch: occupancy query says %d\n", per_cu); per_cu = 1; }
        (void)hipGetLastError();
        grid = cus > 0 ? cus : 256;
    }
    if (grid < 0) return;
    Args a{};
    for (int i = 0; i < 23; ++i) a.in[i] = (const float*)d_in[i];
    a.out = (float*)d_out; a.ws = (unsigned char*)d_ws;
    if (hipMemsetAsync((char*)d_ws + WS_XBAR, 0, 16384, stream) != hipSuccess) { fprintf(stderr, "kernel_launch: memset of the barrier word failed\n"); return; }
    void* args[] = {&a};
    hipError_t e = hipLaunchCooperativeKernel((const void*)fwd_kernel, dim3(grid), dim3(512), args, LDS_BYTES, stream);
    if (e != hipSuccess) fprintf(stderr, "kernel_launch: cooperative launch failed: %s (grid %d)\n", hipGetErrorString(e), grid);
}
```
